# Optimizing an MI355X kernel written in HIP

```python
import math
import jax, jax.numpy as jnp
from jax import lax
import numpy as np

D_MODEL = 1024
BATCH = 8
SEQ = 4096
DEPTH = 1

GRID_W = 64
CTX_LEN = 256
N_ADA = 6
HY_WIDTH = 512
HY_ORDER = 2
HY_EMB = 33
HY_BANDS = (HY_EMB - 1) // 2
HY_FFN = 64
HY_DECAY_TARGET = 1e-2
HY_FAST_PCT = 0.3
HY_SLOW_PCT = 1.5
AT_HEADS = 4
AT_D = 64
AT_W = AT_HEADS * 2 * AT_D
ROPE_AXIS = AT_D // 2
ROPE_BASE = 10000.0
Q_BLOCK = 128
D_FF = 2816
CONV_W = 3
LN_EPS = 1e-5
RMS_EPS = 1e-5
DN_ALPHA = (2.0 * DEPTH) ** 0.25
DN_BETA = (8.0 * DEPTH) ** -0.25
IN_COLS = 3 * HY_WIDTH + 3 * AT_W + 2 * D_MODEL

kernel_name = 'hybrid_hyena_diffattn_convffn_dit'


def layer_norm(x, g, b):
    xf = x.astype(jnp.float32)
    mu = jnp.mean(xf, -1, keepdims=True)
    var = jnp.mean(jnp.square(xf - mu), -1, keepdims=True)
    return ((xf - mu) * lax.rsqrt(var + LN_EPS)).astype(x.dtype) * g + b


def modulate(x, shift, scale):
    return x * (1.0 + scale) + shift


def dwconv3(u, w, b):
    up = jnp.pad(u, ((0, 0), (1, 1), (0, 0)))
    return up[:, :-2] * w[0] + up[:, 1:-1] * w[1] + up[:, 2:] * w[2] + b


def axial_rope_tables(L):
    rows = L // GRID_W
    row = jnp.repeat(jnp.arange(rows, dtype=jnp.float32), GRID_W)
    col = jnp.tile(jnp.arange(GRID_W, dtype=jnp.float32), rows)
    inv = ROPE_BASE ** (-jnp.arange(0, ROPE_AXIS, 2, dtype=jnp.float32) / ROPE_AXIS)
    ang_r = row[:, None] * inv[None]
    ang_c = col[:, None] * inv[None]
    return jnp.cos(ang_r), jnp.sin(ang_r), jnp.cos(ang_c), jnp.sin(ang_c)


def rotate_half(x, cos, sin):
    cos = cos[None, :, None, None, :].astype(x.dtype)
    sin = sin[None, :, None, None, :].astype(x.dtype)
    half = x.shape[-1] // 2
    x1, x2 = x[..., :half], x[..., half:]
    return jnp.concatenate([x1 * cos - x2 * sin, x2 * cos + x1 * sin], -1)


def axial_rope(x, cos_r, sin_r, cos_c, sin_c):
    return jnp.concatenate([rotate_half(x[..., :ROPE_AXIS], cos_r, sin_r),
                            rotate_half(x[..., ROPE_AXIS:], cos_c, sin_c)], -1)


def split_proj(z):
    B, L, _ = z.shape
    o1 = 3 * HY_WIDTH
    o2 = o1 + AT_W
    o3 = o2 + AT_W
    o4 = o3 + AT_W
    o5 = o4 + D_MODEL
    hy = z[..., :o1]
    q = z[..., o1:o2].reshape(B, L, AT_HEADS, 2, AT_D)
    k = z[..., o2:o3].reshape(B, L, AT_HEADS, 2, AT_D)
    v = z[..., o3:o4].reshape(B, L, AT_HEADS, 2 * AT_D)
    g_hy = z[..., o4:o5]
    g_at = z[..., o5:]
    return hy, q, k, v, g_hy, g_at


def hyena_filters(L, w1, b1, w2, b2, w3, b3, freq, w_out):
    t = jnp.linspace(0.0, 1.0, L, dtype=jnp.float32)[:, None]
    w = (2.0 * math.pi / L) * jnp.arange(L, dtype=jnp.float32)[:, None]
    f = jnp.linspace(1e-4, HY_BANDS - 1, HY_BANDS, dtype=jnp.float32)[None, :]
    z = jnp.concatenate([t, jnp.cos(f * w), -jnp.sin(f * w)], -1).astype(w1.dtype)
    hdn = jnp.sin(freq[0] * (z @ w1 + b1))
    hdn = jnp.sin(freq[1] * (hdn @ w2 + b2))
    hdn = jnp.sin(freq[2] * (hdn @ w3 + b3))
    h = (hdn @ w_out).reshape(L, HY_ORDER, 2, HY_WIDTH)
    min_decay = math.log(HY_DECAY_TARGET) / HY_SLOW_PCT
    max_decay = math.log(HY_DECAY_TARGET) / HY_FAST_PCT
    deltas = jnp.linspace(min_decay, max_decay, HY_WIDTH, dtype=jnp.float32)
    decay = jnp.exp(-t * jnp.abs(deltas)[None, :])
    h = h * decay[:, None, None, :].astype(h.dtype)
    fwd, bwd = h[:, :, 0], h[:, :, 1]
    return jnp.concatenate([fwd, jnp.zeros_like(fwd[:1]), bwd[:0:-1]], 0)


def long_conv(u, k, bias):
    L = u.shape[1]
    uf = jnp.fft.rfft(u.astype(jnp.float32), n=2 * L, axis=1)
    kf = jnp.fft.rfft(k.astype(jnp.float32), n=2 * L, axis=0)
    y = jnp.fft.irfft(uf * kf[None], n=2 * L, axis=1)[:, :L]
    return y.astype(u.dtype) + u * bias


def hyena_branch(z_hy, conv_w, conv_b, filt, bias):
    u = dwconv3(z_hy, conv_w, conv_b)
    v, x1, x2 = jnp.split(u, 3, -1)
    zz = x1 * long_conv(v, filt[:, 0], bias[0])
    return x2 * long_conv(zz, filt[:, 1], bias[1])


def diff_attn(q, k, v, lam):
    s = jnp.einsum('bqhcd,bkhcd->bhcqk', q, k).astype(jnp.float32) * (AT_D ** -0.5)
    p = jax.nn.softmax(s, axis=-1)
    a = p[:, :, 0] - lam * p[:, :, 1]
    return jnp.einsum('bhqk,bkhv->bqhv', a.astype(v.dtype), v)


def blocked_diff_attn(q, k, v, lam):
    B, L, H, C, d = q.shape
    nb = L // Q_BLOCK
    qb = jnp.moveaxis(q.reshape(B, nb, Q_BLOCK, H, C, d), 1, 0)
    ob = lax.map(lambda qi: diff_attn(qi, k, v, lam), qb)
    return jnp.moveaxis(ob, 0, 1).reshape(B, L, H, 2 * AT_D)


def merge_branches(y_hy, o_at, g_hy, g_at, subln_g, lam_init, w_hy_o, w_at_o, w_out):
    B, L = o_at.shape[:2]
    of = o_at.astype(jnp.float32)
    of = of * lax.rsqrt(jnp.mean(jnp.square(of), -1, keepdims=True) + RMS_EPS)
    o = (of.astype(o_at.dtype) * subln_g * (1.0 - lam_init)).reshape(B, L, AT_W)
    m = jax.nn.sigmoid(g_hy) * (y_hy @ w_hy_o) + jax.nn.sigmoid(g_at) * (o @ w_at_o)
    return m @ w_out


def conv_ffn(h, w_up, conv_w, conv_b, w_down):
    u = dwconv3(h @ w_up, conv_w, conv_b)
    a, g = jnp.split(u, 2, -1)
    return (jax.nn.silu(g) * a) @ w_down


def setup_inputs(seed: int = 0) -> dict:
    key = jax.random.key(seed)
    ks = jax.random.split(key, 40)
    D = D_MODEL
    L = DEPTH

    def nrm(i, shape, s):
        return s * jax.random.normal(ks[i], shape, jnp.float32)

    return {
        'x': nrm(0, (BATCH, SEQ, D), 1.0),
        'c': nrm(1, (BATCH, D), 1.0),
        'ctx': nrm(2, (BATCH, CTX_LEN, D), 1.0),
        'c_ctx': nrm(3, (D,), 1.0),
        'ln_in_g': 1.0 + nrm(4, (D,), 0.02),
        'ln_in_b': nrm(5, (D,), 0.02),
        'w_ada': nrm(6, (L, D, N_ADA * D), D ** -0.5),
        'b_ada': nrm(7, (L, N_ADA * D), 0.02),
        'w_in': nrm(8, (L, D, IN_COLS), D ** -0.5),
        'hy_conv_w': nrm(9, (L, CONV_W, 3 * HY_WIDTH), CONV_W ** -0.5),
        'hy_conv_b': nrm(10, (L, 3 * HY_WIDTH), 0.02),
        'hy_f_w1': nrm(11, (L, HY_EMB, HY_FFN), HY_EMB ** -0.5),
        'hy_f_b1': nrm(12, (L, HY_FFN), 0.02),
        'hy_f_w2': nrm(13, (L, HY_FFN, HY_FFN), HY_FFN ** -0.5),
        'hy_f_b2': nrm(14, (L, HY_FFN), 0.02),
        'hy_f_w3': nrm(15, (L, HY_FFN, HY_FFN), HY_FFN ** -0.5),
        'hy_f_b3': nrm(16, (L, HY_FFN), 0.02),
        'hy_f_freq': 1.0 + nrm(17, (L, 3, HY_FFN), 0.02),
        'hy_f_wout': nrm(18, (L, HY_FFN, HY_ORDER * 2 * HY_WIDTH), 0.1 * HY_FFN ** -0.5),
        'hy_bias': nrm(19, (L, HY_ORDER, HY_WIDTH), 1.0),
        'lam_q1': nrm(20, (L, AT_D), 0.1),
        'lam_k1': nrm(21, (L, AT_D), 0.1),
        'lam_q2': nrm(22, (L, AT_D), 0.1),
        'lam_k2': nrm(23, (L, AT_D), 0.1),
        'at_subln_g': 1.0 + nrm(24, (L, 2 * AT_D), 0.02),
        'w_hy_o': nrm(25, (L, HY_WIDTH, D), HY_WIDTH ** -0.5),
        'w_at_o': nrm(26, (L, AT_W, D), AT_W ** -0.5),
        'w_out': nrm(27, (L, D, D), DN_BETA * D ** -0.5),
        'ln1_g': 1.0 + nrm(28, (L, D), 0.02),
        'ln1_b': nrm(29, (L, D), 0.02),
        'ffn_w_up': nrm(30, (L, D, 2 * D_FF), D ** -0.5),
        'ffn_conv_w': nrm(31, (L, CONV_W, 2 * D_FF), CONV_W ** -0.5),
        'ffn_conv_b': nrm(32, (L, 2 * D_FF), 0.02),
        'ffn_w_down': nrm(33, (L, D_FF, D), DN_BETA * D_FF ** -0.5),
        'ln2_g': 1.0 + nrm(34, (L, D), 0.02),
        'ln2_b': nrm(35, (L, D), 0.02),
    }


def reference(x, c, ctx, c_ctx, ln_in_g, ln_in_b, w_ada, b_ada, w_in, hy_conv_w, hy_conv_b,
              hy_f_w1, hy_f_b1, hy_f_w2, hy_f_b2, hy_f_w3, hy_f_b3, hy_f_freq, hy_f_wout, hy_bias,
              lam_q1, lam_k1, lam_q2, lam_k2, at_subln_g, w_hy_o, w_at_o, w_out, ln1_g, ln1_b,
              ffn_w_up, ffn_conv_w, ffn_conv_b, ffn_w_down, ln2_g, ln2_b):
    seq_len = x.shape[1]
    ctx_len = ctx.shape[1]
    cos_r, sin_r, cos_c, sin_c = axial_rope_tables(seq_len)
    x = layer_norm(x, ln_in_g, ln_in_b)
    ctx_s = layer_norm(ctx, ln_in_g, ln_in_b)

    for l in range(DEPTH):
        last = l == DEPTH - 1
        lam_init = 0.8 - 0.6 * math.exp(-0.3 * l)
        mod_lat = jax.nn.silu(c) @ w_ada[l] + b_ada[l]
        mod_ctx = jax.nn.silu(c_ctx) @ w_ada[l] + b_ada[l]
        sh1, sc1, g1, sh2, sc2, g2 = jnp.split(mod_lat[:, None, :], N_ADA, -1)
        sh1c, sc1c, g1c, sh2c, sc2c, g2c = jnp.split(mod_ctx[None, None, :], N_ADA, -1)
        lam = (jnp.exp(jnp.sum(lam_q1[l] * lam_k1[l]).astype(jnp.float32))
               - jnp.exp(jnp.sum(lam_q2[l] * lam_k2[l]).astype(jnp.float32)) + lam_init)

        z_lat = modulate(x, sh1, sc1) @ w_in[l]
        z_ctx = modulate(ctx_s, sh1c, sc1c) @ w_in[l]
        hy_l, q_l, k_l, v_l, gh_l, ga_l = split_proj(z_lat)
        hy_c, q_c, k_c, v_c, gh_c, ga_c = split_proj(z_ctx)
        q_l = axial_rope(q_l, cos_r, sin_r, cos_c, sin_c)
        k_l = axial_rope(k_l, cos_r, sin_r, cos_c, sin_c)
        k_all = jnp.concatenate([k_c, k_l], 1)
        v_all = jnp.concatenate([v_c, v_l], 1)
        o_l = blocked_diff_attn(q_l, k_all, v_all, lam)
        filt_lat = hyena_filters(seq_len, hy_f_w1[l], hy_f_b1[l], hy_f_w2[l], hy_f_b2[l],
                                 hy_f_w3[l], hy_f_b3[l], hy_f_freq[l], hy_f_wout[l])
        y_hy_l = hyena_branch(hy_l, hy_conv_w[l], hy_conv_b[l], filt_lat, hy_bias[l])
        y_l = merge_branches(y_hy_l, o_l, gh_l, ga_l, at_subln_g[l], lam_init,
                             w_hy_o[l], w_at_o[l], w_out[l])

        if not last:
            o_c = diff_attn(q_c, k_c, v_c, lam)
            filt_ctx = hyena_filters(ctx_len, hy_f_w1[l], hy_f_b1[l], hy_f_w2[l], hy_f_b2[l],
                                     hy_f_w3[l], hy_f_b3[l], hy_f_freq[l], hy_f_wout[l])
            y_hy_c = hyena_branch(hy_c, hy_conv_w[l], hy_conv_b[l], filt_ctx, hy_bias[l])
            y_c = merge_branches(y_hy_c, o_c, gh_c, ga_c, at_subln_g[l], lam_init,
                                 w_hy_o[l], w_at_o[l], w_out[l])
            ctx_s = layer_norm(DN_ALPHA * ctx_s + g1c * y_c, ln1_g[l], ln1_b[l])
            f_c = conv_ffn(modulate(ctx_s, sh2c, sc2c), ffn_w_up[l], ffn_conv_w[l],
                           ffn_conv_b[l], ffn_w_down[l])
            ctx_s = layer_norm(DN_ALPHA * ctx_s + g2c * f_c, ln2_g[l], ln2_b[l])

        x = layer_norm(DN_ALPHA * x + g1 * y_l, ln1_g[l], ln1_b[l])
        f_l = conv_ffn(modulate(x, sh2, sc2), ffn_w_up[l], ffn_conv_w[l],
                       ffn_conv_b[l], ffn_w_down[l])
        x = layer_norm(DN_ALPHA * x + g2 * f_l, ln2_g[l], ln2_b[l])
    return x
```

```cpp
#include <hip/hip_runtime.h>
#include <hip/hip_cooperative_groups.h>
#include <cstdio>
#include <cstdint>
namespace cg = cooperative_groups;
namespace pg8 {
#define PG8_LAS __attribute__((address_space(3)))
typedef unsigned short bf16_t;
typedef short bf16x8 __attribute__((ext_vector_type(8)));
typedef float f32x4 __attribute__((ext_vector_type(4)));
typedef unsigned u32x4 __attribute__((ext_vector_type(4)));
constexpr int BM = 256, BK = 64, HALF = 128, HTB = HALF * BK * 2  , STAGE_BYTES = 8 * HTB, NXCD = 8, WGM = 8;

__host__ __device__ __forceinline__ int lds_byte(int r, int c) { const int st = (r >> 4) * 2 + (c >> 5), rr = r & 15, cc = c & 31, ob = rr * 64 + cc * 2; return st * 1024 + (ob ^ (((ob >> 9) & 1) << 5)); }
__host__ __device__ __forceinline__ void stage_rc(int b, int& R, int& C) { const int st = b / 1024, sb = b % 1024, swz = sb ^ (((sb >> 9) & 1) << 5); R = (st >> 1) * 16 + swz / 64; C = (st & 1) * 32 + (swz % 64) / 2; }
__host__ __device__ __forceinline__ int perm32(int rho) { const int n = rho >> 4, i = rho & 15; return 8 * (i >> 2) + 4 * n + (i & 3); }

struct Unit { int pm, pn; };
struct Gemm { const bf16_t* A; const bf16_t* Bt; int M, N, K; };

struct StaticOrder {
    int nM, nN, nwg, G, c;
    __host__ __device__ void init(int M, int N, int G_, int c_) { nM = M / BM; nN = N / BM; nwg = nM * nN; G = G_; c = c_; }
    __host__ __device__ bool next(int i, Unit& u) const {
        const long L = (long)i * G + c; if (L >= nwg) return false;
        int wgid = (int)L; { const int q = nwg / NXCD, r = nwg % NXCD, xcd = wgid % NXCD, off = wgid / NXCD; wgid = (xcd < r ? xcd * (q + 1) : r * (q + 1) + (xcd - r) * q) + off; }
        const int nig = WGM * nN, gid = wgid / nig, fm = gid * WGM, gsz = (nM - fm) < WGM ? (nM - fm) : WGM;
        u.pm = fm + ((wgid % nig) % gsz); u.pn = (wgid % nig) / gsz; return true;
    }
    __device__ __forceinline__ void a_ready(const Unit&) const {}
    __device__ __forceinline__ void done(const Unit&) const {}
};
__device__ __forceinline__ unsigned cvt_pk_bf16(float lo, float hi) { unsigned r; asm volatile("v_cvt_pk_bf16_f32 %0, %1, %2" : "=v"(r) : "v"(lo), "v"(hi)); return r; }
typedef float f32x2 __attribute__((ext_vector_type(2)));
template <class Epi, class Sched, bool ALIGN_EPI = false, bool SP2 = false>
__device__ __forceinline__ void gemm_phase(PG8_LAS unsigned char* lds, const Gemm g, const Sched& S, const Epi& E) {
    int tid_l = threadIdx.x; asm volatile("" : "+v"(tid_l));
    const int tid = tid_l, wid = __builtin_amdgcn_readfirstlane(tid >> 6), lane = tid & 63, wr = wid >> 2, wc = wid & 3, fr = lane & 15, fq = lane >> 4;
    const int K = g.K, nt = K / BK;
    unsigned voffA[2], voffB[2];
#pragma unroll
    for (int i = 0; i < 2; ++i) { int R, C; stage_rc(tid * 16 + i * 8192, R, C); const int Rb = Epi::PERM ? ((R & ~31) + perm32(R & 31)) : R;
        voffA[i] = (unsigned)(R * K + C) * 2u; voffB[i] = (unsigned)(Rb * K + C) * 2u; }
    const size_t kstep = (size_t)(BK * 2);
    const size_t hstep = (size_t)HALF * K * 2;
    const size_t tstep = 2 * hstep;
    const unsigned ldsw = (unsigned)wid * 1024u;
    const int aoff = lds_byte(wr * 64 + fr, fq * 8), boff = lds_byte(wc * 32 + fr, fq * 8);
#define PG8_SA(b, h) (((b) * 2 + (h)) * HTB)
#define PG8_SB(b, h) ((4 + (b) * 2 + (h)) * HTB)
#define PG8_STAGE(bufoff, gbase, voff) do { _Pragma("unroll") for (int _i = 0; _i < 2; ++_i) \
        __builtin_amdgcn_global_load_lds((const unsigned*)((const char*)(gbase) + (voff)[_i]), (PG8_LAS unsigned*)(lds + (bufoff) + ldsw + _i * 8192), 16, 0, 0); } while (0)
#define PG8_LDA(dst, b, h) do { _Pragma("unroll") for (int m = 0; m < 4; ++m) _Pragma("unroll") for (int k = 0; k < 2; ++k) dst[m][k] = *(const PG8_LAS bf16x8*)(lds + PG8_SA(b, h) + aoff + m * 2048 + k * 1024); } while (0)
#define PG8_LDB(dst, b, h) do { _Pragma("unroll") for (int n = 0; n < 2; ++n) _Pragma("unroll") for (int k = 0; k < 2; ++k) dst[n][k] = *(const PG8_LAS bf16x8*)(lds + PG8_SB(b, h) + boff + n * 2048 + k * 1024); } while (0)
#define PG8_MMA(ai, bj, At, Bt) do { __builtin_amdgcn_s_setprio(1); _Pragma("unroll") for (int m = 0; m < 4; ++m) _Pragma("unroll") for (int n = 0; n < 2; ++n) _Pragma("unroll") for (int k = 0; k < 2; ++k) \
        acc[ai][bj][m][n] = __builtin_amdgcn_mfma_f32_16x16x32_bf16(Bt[n][k], At[m][k], acc[ai][bj][m][n], 0, 0, 0); __builtin_amdgcn_s_setprio(0); } while (0)
#define PG8_WAIT_V(n) asm volatile("s_waitcnt vmcnt(" #n ")" ::: "memory")
#define PG8_WAIT_L(n) asm volatile("s_waitcnt lgkmcnt(" #n ")" ::: "memory")
#define PG8_BAR __builtin_amdgcn_s_barrier()
#define PG8_SCHED __builtin_amdgcn_sched_barrier(0)
    Unit cur, nxt; int ui = 0;
    if (!S.next(0, cur)) return;
    f32x4 acc[2][2][4][2];
#pragma unroll
    for (int a = 0; a < 2; ++a)
#pragma unroll
        for (int b = 0; b < 2; ++b)
#pragma unroll
            for (int m = 0; m < 4; ++m)
#pragma unroll
                for (int n = 0; n < 2; ++n) acc[a][b][m][n] = (f32x4){0.f, 0.f, 0.f, 0.f};
    bf16x8 At[4][2], B0[2][2], B1[2][2];
    const char* cA = (const char*)g.A + (size_t)cur.pm * tstep; const char* cB = (const char*)g.Bt + (size_t)cur.pn * tstep;
    S.a_ready(cur);
    if constexpr (SP2) {
        PG8_STAGE(PG8_SB(0, 0), cB, voffB); PG8_STAGE(PG8_SB(0, 1), cB + hstep, voffB); PG8_STAGE(PG8_SA(0, 0), cA, voffA); PG8_STAGE(PG8_SA(0, 1), cA + hstep, voffA);
        if (wr == 1) PG8_BAR;
        PG8_WAIT_V(2); PG8_BAR;
        PG8_STAGE(PG8_SB(1, 0), cB + kstep, voffB); PG8_STAGE(PG8_SA(1, 0), cA + kstep, voffA); PG8_STAGE(PG8_SB(1, 1), cB + hstep + kstep, voffB);
        PG8_WAIT_V(6); PG8_BAR;
    } else {
        PG8_STAGE(PG8_SB(0, 0), cB, voffB); PG8_STAGE(PG8_SA(0, 0), cA, voffA); PG8_STAGE(PG8_SB(0, 1), cB + hstep, voffB); PG8_STAGE(PG8_SA(0, 1), cA + hstep, voffA);
        if (wr == 1) PG8_BAR;
        PG8_WAIT_V(4); PG8_BAR;
        PG8_STAGE(PG8_SB(1, 0), cB + kstep, voffB); PG8_STAGE(PG8_SA(1, 0), cA + kstep, voffA); PG8_STAGE(PG8_SB(1, 1), cB + hstep + kstep, voffB);
        PG8_WAIT_V(6); PG8_BAR;
    }
    for (;;) {
        const bool has_next = S.next(ui + 1, nxt);
        const char* nA = has_next ? (const char*)g.A + (size_t)nxt.pm * tstep : cA; const char* nB = has_next ? (const char*)g.Bt + (size_t)nxt.pn * tstep : cB;
        for (int t = 0; t < nt; t += 2) {
            const bool last = (t == nt - 2);
            const char* a1 = cA + (size_t)(t + 1) * kstep;
            const char* a2 = last ? nA : cA + (size_t)(t + 2) * kstep; const char* b2 = last ? nB : cB + (size_t)(t + 2) * kstep;
            const char* a3 = a2 + kstep; const char* b3 = b2 + kstep;
            if (last && has_next) S.a_ready(nxt);
            if constexpr (SP2) {
            PG8_LDB(B0, 0, 0); PG8_LDB(B1, 0, 1); PG8_SCHED; PG8_LDA(At, 0, 0); PG8_STAGE(PG8_SA(1, 1), a1 + hstep, voffA);
            PG8_WAIT_V(8); PG8_WAIT_L(0); PG8_BAR; PG8_MMA(0, 0, At, B0); PG8_MMA(0, 1, At, B1); PG8_BAR; PG8_SCHED;
            PG8_LDA(At, 0, 1); PG8_STAGE(PG8_SB(0, 0), b2, voffB); PG8_STAGE(PG8_SB(0, 1), b2 + hstep, voffB); PG8_STAGE(PG8_SA(0, 0), a2, voffA);
            PG8_WAIT_V(8); PG8_WAIT_L(0); PG8_BAR; PG8_MMA(1, 0, At, B0); PG8_MMA(1, 1, At, B1); PG8_BAR; PG8_SCHED;
            PG8_LDB(B0, 1, 0); PG8_LDB(B1, 1, 1); PG8_SCHED; PG8_LDA(At, 1, 0); PG8_STAGE(PG8_SA(0, 1), a2 + hstep, voffA);
            PG8_WAIT_V(8); PG8_WAIT_L(0); PG8_BAR; PG8_MMA(0, 0, At, B0); PG8_MMA(0, 1, At, B1); PG8_BAR; PG8_SCHED;
            PG8_LDA(At, 1, 1); PG8_STAGE(PG8_SB(1, 0), b3, voffB); PG8_STAGE(PG8_SB(1, 1), b3 + hstep, voffB); PG8_STAGE(PG8_SA(1, 0), a3, voffA);
            PG8_WAIT_V(8); PG8_WAIT_L(0); PG8_BAR; PG8_MMA(1, 0, At, B0); PG8_MMA(1, 1, At, B1); PG8_BAR; PG8_SCHED;
            } else {
            PG8_LDB(B0, 0, 0); PG8_SCHED; PG8_LDA(At, 0, 0); PG8_STAGE(PG8_SA(1, 1), a1 + hstep, voffA);
            PG8_WAIT_L(8); PG8_BAR; PG8_WAIT_L(0); PG8_MMA(0, 0, At, B0); PG8_BAR; PG8_SCHED;
            PG8_LDB(B1, 0, 1); PG8_STAGE(PG8_SB(0, 0), b2, voffB);
            PG8_BAR; PG8_WAIT_L(0); PG8_MMA(0, 1, At, B1); PG8_BAR;
            PG8_LDA(At, 0, 1); PG8_STAGE(PG8_SA(0, 0), a2, voffA);
            PG8_BAR; PG8_WAIT_L(0); PG8_MMA(1, 0, At, B0); PG8_BAR; PG8_SCHED;
            PG8_STAGE(PG8_SB(0, 1), b2 + hstep, voffB);
            PG8_WAIT_V(6); PG8_BAR; PG8_MMA(1, 1, At, B1); PG8_BAR;
            PG8_LDB(B0, 1, 0); PG8_SCHED; PG8_LDA(At, 1, 0); PG8_STAGE(PG8_SA(0, 1), a2 + hstep, voffA);
            PG8_WAIT_L(8); PG8_BAR; PG8_WAIT_L(0); PG8_MMA(0, 0, At, B0); PG8_BAR; PG8_SCHED;
            PG8_LDB(B1, 1, 1); PG8_STAGE(PG8_SB(1, 0), b3, voffB);
            PG8_BAR; PG8_WAIT_L(0); PG8_MMA(0, 1, At, B1); PG8_BAR;
            PG8_LDA(At, 1, 1); PG8_STAGE(PG8_SA(1, 0), a3, voffA);
            PG8_BAR; PG8_WAIT_L(0); PG8_MMA(1, 0, At, B0); PG8_BAR; PG8_SCHED;
            PG8_STAGE(PG8_SB(1, 1), b3 + hstep, voffB);
            PG8_WAIT_V(6); PG8_BAR; PG8_MMA(1, 1, At, B1); PG8_BAR;
            }
        }
        if constexpr (ALIGN_EPI) { if (wr == 0) PG8_BAR; }
        if constexpr (!Epi::AFTER_DRAIN) { E(acc, cur, wr, wc, fr, fq); S.done(cur); }
        if (!has_next) break;
#pragma unroll
        for (int a = 0; a < 2; ++a)
#pragma unroll
            for (int b = 0; b < 2; ++b)
#pragma unroll
                for (int m = 0; m < 4; ++m)
#pragma unroll
                    for (int n = 0; n < 2; ++n) acc[a][b][m][n] = (f32x4){0.f, 0.f, 0.f, 0.f};
        cur = nxt; cA = nA; cB = nB; ++ui;
        if constexpr (ALIGN_EPI) { if (wr == 1) PG8_BAR; }
    }
    PG8_WAIT_V(0);
    if constexpr (!ALIGN_EPI) { if (wr == 0) PG8_BAR; }
    PG8_BAR;
    if constexpr (Epi::AFTER_DRAIN) { E.fused(acc, cur, wr, wc, fr, fq, lds, wid, lane); S.done(cur); }
#undef PG8_SA
#undef PG8_SB
#undef PG8_STAGE
#undef PG8_LDA
#undef PG8_LDB
#undef PG8_MMA
#undef PG8_WAIT_V
#undef PG8_WAIT_L
#undef PG8_BAR
#undef PG8_SCHED
}
}

#ifndef EN_ATT
#define EN_ATT 1
#endif
#ifndef EN_HY
#define EN_HY 1
#endif
#ifndef EN_FFN
#define EN_FFN 1
#endif
#ifndef PHASES
#define PHASES 0xFFFF
#endif
#define PH(k) ((PHASES >> (k)) & 1)
#define LAS __attribute__((address_space(3)))
typedef unsigned short bf16_t;
typedef pg8::f32x4 f32x4;
typedef pg8::u32x4 u32x4;
typedef pg8::bf16x8 bf16x8;
typedef float f32x16 __attribute__((ext_vector_type(16)));
typedef float f32x2 __attribute__((ext_vector_type(2)));
typedef unsigned u32x2 __attribute__((ext_vector_type(2)));
typedef short s16x4 __attribute__((ext_vector_type(4)));

constexpr int D = 1024, NB = 8, SEQ = 4096, MROWS = NB * SEQ, CTX = 256, MCTX = NB * CTX, KV = CTX + SEQ;
constexpr int INC = 5120, DFF = 2816, NUP = 2 * DFF, NADA = 6 * D;
constexpr float LN_EPS = 1e-5f, RMS_EPS = 1e-5f;
constexpr float DN_ALPHA = 1.189207115002721f;
constexpr float LAM_INIT = 0.2f;
constexpr float QSCALE = 0.125f * 1.4426950408889634f;

constexpr size_t MiB = 1u << 20;
constexpr size_t WS_ST0 = 0, WS_ST1 = 256 * 1024, WS_ROPE = 512 * 1024, WS_TW = 528 * 1024, WS_MOD = 576 * 1024;
constexpr size_t WS_MODP = 1 * MiB;
constexpr size_t WS_WIN = 3 * MiB, WS_WHY = 13 * MiB, WS_WAT = 14 * MiB, WS_WOUT = 15 * MiB, WS_WUP = 17 * MiB, WS_WDN = 28 * MiB;
constexpr size_t WS_XM = 34 * MiB;
constexpr size_t WS_ON = 34 * MiB, WS_YHT = 66 * MiB, WS_HM = 34 * MiB;
constexpr size_t WS_CTXM = 98 * MiB;
constexpr size_t WS_FILT = 102 * MiB;
constexpr size_t WS_SG = 102 * MiB;
constexpr size_t WS_KSPEC = 230 * MiB;
constexpr size_t WS_MBUF = 230 * MiB;
constexpr size_t WS_ZHY = 294 * MiB;
constexpr size_t WS_YH = 294 * MiB;
constexpr size_t WS_Q = 390 * MiB, WS_K = 422 * MiB, WS_V = 456 * MiB;
constexpr size_t WS_U = 102 * MiB;
constexpr size_t WS_ACT = 278 * MiB;
constexpr size_t WS_END = 490 * MiB;

constexpr int LDS_BYTES = 139264;

__device__ __forceinline__ int tid_fresh() { int t = threadIdx.x; asm volatile("" : "+v"(t)); return t; }
__device__ __forceinline__ unsigned pk2(float lo, float hi) { return pg8::cvt_pk_bf16(lo, hi); }
__device__ __forceinline__ float bflo(unsigned w) { return __uint_as_float(w << 16); }
__device__ __forceinline__ float bfhi(unsigned w) { return __uint_as_float(w & 0xffff0000u); }
__device__ __forceinline__ float bf1(bf16_t v) { return __uint_as_float((unsigned)v << 16); }
__device__ __forceinline__ float wave_sum(float v) {
#pragma unroll
    for (int o = 1; o < 64; o <<= 1) v += __shfl_xor(v, o);
    return v;
}
__device__ __forceinline__ float fast_sigmoid(float x) { return __builtin_amdgcn_rcpf(1.0f + __builtin_amdgcn_exp2f(-1.4426950408889634f * x)); }
__device__ __forceinline__ u32x4 pack8(const f32x4& a, const f32x4& b) { u32x4 w; w.x = pk2(a[0], a[1]); w.y = pk2(a[2], a[3]); w.z = pk2(b[0], b[1]); w.w = pk2(b[2], b[3]); return w; }
__device__ __forceinline__ void unpack8(const u32x4& w, f32x4& a, f32x4& b) { a = (f32x4){bflo(w.x), bfhi(w.x), bflo(w.y), bfhi(w.y)}; b = (f32x4){bflo(w.z), bfhi(w.z), bflo(w.w), bfhi(w.w)}; }

struct EpiIn {
    static constexpr bool PERM = true, AFTER_DRAIN = false;
    bf16_t *zhy, *q, *k, *v, *sg; const f32x2* rope;
    __device__ __forceinline__ void operator()(const f32x4 (&acc)[2][2][4][2], const pg8::Unit& u, int wr, int wc, int fr, int fq) const {
        const int pn = u.pn;
#pragma unroll
        for (int ai = 0; ai < 2; ++ai)
#pragma unroll
            for (int m = 0; m < 4; ++m) {
                const int r = u.pm * 256 + ai * 128 + wr * 64 + m * 16 + fr; const int b = r >> 12, t = r & 4095;
#pragma unroll
                for (int bj = 0; bj < 2; ++bj) {
                    const int c = pn * 256 + bj * 128 + wc * 32 + fq * 8;
                    const f32x4 v0 = acc[ai][bj][m][0], v1 = acc[ai][bj][m][1];
                    if (pn < 6) {
                        bf16_t* dst = zhy + ((size_t)(b * 1536 + c) * 4096 + t);
                        const u32x4 w = pack8(v0, v1);
                        dst[0] = (bf16_t)(w.x & 0xffff); dst[4096] = (bf16_t)(w.x >> 16); dst[2 * 4096] = (bf16_t)(w.y & 0xffff); dst[3 * 4096] = (bf16_t)(w.y >> 16);
                        dst[4 * 4096] = (bf16_t)(w.z & 0xffff); dst[5 * 4096] = (bf16_t)(w.z >> 16); dst[6 * 4096] = (bf16_t)(w.w & 0xffff); dst[7 * 4096] = (bf16_t)(w.w >> 16);
                    } else if (pn < 10) {
                        const bool isq = pn < 8; const int cq = c - (isq ? 1536 : 2048);
                        const int h = cq >> 7, cc = (cq >> 6) & 1, d = cq & 63, axis = (cq >> 5) & 1;
                        const int pos = axis ? (t & 63) : (t >> 6);
                        const f32x4* rt = (const f32x4*)(rope + pos * 16 + (fq & 1) * 8);
                        const f32x4 t0 = rt[0], t1 = rt[1], t2 = rt[2], t3 = rt[3];
                        const float sgn = (fq < 2) ? -1.0f : 1.0f;
                        f32x4 p0, p1;
#pragma unroll
                        for (int e = 0; e < 4; ++e) { p0[e] = __shfl_xor(v0[e], 32); p1[e] = __shfl_xor(v1[e], 32); }
                        f32x4 o0, o1;
                        o0[0] = v0[0] * t0[0] + sgn * p0[0] * t0[1]; o0[1] = v0[1] * t0[2] + sgn * p0[1] * t0[3];
                        o0[2] = v0[2] * t1[0] + sgn * p0[2] * t1[1]; o0[3] = v0[3] * t1[2] + sgn * p0[3] * t1[3];
                        o1[0] = v1[0] * t2[0] + sgn * p1[0] * t2[1]; o1[1] = v1[1] * t2[2] + sgn * p1[1] * t2[3];
                        o1[2] = v1[2] * t3[0] + sgn * p1[2] * t3[1]; o1[3] = v1[3] * t3[2] + sgn * p1[3] * t3[3];
                        if (isq) { o0 = o0 * QSCALE; o1 = o1 * QSCALE; *(u32x4*)(q + ((size_t)((b * 4 + h) * 2 + cc) * SEQ + t) * 64 + d) = pack8(o0, o1); }
                        else *(u32x4*)(k + ((size_t)((b * 4 + h) * 2 + cc) * KV + CTX + t) * 64 + d) = pack8(o0, o1);
                    } else if (pn < 12) {
                        const int cv = c - 2560, h = cv >> 7, dv = cv & 127;
                        *(u32x4*)(v + ((size_t)(b * 4 + h) * KV + CTX + t) * 128 + dv) = pack8(v0, v1);
                    } else {
                        f32x4 s0, s1;
#pragma unroll
                        for (int e = 0; e < 4; ++e) { s0[e] = fast_sigmoid(v0[e]); s1[e] = fast_sigmoid(v1[e]); }
                        *(u32x4*)(sg + (size_t)r * 2048 + (c - 3072)) = pack8(s0, s1);
                    }
                }
            }
    }
};
struct EpiCtx {
    static constexpr bool PERM = true, AFTER_DRAIN = false;
    bf16_t *k, *v;
    __device__ __forceinline__ void operator()(const f32x4 (&acc)[2][2][4][2], const pg8::Unit& u, int wr, int wc, int fr, int fq) const {
        const int pn = u.pn;
#pragma unroll
        for (int ai = 0; ai < 2; ++ai)
#pragma unroll
            for (int m = 0; m < 4; ++m) {
                const int r = u.pm * 256 + ai * 128 + wr * 64 + m * 16 + fr; const int b = r >> 8, t = r & 255;
#pragma unroll
                for (int bj = 0; bj < 2; ++bj) {
                    const int c = pn * 256 + bj * 128 + wc * 32 + fq * 8;
                    const u32x4 w = pack8(acc[ai][bj][m][0], acc[ai][bj][m][1]);
                    if (pn < 2) { const int h = c >> 7, cc = (c >> 6) & 1, d = c & 63; *(u32x4*)(k + ((size_t)((b * 4 + h) * 2 + cc) * KV + t) * 64 + d) = w; }
                    else { const int cv = c - 512, h = cv >> 7, dv = cv & 127; *(u32x4*)(v + ((size_t)(b * 4 + h) * KV + t) * 128 + dv) = w; }
                }
            }
    }
};
template <bool ADD> struct EpiMerge {
    static constexpr bool PERM = true, AFTER_DRAIN = false;
    bf16_t* mb; const bf16_t* sg;
    __device__ __forceinline__ void operator()(const f32x4 (&acc)[2][2][4][2], const pg8::Unit& u, int wr, int wc, int fr, int fq) const {
#pragma unroll
        for (int ai = 0; ai < 2; ++ai)
#pragma unroll
            for (int m = 0; m < 4; ++m) {
                const int r = u.pm * 256 + ai * 128 + wr * 64 + m * 16 + fr;
#pragma unroll
                for (int bj = 0; bj < 2; ++bj) {
                    const int c = u.pn * 256 + bj * 128 + wc * 32 + fq * 8;
                    f32x4 g0, g1; unpack8(*(const u32x4*)(sg + (size_t)r * 2048 + (ADD ? 1024 : 0) + c), g0, g1);
                    f32x4 o0 = acc[ai][bj][m][0] * g0, o1 = acc[ai][bj][m][1] * g1;
                    bf16_t* dst = mb + (size_t)r * D + c;
                    if (ADD) { f32x4 p0, p1; unpack8(*(const u32x4*)dst, p0, p1); o0 = o0 + p0; o1 = o1 + p1; }
                    *(u32x4*)dst = pack8(o0, o1);
                }
            }
    }
};
struct EpiOut {
    static constexpr bool PERM = true, AFTER_DRAIN = false;
    const float *x, *st0, *lg, *lb, *mod; float* out;
    __device__ __forceinline__ void operator()(const f32x4 (&acc)[2][2][4][2], const pg8::Unit& u, int wr, int wc, int fr, int fq) const {
#pragma unroll
        for (int ai = 0; ai < 2; ++ai)
#pragma unroll
            for (int m = 0; m < 4; ++m) {
                const int r = u.pm * 256 + ai * 128 + wr * 64 + m * 16 + fr; const int b = r >> 12;
                const f32x2 st = *(const f32x2*)(st0 + 2 * r);
#pragma unroll
                for (int bj = 0; bj < 2; ++bj) {
                    const int c = u.pn * 256 + bj * 128 + wc * 32 + fq * 8;
#pragma unroll
                    for (int n = 0; n < 2; ++n) {
                        const f32x4 xv = *(const f32x4*)(x + (size_t)r * D + c + 4 * n);
                        const f32x4 g = *(const f32x4*)(lg + c + 4 * n), bb = *(const f32x4*)(lb + c + 4 * n);
                        const f32x4 g1 = *(const f32x4*)(mod + b * NADA + 2 * D + c + 4 * n);
                        const f32x4 xl = (xv - st.x) * st.y * g + bb;
                        *(f32x4*)(out + (size_t)r * D + c + 4 * n) = xl * DN_ALPHA + g1 * acc[ai][bj][m][n];
                    }
                }
            }
    }
};
struct EpiUp {
    static constexpr bool PERM = true, AFTER_DRAIN = false;
    bf16_t* ub;
    __device__ __forceinline__ void operator()(const f32x4 (&acc)[2][2][4][2], const pg8::Unit& u, int wr, int wc, int fr, int fq) const {
#pragma unroll
        for (int ai = 0; ai < 2; ++ai)
#pragma unroll
            for (int m = 0; m < 4; ++m) {
                const int r = u.pm * 256 + ai * 128 + wr * 64 + m * 16 + fr;
#pragma unroll
                for (int bj = 0; bj < 2; ++bj) {
                    const int c = u.pn * 256 + bj * 128 + wc * 32 + fq * 8;
                    *(u32x4*)(ub + (size_t)r * NUP + c) = pack8(acc[ai][bj][m][0], acc[ai][bj][m][1]);
                }
            }
    }
};
struct EpiDown {
    static constexpr bool PERM = true, AFTER_DRAIN = false;
    const float *st1, *lg, *lb, *mod; float* out;
    __device__ __forceinline__ void operator()(const f32x4 (&acc)[2][2][4][2], const pg8::Unit& u, int wr, int wc, int fr, int fq) const {
#pragma unroll
        for (int ai = 0; ai < 2; ++ai)
#pragma unroll
            for (int m = 0; m < 4; ++m) {
                const int r = u.pm * 256 + ai * 128 + wr * 64 + m * 16 + fr; const int b = r >> 12;
                const f32x2 st = *(const f32x2*)(st1 + 2 * r);
#pragma unroll
                for (int bj = 0; bj < 2; ++bj) {
                    const int c = u.pn * 256 + bj * 128 + wc * 32 + fq * 8;
#pragma unroll
                    for (int n = 0; n < 2; ++n) {
                        float* po = out + (size_t)r * D + c + 4 * n;
                        const f32x4 rv = *(const f32x4*)po;
                        const f32x4 g = *(const f32x4*)(lg + c + 4 * n), bb = *(const f32x4*)(lb + c + 4 * n);
                        const f32x4 g2 = *(const f32x4*)(mod + b * NADA + 5 * D + c + 4 * n);
                        const f32x4 x1 = (rv - st.x) * st.y * g + bb;
#if EN_FFN
                        *(f32x4*)po = x1 * DN_ALPHA + g2 * acc[ai][bj][m][n];
#else
                        *(f32x4*)po = x1 * DN_ALPHA;
#endif
                    }
                }
            }
    }
};

namespace att {
constexpr int STAGE = 32768, K1_OFF = 8192, V_OFF = 16384, NT = KV / 64;
__device__ __forceinline__ void stage_tile(LAS unsigned char* dst, const bf16_t* K0, const bf16_t* K1, const bf16_t* Vb, int key0, int wid, int lane) {
    __builtin_amdgcn_global_load_lds((const unsigned*)(K0 + (size_t)(key0 + lane) * 64 + wid * 8), (LAS unsigned*)(dst + wid * 1024), 16, 0, 0);
    __builtin_amdgcn_global_load_lds((const unsigned*)(K1 + (size_t)(key0 + lane) * 64 + wid * 8), (LAS unsigned*)(dst + K1_OFF + wid * 1024), 16, 0, 0);
#pragma unroll
    for (int i = 0; i < 2; ++i) {
        const int pv = wid + 8 * i, db = pv >> 2, kg = pv & 3;
        __builtin_amdgcn_global_load_lds((const unsigned*)(Vb + (size_t)(key0 + 16 * kg + (lane >> 2)) * 128 + db * 32 + (lane & 3) * 8), (LAS unsigned*)(dst + V_OFF + db * 4096 + kg * 1024), 16, 0, 0);
    }
}
__device__ __forceinline__ s16x4 vtr(const LAS unsigned char* p) {
    typedef short v4i16_t __attribute__((ext_vector_type(4)));
    return __builtin_bit_cast(s16x4, __builtin_amdgcn_ds_read_tr16_b64_v4i16((LAS v4i16_t*)p));
}
__device__ __forceinline__ void attn_unit(int b, int h, int qb, const bf16_t* Q, const bf16_t* Kg, const bf16_t* Vg, bf16_t* On, float lam, const float* subln, LAS unsigned char* lds) {
    const int tid = tid_fresh(), lane = tid & 63, r32 = lane & 31, hi = lane >> 5;
    const int wid = __builtin_amdgcn_readfirstlane(tid >> 6), comp = wid >> 2, wq = wid & 3;
    const int t0 = qb * 128 + wq * 32;
    const bf16_t* Qp = Q + ((size_t)((b * 4 + h) * 2 + comp) * SEQ + t0 + r32) * 64;
    bf16x8 qr[4];
#pragma unroll
    for (int d0 = 0; d0 < 4; ++d0) qr[d0] = *(const bf16x8*)(Qp + d0 * 16 + hi * 8);
    const bf16_t* K0 = Kg + (size_t)((b * 4 + h) * 2) * KV * 64; const bf16_t* K1 = K0 + (size_t)KV * 64;
    const bf16_t* Vb = Vg + (size_t)(b * 4 + h) * KV * 128;
    f32x16 o[4];
#pragma unroll
    for (int i = 0; i < 4; ++i)
#pragma unroll
        for (int r = 0; r < 16; ++r) o[i][r] = 0.f;
    float mrun = -1e30f, lrun = 0.f;
    const int vlane = ((lane >> 4) & 1) * 32 + (lane & 3) * 8 + (4 * hi + ((lane & 15) >> 2)) * 64;
    stage_tile(lds, K0, K1, Vb, 0, wid, lane);
    for (int t = 0; t < NT; ++t) {
        __syncthreads();
        if (t + 1 < NT) stage_tile(lds + ((t + 1) & 1) * STAGE, K0, K1, Vb, (t + 1) * 64, wid, lane);
        const LAS unsigned char* sb = lds + (t & 1) * STAGE;
        const LAS unsigned char* Ks = sb + (comp ? K1_OFF : 0);
        f32x16 p0, p1;
#pragma unroll
        for (int r = 0; r < 16; ++r) { p0[r] = 0.f; p1[r] = 0.f; }
#pragma unroll
        for (int d0 = 0; d0 < 4; ++d0) {
            const bf16x8 ka = *(const LAS bf16x8*)(Ks + (2 * d0 + hi) * 1024 + r32 * 16);
            const bf16x8 kb = *(const LAS bf16x8*)(Ks + (2 * d0 + hi) * 1024 + 512 + r32 * 16);
            p0 = __builtin_amdgcn_mfma_f32_32x32x16_bf16(ka, qr[d0], p0, 0, 0, 0);
            p1 = __builtin_amdgcn_mfma_f32_32x32x16_bf16(kb, qr[d0], p1, 0, 0, 0);
        }
        float mx = fmaxf(p0[0], p1[0]);
#pragma unroll
        for (int r = 1; r < 16; ++r) mx = fmaxf(mx, fmaxf(p0[r], p1[r]));
        mx = fmaxf(mx, __shfl_xor(mx, 32));
        const float mnew = fmaxf(mrun, mx); const float alpha = __builtin_amdgcn_exp2f(mrun - mnew); mrun = mnew;
        float ls = 0.f;
#pragma unroll
        for (int r = 0; r < 16; ++r) { p0[r] = __builtin_amdgcn_exp2f(p0[r] - mnew); p1[r] = __builtin_amdgcn_exp2f(p1[r] - mnew); ls += p0[r] + p1[r]; }
        lrun = lrun * alpha + ls;
#pragma unroll
        for (int i = 0; i < 4; ++i)
#pragma unroll
            for (int r = 0; r < 16; ++r) o[i][r] *= alpha;
        bf16x8 pf[4];
        { u32x4 w;
          w.x = pk2(p0[0], p0[1]); w.y = pk2(p0[2], p0[3]); w.z = pk2(p0[4], p0[5]); w.w = pk2(p0[6], p0[7]); pf[0] = __builtin_bit_cast(bf16x8, w);
          w.x = pk2(p0[8], p0[9]); w.y = pk2(p0[10], p0[11]); w.z = pk2(p0[12], p0[13]); w.w = pk2(p0[14], p0[15]); pf[1] = __builtin_bit_cast(bf16x8, w);
          w.x = pk2(p1[0], p1[1]); w.y = pk2(p1[2], p1[3]); w.z = pk2(p1[4], p1[5]); w.w = pk2(p1[6], p1[7]); pf[2] = __builtin_bit_cast(bf16x8, w);
          w.x = pk2(p1[8], p1[9]); w.y = pk2(p1[10], p1[11]); w.z = pk2(p1[12], p1[13]); w.w = pk2(p1[14], p1[15]); pf[3] = __builtin_bit_cast(bf16x8, w); }
        const LAS unsigned char* Vs = sb + V_OFF + vlane;
#pragma unroll
        for (int blk = 0; blk < 4; ++blk)
#pragma unroll
            for (int ks = 0; ks < 4; ++ks) {
                const s16x4 lo = vtr(Vs + blk * 4096 + ks * 1024), hh = vtr(Vs + blk * 4096 + ks * 1024 + 512);
                const bf16x8 vf = (bf16x8){lo[0], lo[1], lo[2], lo[3], hh[0], hh[1], hh[2], hh[3]};
                o[blk] = __builtin_amdgcn_mfma_f32_32x32x16_bf16(vf, pf[ks], o[blk], 0, 0, 0);
            }
    }
    lrun += __shfl_xor(lrun, 32);
    const float inv = 1.0f / lrun;
    __syncthreads();
    LAS float* ex = (LAS float*)lds;
    if (comp == 1) {
#pragma unroll
        for (int i = 0; i < 4; ++i)
#pragma unroll
            for (int r = 0; r < 16; ++r) ex[(wq * 64 + i * 16 + r) * 64 + lane] = o[i][r] * inv;
    }
    __syncthreads();
    if (comp == 0) {
        float ss = 0.f;
#pragma unroll
        for (int i = 0; i < 4; ++i)
#pragma unroll
            for (int r = 0; r < 16; ++r) { const float v = o[i][r] * inv - lam * ex[(wq * 64 + i * 16 + r) * 64 + lane]; o[i][r] = v; ss += v * v; }
        ss += __shfl_xor(ss, 32);
        const float rn = 1.0f / sqrtf(ss * (1.0f / 128.0f) + RMS_EPS) * (1.0f - LAM_INIT);
        bf16_t* dst = On + (size_t)(b * SEQ + t0 + r32) * 512 + h * 128;
#pragma unroll
        for (int i = 0; i < 4; ++i)
#pragma unroll
            for (int g = 0; g < 4; ++g) {
                const int d = 32 * i + 8 * g + 4 * hi;
                const f32x4 sg = *(const f32x4*)(subln + d);
                u32x2 w; w.x = pk2(o[i][4 * g] * rn * sg[0], o[i][4 * g + 1] * rn * sg[1]); w.y = pk2(o[i][4 * g + 2] * rn * sg[2], o[i][4 * g + 3] * rn * sg[3]);
                *(u32x2*)(dst + d) = w;
            }
    }
    __syncthreads();
}
}

namespace hy {
__device__ const float WC[16] = {1.0f, 0.98078528040323043f, 0.92387953251128674f, 0.83146961230254524f, 0.70710678118654757f, 0.55557023301960229f, 0.38268343236508984f, 0.19509032201612833f,
                                 0.0f, -0.19509032201612833f, -0.38268343236508984f, -0.55557023301960229f, -0.70710678118654757f, -0.83146961230254524f, -0.92387953251128674f, -0.98078528040323043f};
__device__ const float WS[16] = {0.0f, 0.19509032201612825f, 0.38268343236508978f, 0.55557023301960218f, 0.70710678118654746f, 0.83146961230254524f, 0.92387953251128674f, 0.98078528040323043f,
                                 1.0f, 0.98078528040323043f, 0.92387953251128674f, 0.83146961230254546f, 0.70710678118654757f, 0.55557023301960218f, 0.38268343236508989f, 0.19509032201612861f};
__device__ __forceinline__ int PX(int i) { return i + ((i >> 5) << 1); }
template <bool CONJ> __device__ __forceinline__ f32x2 cmulw(f32x2 a, float c, float s) {
    if (!CONJ) return (f32x2){a.x * c + a.y * s, a.y * c - a.x * s};
    return (f32x2){a.x * c - a.y * s, a.y * c + a.x * s};
}
template <int H, bool INV> __device__ __forceinline__ void pass16(LAS f32x2* X, const f32x2* TW, int tid) {
    constexpr int S = H / 8, MULT = 4096 / H;
    const int j0 = tid % S, blk = tid / S, base = blk * 2 * H + j0;
    f32x2 e[16];
#pragma unroll
    for (int r = 0; r < 16; ++r) e[r] = X[PX(base + r * S)];
    f32x2 w[4];
#pragma unroll
    for (int k = 0; k < 4; ++k) w[k] = TW[(j0 << k) * MULT];
    if (!INV) {
#pragma unroll
        for (int k = 0; k < 4; ++k) {
            const int hk = 8 >> k;
#pragma unroll
            for (int r = 0; r < 16; ++r) if (!(r & hk)) {
                const f32x2 a = e[r], bb = e[r + hk]; e[r] = a + bb; f32x2 d = a - bb;
                const int ci = (r % hk) << (k + 1);
                if (ci != 0) d = cmulw<false>(d, WC[ci], WS[ci]);
                e[r + hk] = cmulw<false>(d, w[k].x, w[k].y);
            }
        }
    } else {
#pragma unroll
        for (int k = 3; k >= 0; --k) {
            const int hk = 8 >> k;
#pragma unroll
            for (int r = 0; r < 16; ++r) if (!(r & hk)) {
                const f32x2 a = e[r]; f32x2 bb = cmulw<true>(e[r + hk], w[k].x, w[k].y);
                const int ci = (r % hk) << (k + 1);
                if (ci != 0) bb = cmulw<true>(bb, WC[ci], WS[ci]);
                e[r] = a + bb; e[r + hk] = a - bb;
            }
        }
    }
#pragma unroll
    for (int r = 0; r < 16; ++r) X[PX(base + r * S)] = e[r];
}
template <bool FILT> __device__ __forceinline__ void pass32(LAS f32x2* X, f32x2* Kout, const f32x2* Kin, int tid) {
    if (tid < 256) {
        f32x2 e[32];
        const LAS f32x4* xp = (const LAS f32x4*)(X + PX(32 * tid));
#pragma unroll
        for (int i = 0; i < 16; ++i) { const f32x4 v = xp[i]; e[2 * i] = (f32x2){v[0], v[1]}; e[2 * i + 1] = (f32x2){v[2], v[3]}; }
#pragma unroll
        for (int k = 0; k < 5; ++k) {
            const int hk = 16 >> k;
#pragma unroll
            for (int r = 0; r < 32; ++r) if (!(r & hk)) {
                const f32x2 a = e[r], bb = e[r + hk]; e[r] = a + bb; f32x2 d = a - bb;
                const int ci = (r % hk) << k;
                if (ci != 0) d = cmulw<false>(d, WC[ci], WS[ci]);
                e[r + hk] = d;
            }
        }
        if (FILT) {
            f32x4* kp = (f32x4*)(Kout + 32 * tid);
#pragma unroll
            for (int i = 0; i < 16; ++i) kp[i] = (f32x4){e[2 * i].x, e[2 * i].y, e[2 * i + 1].x, e[2 * i + 1].y};
        } else {
            const f32x4* kp = (const f32x4*)(Kin + 32 * tid);
#pragma unroll
            for (int i = 0; i < 16; ++i) {
                const f32x4 kv = kp[i];
                e[2 * i] = (f32x2){e[2 * i].x * kv[0] - e[2 * i].y * kv[1], e[2 * i].x * kv[1] + e[2 * i].y * kv[0]};
                e[2 * i + 1] = (f32x2){e[2 * i + 1].x * kv[2] - e[2 * i + 1].y * kv[3], e[2 * i + 1].x * kv[3] + e[2 * i + 1].y * kv[2]};
            }
#pragma unroll
            for (int k = 4; k >= 0; --k) {
                const int hk = 16 >> k;
#pragma unroll
                for (int r = 0; r < 32; ++r) if (!(r & hk)) {
                    const f32x2 a = e[r]; f32x2 bb = e[r + hk];
                    const int ci = (r % hk) << k;
                    if (ci != 0) bb = cmulw<true>(bb, WC[ci], WS[ci]);
                    e[r] = a + bb; e[r + hk] = a - bb;
                }
            }
            LAS f32x4* xo = (LAS f32x4*)(X + PX(32 * tid));
#pragma unroll
            for (int i = 0; i < 16; ++i) xo[i] = (f32x4){e[2 * i].x, e[2 * i].y, e[2 * i + 1].x, e[2 * i + 1].y};
        }
    }
}
__device__ __forceinline__ void conv_fft(LAS f32x2* X, const f32x2* TW, const f32x2* Ks, int tid) {
    __syncthreads(); pass16<4096, false>(X, TW, tid);
    __syncthreads(); pass16<256, false>(X, TW, tid);
    __syncthreads(); pass32<false>(X, nullptr, Ks, tid);
    __syncthreads(); pass16<256, true>(X, TW, tid);
    __syncthreads(); pass16<4096, true>(X, TW, tid);
    __syncthreads();
}
__device__ __forceinline__ void conv3_load(const bf16_t* zrow, float w0, float w1, float w2, float bias, int tid, float (&out)[8]) {
    const u32x4 raw = *(const u32x4*)(zrow + 8 * tid);
    float z[10];
    z[0] = tid > 0 ? bf1(zrow[8 * tid - 1]) : 0.f; z[9] = tid < 511 ? bf1(zrow[8 * tid + 8]) : 0.f;
    z[1] = bflo(raw.x); z[2] = bfhi(raw.x); z[3] = bflo(raw.y); z[4] = bfhi(raw.y); z[5] = bflo(raw.z); z[6] = bfhi(raw.z); z[7] = bflo(raw.w); z[8] = bfhi(raw.w);
#pragma unroll
    for (int i = 0; i < 8; ++i) out[i] = w0 * z[i] + w1 * z[i + 1] + w2 * z[i + 2] + bias;
}
__device__ __forceinline__ void put8(LAS f32x2* X, int tid, const float (&a)[8], const float (&b)[8]) {
    LAS f32x4* lo = (LAS f32x4*)(X + PX(8 * tid)); LAS f32x4* up = (LAS f32x4*)(X + PX(4096 + 8 * tid));
#pragma unroll
    for (int i = 0; i < 4; ++i) { lo[i] = (f32x4){a[2 * i], b[2 * i], a[2 * i + 1], b[2 * i + 1]}; up[i] = (f32x4){0.f, 0.f, 0.f, 0.f}; }
}
__device__ __forceinline__ void get8(const LAS f32x2* X, int tid, float (&a)[8], float (&b)[8]) {
    const LAS f32x4* lo = (const LAS f32x4*)(X + PX(8 * tid));
#pragma unroll
    for (int i = 0; i < 4; ++i) { const f32x4 v = lo[i]; a[2 * i] = v[0] * (1.0f / 8192.0f); b[2 * i] = v[1] * (1.0f / 8192.0f); a[2 * i + 1] = v[2] * (1.0f / 8192.0f); b[2 * i + 1] = v[3] * (1.0f / 8192.0f); }
}
__device__ __forceinline__ void hyena_unit(int c, int bp, const bf16_t* zhy, const float* cw, const float* cb, const float* hbias, const f32x2* kspec, const f32x2* TW, bf16_t* yht, LAS f32x2* X) {
    const int tid = tid_fresh(); const int b0 = 2 * bp, b1 = b0 + 1;
    float va[8], vb[8];
    { const float w0 = cw[c], w1 = cw[1536 + c], w2 = cw[3072 + c], bs = cb[c];
      conv3_load(zhy + (size_t)(b0 * 1536 + c) * 4096, w0, w1, w2, bs, tid, va);
      conv3_load(zhy + (size_t)(b1 * 1536 + c) * 4096, w0, w1, w2, bs, tid, vb); }
    put8(X, tid, va, vb);
    conv_fft(X, TW, kspec + (size_t)c * 8192, tid);
    float ca[8], cbv[8]; get8(X, tid, ca, cbv);
    float za[8], zb[8];
    { const int c1 = 512 + c; const float w0 = cw[c1], w1 = cw[1536 + c1], w2 = cw[3072 + c1], bs = cb[c1], hb = hbias[c];
      float xa[8], xb[8];
      conv3_load(zhy + (size_t)(b0 * 1536 + c1) * 4096, w0, w1, w2, bs, tid, xa);
      conv3_load(zhy + (size_t)(b1 * 1536 + c1) * 4096, w0, w1, w2, bs, tid, xb);
#pragma unroll
      for (int i = 0; i < 8; ++i) { za[i] = xa[i] * (ca[i] + va[i] * hb); zb[i] = xb[i] * (cbv[i] + vb[i] * hb); } }
    put8(X, tid, za, zb);
    conv_fft(X, TW, kspec + (size_t)(512 + c) * 8192, tid);
    get8(X, tid, ca, cbv);
    { const int c2 = 1024 + c; const float w0 = cw[c2], w1 = cw[1536 + c2], w2 = cw[3072 + c2], bs = cb[c2], hb = hbias[512 + c];
      float xa[8], xb[8];
      conv3_load(zhy + (size_t)(b0 * 1536 + c2) * 4096, w0, w1, w2, bs, tid, xa);
      conv3_load(zhy + (size_t)(b1 * 1536 + c2) * 4096, w0, w1, w2, bs, tid, xb);
      u32x4 wa, wb;
      wa.x = pk2(xa[0] * (ca[0] + za[0] * hb), xa[1] * (ca[1] + za[1] * hb)); wa.y = pk2(xa[2] * (ca[2] + za[2] * hb), xa[3] * (ca[3] + za[3] * hb));
      wa.z = pk2(xa[4] * (ca[4] + za[4] * hb), xa[5] * (ca[5] + za[5] * hb)); wa.w = pk2(xa[6] * (ca[6] + za[6] * hb), xa[7] * (ca[7] + za[7] * hb));
      wb.x = pk2(xb[0] * (cbv[0] + zb[0] * hb), xb[1] * (cbv[1] + zb[1] * hb)); wb.y = pk2(xb[2] * (cbv[2] + zb[2] * hb), xb[3] * (cbv[3] + zb[3] * hb));
      wb.z = pk2(xb[4] * (cbv[4] + zb[4] * hb), xb[5] * (cbv[5] + zb[5] * hb)); wb.w = pk2(xb[6] * (cbv[6] + zb[6] * hb), xb[7] * (cbv[7] + zb[7] * hb));
      *(u32x4*)(yht + (size_t)(b0 * 512 + c) * 4096 + 8 * tid) = wa;
      *(u32x4*)(yht + (size_t)(b1 * 512 + c) * 4096 + 8 * tid) = wb; }
    __syncthreads();
}
}

__device__ __forceinline__ void transpose_item(const float* W, int K, int N, bf16_t* WT, LAS float* scr, int item, int lane) {
    const int nblk = N / 32, kb = item / nblk, nb = item % nblk, k0 = 64 * kb, n0 = 32 * nb;
#pragma unroll 8
    for (int i = 0; i < 32; ++i) { const int kk = 2 * i + (lane >> 5); scr[kk * 33 + (lane & 31)] = W[(size_t)(k0 + kk) * N + n0 + (lane & 31)]; }
    asm volatile("s_waitcnt lgkmcnt(0)" ::: "memory");
    const int c = lane & 7;
#pragma unroll
    for (int j = 0; j < 4; ++j) { const int n = (lane >> 3) + 8 * j; const LAS float* s = scr + (8 * c) * 33 + n;
        u32x4 o; o.x = pk2(s[0 * 33], s[1 * 33]); o.y = pk2(s[2 * 33], s[3 * 33]); o.z = pk2(s[4 * 33], s[5 * 33]); o.w = pk2(s[6 * 33], s[7 * 33]);
        *(u32x4*)(WT + (size_t)(n0 + n) * K + k0 + 8 * c) = o; }
    asm volatile("s_waitcnt lgkmcnt(0)" ::: "memory");
}
__device__ __forceinline__ void ln_row(const float* xrow, const float* g, const float* bb, int lane, f32x4 (&v)[4], float& mean, float& rstd) {
    const f32x4* xr = (const f32x4*)xrow + lane; float s = 0.f;
#pragma unroll
    for (int j = 0; j < 4; ++j) { v[j] = xr[64 * j]; s += (v[j][0] + v[j][1]) + (v[j][2] + v[j][3]); }
    mean = wave_sum(s) * (1.f / D); float s2 = 0.f;
#pragma unroll
    for (int j = 0; j < 4; ++j) { v[j] = v[j] - mean; s2 += (v[j][0] * v[j][0] + v[j][1] * v[j][1]) + (v[j][2] * v[j][2] + v[j][3] * v[j][3]); }
    rstd = 1.f / sqrtf(wave_sum(s2) * (1.f / D) + LN_EPS);
#pragma unroll
    for (int j = 0; j < 4; ++j) { const f32x4 gg = ((const f32x4*)g)[64 * j + lane], b4 = ((const f32x4*)bb)[64 * j + lane]; v[j] = v[j] * rstd * gg + b4; }
}

struct Params { const float* in[36]; float* out; unsigned char* ws; };
typedef const __attribute__((address_space(4))) Params* KPtr;
__device__ __forceinline__ KPtr kargs() { KPtr k = (KPtr)__builtin_amdgcn_kernarg_segment_ptr(); asm volatile("" : "+s"(k)); return k; }
#define WSP(T, off) ((T*)(kp->ws + (off)))
#define TIDS() const int tid = tid_fresh(), lane = tid & 63, wave = __builtin_amdgcn_readfirstlane(tid >> 6); const int gw = vcu * 8 + wave; (void)lane; (void)gw

__global__ void __launch_bounds__(512, 2) fwd_kernel(Params p) {
    extern __shared__ __attribute__((aligned(16))) unsigned char lds_raw[];
    LAS unsigned char* lds = (LAS unsigned char*)lds_raw;
    cg::grid_group grid = cg::this_grid();
    const int bx = blockIdx.x, G = gridDim.x;
    const int vcu = (G % 8 == 0) ? (bx % 8) * (G / 8) + bx / 8 : bx;
    const int NGW = G * 8;
    if (PH(0)) {
        KPtr kp = kargs();
        TIDS();
        f32x2* rope = WSP(f32x2, WS_ROPE); f32x2* TW = WSP(f32x2, WS_TW); float* modp = WSP(float, WS_MODP); float* FILT = WSP(float, WS_FILT);
        LAS float* SC = (LAS float*)lds;
        for (int i = tid; i < 9 * 1024; i += 512) { const float cv = i < 8192 ? kp->in[1][i] : kp->in[3][i - 8192]; SC[i] = cv * fast_sigmoid(cv); }
        { const int gt = bx * 512 + tid;
          if (gt < 4096) { float sn, cs; sincospif((float)gt * (1.0f / 4096.0f), &sn, &cs); TW[gt] = (f32x2){cs, sn}; }
          else if (gt < 5120) { const int e = gt - 4096, pos = e >> 4, j = e & 15; const float inv = powf(10000.0f, -(float)(2 * j) / 32.0f); const float ang = (float)pos * inv; rope[e] = (f32x2){cosf(ang), sinf(ang)}; } }
        {
            LAS float* zf = (LAS float*)(lds + 40960);
            LAS float* hA = zf + 16 * 33 + 16;
            LAS float* hB = hA + 1024;
            const int t0 = 16 * bx;
            for (int idx = tid; idx < 16 * 33; idx += 512) {
                const int pp = idx / 33, i = idx % 33, t = t0 + pp; float val;
                if (i == 0) val = (float)t / 4095.0f;
                else { const int band = (i - 1) & 15; const float fv = 1e-4f + (float)band * ((15.0f - 1e-4f) / 15.0f); const float wv = (6.283185307179586f / 4096.0f) * (float)t; const float arg = fv * wv; val = (i <= 16) ? cosf(arg) : -sinf(arg); }
                zf[idx] = val;
            }
            __syncthreads();
            const float *w1 = kp->in[11], *b1 = kp->in[12], *w2 = kp->in[13], *b2 = kp->in[14], *w3 = kp->in[15], *b3 = kp->in[16], *fq = kp->in[17], *wout = kp->in[18];
            for (int idx = tid; idx < 1024; idx += 512) { const int f = idx & 63, pp = idx >> 6; float s = b1[f];
                for (int i = 0; i < 33; ++i) s += zf[pp * 33 + i] * w1[i * 64 + f];
                hA[f * 16 + pp] = sinf(fq[f] * s); }
            __syncthreads();
            for (int idx = tid; idx < 1024; idx += 512) { const int f = idx & 63, pp = idx >> 6; float s = b2[f];
                for (int k = 0; k < 64; ++k) s += hA[k * 16 + pp] * w2[k * 64 + f];
                hB[f * 16 + pp] = sinf(fq[64 + f] * s); }
            __syncthreads();
            for (int idx = tid; idx < 1024; idx += 512) { const int f = idx & 63, pp = idx >> 6; float s = b3[f];
                for (int k = 0; k < 64; ++k) s += hB[k * 16 + pp] * w3[k * 64 + f];
                hA[f * 16 + pp] = sinf(fq[128 + f] * s); }
            __syncthreads();
            for (int q = 0; q < 4; ++q) {
                const int n = wave * 256 + q * 64 + lane;
                f32x4 a0 = {0.f, 0.f, 0.f, 0.f}, a1 = a0, a2 = a0, a3 = a0;
#pragma unroll 4
                for (int k = 0; k < 64; ++k) { const float w = wout[k * 2048 + n]; const LAS f32x4* hp = (const LAS f32x4*)(hA + k * 16);
                    a0 += hp[0] * w; a1 += hp[1] * w; a2 += hp[2] * w; a3 += hp[3] * w; }
                const int cch = n & 511; const float mind = -3.0701134573253945f, maxd = -15.350567286626973f;
                const float delta = fabsf(mind + (float)cch * ((maxd - mind) / 511.0f));
                f32x4 dc[4];
#pragma unroll
                for (int g4 = 0; g4 < 4; ++g4)
#pragma unroll
                    for (int e = 0; e < 4; ++e) dc[g4][e] = expf(-((float)(t0 + 4 * g4 + e) / 4095.0f) * delta);
                f32x4* dst = (f32x4*)(FILT + (size_t)n * 4096 + t0);
                dst[0] = a0 * dc[0]; dst[1] = a1 * dc[1]; dst[2] = a2 * dc[2]; dst[3] = a3 * dc[3];
            }
        }
        if (wave < 3) {
            const int item = bx * 3 + wave; const int kc = item / 96, nb = item % 96, n = nb * 64 + lane;
            const float* wa = kp->in[6];
            float acc[9];
#pragma unroll
            for (int i = 0; i < 9; ++i) acc[i] = 0.f;
#pragma unroll 4
            for (int k = kc * 128; k < kc * 128 + 128; ++k) { const float w = wa[(size_t)k * NADA + n];
#pragma unroll
                for (int i = 0; i < 9; ++i) acc[i] += SC[i * 1024 + k] * w; }
#pragma unroll
            for (int i = 0; i < 9; ++i) modp[(size_t)(kc * 9 + i) * NADA + n] = acc[i];
        }
        {
            LAS float* scr = (LAS float*)(lds + 65536 + wave * 8448);
            constexpr int I_IN = 16 * 160, I_HY = 8 * 32, I_AT = 8 * 32, I_OUT = 16 * 32, I_UP = 16 * 176, I_DN = 44 * 32;
            constexpr int NIT = I_IN + I_HY + I_AT + I_OUT + I_UP + I_DN;
            for (int it = gw; it < NIT; it += NGW) {
                int r = it;
                if (r < I_IN) { transpose_item(kp->in[8], 1024, INC, WSP(bf16_t, WS_WIN), scr, r, lane); continue; } r -= I_IN;
                if (r < I_HY) { transpose_item(kp->in[25], 512, 1024, WSP(bf16_t, WS_WHY), scr, r, lane); continue; } r -= I_HY;
                if (r < I_AT) { transpose_item(kp->in[26], 512, 1024, WSP(bf16_t, WS_WAT), scr, r, lane); continue; } r -= I_AT;
                if (r < I_OUT) { transpose_item(kp->in[27], 1024, 1024, WSP(bf16_t, WS_WOUT), scr, r, lane); continue; } r -= I_OUT;
                if (r < I_UP) { transpose_item(kp->in[30], 1024, NUP, WSP(bf16_t, WS_WUP), scr, r, lane); continue; } r -= I_UP;
                transpose_item(kp->in[33], DFF, 1024, WSP(bf16_t, WS_WDN), scr, r, lane);
            }
        }
    }
    grid.sync();

    if (PH(1)) {
        KPtr kp = kargs();
        TIDS();
        const float* x = kp->in[0]; const float* ctx = kp->in[2]; const float *ln_in_g = kp->in[4], *ln_in_b = kp->in[5];
        float* st0 = WSP(float, WS_ST0); float* mod = WSP(float, WS_MOD); const float* modp = WSP(float, WS_MODP); bf16_t *XM = WSP(bf16_t, WS_XM), *CTXM = WSP(bf16_t, WS_CTXM);
        const f32x2* TW = WSP(f32x2, WS_TW); const float* FILT = WSP(float, WS_FILT); f32x2* KSPEC = WSP(f32x2, WS_KSPEC);
        LAS float* SH = (LAS float*)(lds + 73728);
        const int b = bx >> 5;
        const float* bada = kp->in[7];
        for (int j = tid; j < 4096; j += 512) { const int row = j < 2048 ? b : 8, col = j & 2047; float s = bada[col];
#pragma unroll
            for (int kc = 0; kc < 8; ++kc) s += modp[(size_t)(kc * 9 + row) * NADA + col];
            SH[j] = s; }
        if (bx < 9) for (int j = tid; j < NADA; j += 512) { float s = bada[j];
#pragma unroll
            for (int kc = 0; kc < 8; ++kc) s += modp[(size_t)(kc * 9 + bx) * NADA + j];
            mod[bx * NADA + j] = s; }
        __syncthreads();
        for (int i = 0; i < 17; ++i) {
            const bool isctx = (i == 16); const int r = isctx ? (bx * 8 + wave) : (bx * 128 + i * 8 + wave);
            f32x4 v[4]; float mean, rstd;
            ln_row((isctx ? ctx : x) + (size_t)r * D, ln_in_g, ln_in_b, lane, v, mean, rstd);
            if (!isctx && lane == 0) *(f32x2*)(st0 + 2 * r) = (f32x2){mean, rstd};
            const LAS float* sh = SH + (isctx ? 2048 : 0);
            bf16_t* dst = (isctx ? CTXM : XM) + (size_t)r * D;
#pragma unroll
            for (int j = 0; j < 4; ++j) { const int col = 256 * j + 4 * lane;
                const f32x4 s4 = *(const LAS f32x4*)(sh + col), c4 = *(const LAS f32x4*)(sh + 1024 + col);
                const f32x4 o = v[j] * (c4 + 1.0f) + s4;
                u32x2 w; w.x = pk2(o[0], o[1]); w.y = pk2(o[2], o[3]); *(u32x2*)(dst + col) = w; }
        }
#if EN_HY
        LAS f32x2* X = (LAS f32x2*)lds;
        for (int i = 0; i < 4; ++i) {
            const int fid = 4 * bx + i, order = fid >> 9, c = fid & 511;
            const float* fwd = FILT + (size_t)(order * 1024 + c) * 4096; const float* bwd = fwd + (size_t)512 * 4096;
            __syncthreads();
#pragma unroll 4
            for (int r = 0; r < 16; ++r) { const int idx = tid + 512 * r; float val;
                if (idx < 4096) val = fwd[idx]; else if (idx == 4096) val = 0.f; else val = bwd[8192 - idx];
                X[hy::PX(idx)] = (f32x2){val, 0.f}; }
            __syncthreads(); hy::pass16<4096, false>(X, TW, tid);
            __syncthreads(); hy::pass16<256, false>(X, TW, tid);
            __syncthreads(); hy::pass32<true>(X, KSPEC + (size_t)fid * 8192, nullptr, tid);
        }
#endif
    }
    grid.sync();

    if (PH(2)) {
        KPtr kp = kargs();
        pg8::Gemm g{WSP(bf16_t, WS_XM), WSP(bf16_t, WS_WIN), MROWS, INC, D}; pg8::StaticOrder S; S.init(MROWS, INC, G, bx);
        EpiIn E{WSP(bf16_t, WS_ZHY), WSP(bf16_t, WS_Q), WSP(bf16_t, WS_K), WSP(bf16_t, WS_V), WSP(bf16_t, WS_SG), WSP(f32x2, WS_ROPE)};
        pg8::gemm_phase<EpiIn, pg8::StaticOrder, true, true>(lds, g, S, E);
    }
    if (PH(2)) {
        KPtr kp = kargs();
        pg8::Gemm g{WSP(bf16_t, WS_CTXM), WSP(bf16_t, WS_WIN) + (size_t)2048 * D, MCTX, 1024, D}; pg8::StaticOrder S; S.init(MCTX, 1024, G, bx);
        EpiCtx E{WSP(bf16_t, WS_K), WSP(bf16_t, WS_V)};
        pg8::gemm_phase<EpiCtx, pg8::StaticOrder, true, true>(lds, g, S, E);
    }
    grid.sync();

    if (PH(3)) {
        KPtr kp = kargs();
        TIDS();
#if EN_ATT
        float lam;
        { const float a = kp->in[20][lane] * kp->in[21][lane], bq = kp->in[22][lane] * kp->in[23][lane]; lam = expf(wave_sum(a)) - expf(wave_sum(bq)) + LAM_INIT; }
        for (int i = 0; i < 4; ++i) { const int unit = vcu * 4 + i; if (unit < 1024) att::attn_unit(unit >> 7, (unit >> 5) & 3, unit & 31, WSP(bf16_t, WS_Q), WSP(bf16_t, WS_K), WSP(bf16_t, WS_V), WSP(bf16_t, WS_ON), lam, kp->in[24], lds); }
#else
        for (size_t i = (size_t)bx * 512 + tid; i < (size_t)MROWS * 512 / 8; i += (size_t)G * 512) (WSP(u32x4, WS_ON))[i] = (u32x4){0u, 0u, 0u, 0u};
#endif
#if EN_HY
        for (int i = 0; i < 8; ++i) { const int unit = vcu * 8 + i; if (unit < 2048) hy::hyena_unit(unit >> 2, unit & 3, WSP(bf16_t, WS_ZHY), kp->in[9], kp->in[10], kp->in[19], WSP(f32x2, WS_KSPEC), WSP(f32x2, WS_TW), WSP(bf16_t, WS_YHT), (LAS f32x2*)lds); }
#endif
    }
    grid.sync();

    if (PH(4)) {
        KPtr kp = kargs();
        TIDS();
        const bf16_t* YHT = WSP(bf16_t, WS_YHT); bf16_t* YH = WSP(bf16_t, WS_YH);
#if EN_HY
        LAS bf16_t* scr = (LAS bf16_t*)(lds + wave * 8448);
        for (int tile = gw; tile < 4096; tile += NGW) {
            const int b = tile >> 9, cb = (tile >> 6) & 7, tb = tile & 63;
            const bf16_t* src = YHT + (size_t)(b * 512 + cb * 64) * 4096 + tb * 64;
            for (int i = 0; i < 64; ++i) scr[i * 66 + lane] = src[(size_t)i * 4096 + lane];
            asm volatile("s_waitcnt lgkmcnt(0)" ::: "memory");
            bf16_t* dst = YH + (size_t)(b * 4096 + tb * 64) * 512 + cb * 64;
            for (int j = 0; j < 64; ++j) dst[(size_t)j * 512 + lane] = scr[lane * 66 + j];
            asm volatile("s_waitcnt lgkmcnt(0)" ::: "memory");
        }
#else
        for (size_t i = (size_t)bx * 512 + tid; i < (size_t)MROWS * 512 / 8; i += (size_t)G * 512) ((u32x4*)YH)[i] = (u32x4){0u, 0u, 0u, 0u};
#endif
    }
    grid.sync();

    if (PH(5)) {
        KPtr kp = kargs();
        pg8::Gemm g{WSP(bf16_t, WS_YH), WSP(bf16_t, WS_WHY), MROWS, D, 512}; pg8::StaticOrder S; S.init(MROWS, D, G, bx);
        EpiMerge<false> E{WSP(bf16_t, WS_MBUF), WSP(bf16_t, WS_SG)};
        pg8::gemm_phase<EpiMerge<false>, pg8::StaticOrder, true, true>(lds, g, S, E);
    }
    asm volatile("s_waitcnt vmcnt(0)" ::: "memory"); __syncthreads();
    if (PH(5)) {
        KPtr kp = kargs();
        pg8::Gemm g{WSP(bf16_t, WS_ON), WSP(bf16_t, WS_WAT), MROWS, D, 512}; pg8::StaticOrder S; S.init(MROWS, D, G, bx);
        EpiMerge<true> E{WSP(bf16_t, WS_MBUF), WSP(bf16_t, WS_SG)};
        pg8::gemm_phase<EpiMerge<true>, pg8::StaticOrder, true, true>(lds, g, S, E);
    }
    grid.sync();

    if (PH(6)) {
        KPtr kp = kargs();
        pg8::Gemm g{WSP(bf16_t, WS_MBUF), WSP(bf16_t, WS_WOUT), MROWS, D, D}; pg8::StaticOrder S; S.init(MROWS, D, G, bx);
        EpiOut E{kp->in[0], WSP(float, WS_ST0), kp->in[4], kp->in[5], WSP(float, WS_MOD), kp->out};
        pg8::gemm_phase<EpiOut, pg8::StaticOrder, true, true>(lds, g, S, E);
    }
    grid.sync();

    if (PH(7)) { KPtr kp = kargs(); TIDS(); float* st1 = WSP(float, WS_ST1); const float* mod = WSP(float, WS_MOD); bf16_t* HM = WSP(bf16_t, WS_HM); const float* outp = kp->out; const float *l1g = kp->in[28], *l1b = kp->in[29];
    for (int r = gw; r < MROWS; r += NGW) {
        f32x4 v[4]; float mean, rstd; const int b = r >> 12;
        ln_row(outp + (size_t)r * D, l1g, l1b, lane, v, mean, rstd);
        if (lane == 0) *(f32x2*)(st1 + 2 * r) = (f32x2){mean, rstd};
#pragma unroll
        for (int j = 0; j < 4; ++j) { const int col = 256 * j + 4 * lane;
            const f32x4 s4 = *(const f32x4*)(mod + b * NADA + 3 * D + col), c4 = *(const f32x4*)(mod + b * NADA + 4 * D + col);
            const f32x4 o = v[j] * (c4 + 1.0f) + s4;
            u32x2 w; w.x = pk2(o[0], o[1]); w.y = pk2(o[2], o[3]); *(u32x2*)(HM + (size_t)r * D + col) = w; }
    } }
    grid.sync();

    for (int hf = 0; hf < 2; ++hf) {
#if EN_FFN
        if (PH(8)) {
            KPtr kp = kargs();
            pg8::Gemm g{WSP(bf16_t, WS_HM) + (size_t)hf * 16384 * D, WSP(bf16_t, WS_WUP), 16384, NUP, D}; pg8::StaticOrder S; S.init(16384, NUP, G, bx);
            EpiUp E{WSP(bf16_t, WS_U)};
            pg8::gemm_phase<EpiUp, pg8::StaticOrder, true, true>(lds, g, S, E);
        }
        grid.sync();
        if (PH(9)) {
            KPtr kp = kargs(); TIDS(); const float* cw = kp->in[31]; const float* cb = kp->in[32]; const bf16_t* UB = WSP(bf16_t, WS_U); bf16_t* ACT = WSP(bf16_t, WS_ACT);
            for (int it = bx * 512 + tid; it < 1024 * 352; it += G * 512) {
                const int rc = it / 352, jg = it % 352, r0 = rc * 16, tt = r0 & 4095, ca = 8 * jg, cg_ = DFF + 8 * jg;
                f32x4 wA[3][2], wG[3][2], bA[2], bG[2];
#pragma unroll
                for (int j = 0; j < 3; ++j)
#pragma unroll
                    for (int n = 0; n < 2; ++n) { wA[j][n] = *(const f32x4*)(cw + j * NUP + ca + 4 * n); wG[j][n] = *(const f32x4*)(cw + j * NUP + cg_ + 4 * n); }
#pragma unroll
                for (int n = 0; n < 2; ++n) { bA[n] = *(const f32x4*)(cb + ca + 4 * n); bG[n] = *(const f32x4*)(cb + cg_ + 4 * n); }
                const bf16_t* ua = UB + (size_t)r0 * NUP + ca; const bf16_t* ug = UB + (size_t)r0 * NUP + cg_;
                f32x4 pA[2], cA[2], nA[2], pG[2], cG[2], nG[2];
                const f32x4 z4 = {0.f, 0.f, 0.f, 0.f};
                if (tt > 0) { unpack8(*(const u32x4*)(ua - NUP), pA[0], pA[1]); unpack8(*(const u32x4*)(ug - NUP), pG[0], pG[1]); } else { pA[0] = pA[1] = pG[0] = pG[1] = z4; }
                unpack8(*(const u32x4*)ua, cA[0], cA[1]); unpack8(*(const u32x4*)ug, cG[0], cG[1]);
                bf16_t* dst = ACT + (size_t)(hf * 16384 + r0) * DFF + ca;
                for (int i = 0; i < 16; ++i) {
                    if (tt + i < 4095) { unpack8(*(const u32x4*)(ua + (size_t)(i + 1) * NUP), nA[0], nA[1]); unpack8(*(const u32x4*)(ug + (size_t)(i + 1) * NUP), nG[0], nG[1]); } else { nA[0] = nA[1] = nG[0] = nG[1] = z4; }
                    f32x4 o[2];
#pragma unroll
                    for (int n = 0; n < 2; ++n) {
                        const f32x4 av = wA[0][n] * pA[n] + wA[1][n] * cA[n] + wA[2][n] * nA[n] + bA[n];
                        const f32x4 gv = wG[0][n] * pG[n] + wG[1][n] * cG[n] + wG[2][n] * nG[n] + bG[n];
#pragma unroll
                        for (int e = 0; e < 4; ++e) o[n][e] = gv[e] * fast_sigmoid(gv[e]) * av[e];
                        pA[n] = cA[n]; cA[n] = nA[n]; pG[n] = cG[n]; cG[n] = nG[n];
                    }
                    *(u32x4*)(dst + (size_t)i * DFF) = pack8(o[0], o[1]);
                }
            }
        }
        grid.sync();
#endif
    }

    if (PH(10)) {
        KPtr kp = kargs();
        pg8::Gemm g{WSP(bf16_t, WS_ACT), WSP(bf16_t, WS_WDN), MROWS, D, DFF}; pg8::StaticOrder S; S.init(MROWS, D, G, bx);
        EpiDown E{WSP(float, WS_ST1), kp->in[28], kp->in[29], WSP(float, WS_MOD), kp->out};
        pg8::gemm_phase<EpiDown, pg8::StaticOrder, true, true>(lds, g, S, E);
    }
    grid.sync();

    if (PH(11)) { KPtr kp = kargs(); TIDS(); float* outp = kp->out; const float *l2g = kp->in[34], *l2b = kp->in[35];
    for (int r = gw; r < MROWS; r += NGW) {
        f32x4 v[4]; float mean, rstd;
        ln_row(outp + (size_t)r * D, l2g, l2b, lane, v, mean, rstd);
        f32x4* o = (f32x4*)(outp + (size_t)r * D) + lane;
#pragma unroll
        for (int j = 0; j < 4; ++j) o[64 * j] = v[j];
    } }
}

extern "C" void kernel_launch(void* const* d_in, const int* in_sizes, int n_in, void* d_out, int out_size, void* d_ws, size_t ws_size, hipStream_t stream) {
    static int grid = 0;
    if (grid == 0) {
        if (n_in != 36 || out_size != MROWS * D || ws_size < WS_END) { fprintf(stderr, "kernel_launch: unexpected shapes (n_in %d out %d ws %zu)\n", n_in, out_size, ws_size); grid = -1; return; }
        int dev = 0, cus = 0, per_cu = 0;
        hipGetDevice(&dev); hipDeviceGetAttribute(&cus, hipDeviceAttributeMultiprocessorCount, dev);
        hipFuncSetAttribute((const void*)fwd_kernel, hipFuncAttributeMaxDynamicSharedMemorySize, LDS_BYTES);
        hipOccupancyMaxActiveBlocksPerMultiprocessor(&per_cu, (const void*)fwd_kernel, 512, LDS_BYTES);
        if (per_cu < 1) { fprintf(stderr, "kernel_launch: occupancy query returned %d\n", per_cu); per_cu = 1; }
        (void)hipGetLastError();
        grid = cus;
    }
    if (grid < 0) return;
    Params prm{};
    for (int i = 0; i < 36; ++i) prm.in[i] = (const float*)d_in[i];
    prm.out = (float*)d_out; prm.ws = (unsigned char*)d_ws;
    void* args[] = {&prm};
    hipError_t e = hipLaunchCooperativeKernel((const void*)fwd_kernel, dim3(grid), dim3(512), args, LDS_BYTES, stream);
    if (e != hipSuccess) fprintf(stderr, "cooperative launch failed: %s (grid %d)\n", hipGetErrorString(e), grid);
}
```

```cpp
#include <hip/hip_runtime.h>
#include <hip/hip_cooperative_groups.h>
#include <cstdio>
#include <cstdint>
namespace cg = cooperative_groups;
namespace pg8 {
#define PG8_LAS __attribute__((address_space(3)))
typedef unsigned short bf16_t;
typedef short bf16x8 __attribute__((ext_vector_type(8)));
typedef float f32x4 __attribute__((ext_vector_type(4)));
typedef unsigned u32x4 __attribute__((ext_vector_type(4)));
constexpr int BM = 256, BK = 64, HALF = 128, HTB = HALF * BK * 2  , STAGE_BYTES = 8 * HTB, NXCD = 8, WGM = 8;

__host__ __device__ __forceinline__ int lds_byte(int r, int c) { const int st = (r >> 4) * 2 + (c >> 5), rr = r & 15, cc = c & 31, ob = rr * 64 + cc * 2; return st * 1024 + (ob ^ (((ob >> 9) & 1) << 5)); }
__host__ __device__ __forceinline__ void stage_rc(int b, int& R, int& C) { const int st = b / 1024, sb = b % 1024, swz = sb ^ (((sb >> 9) & 1) << 5); R = (st >> 1) * 16 + swz / 64; C = (st & 1) * 32 + (swz % 64) / 2; }
__host__ __device__ __forceinline__ int perm32(int rho) { const int n = rho >> 4, i = rho & 15; return 8 * (i >> 2) + 4 * n + (i & 3); }

struct Unit { int pm, pn; };
struct Gemm { const bf16_t* A; const bf16_t* Bt; int M, N, K; int a_rows = 256; };

struct StaticOrder {
    int nM, nN, nwg, G, c;
    __host__ __device__ void init(int M, int N, int G_, int c_) { nM = M / BM; nN = N / BM; nwg = nM * nN; G = G_; c = c_; }
    __host__ __device__ bool next(int i, Unit& u) const {
        const long L = (long)i * G + c; if (L >= nwg) return false;
        int wgid = (int)L; { const int q = nwg / NXCD, r = nwg % NXCD, xcd = wgid % NXCD, off = wgid / NXCD; wgid = (xcd < r ? xcd * (q + 1) : r * (q + 1) + (xcd - r) * q) + off; }
        const int nig = WGM * nN, gid = wgid / nig, fm = gid * WGM, gsz = (nM - fm) < WGM ? (nM - fm) : WGM;
        u.pm = fm + ((wgid % nig) % gsz); u.pn = (wgid % nig) / gsz; return true;
    }
    __device__ __forceinline__ void a_ready(const Unit&) const {}
    __device__ __forceinline__ void done(const Unit&) const {}
};
__device__ __forceinline__ unsigned cvt_pk_bf16(float lo, float hi) { unsigned r; asm volatile("v_cvt_pk_bf16_f32 %0, %1, %2" : "=v"(r) : "v"(lo), "v"(hi)); return r; }
typedef float f32x2 __attribute__((ext_vector_type(2)));
template <class Epi, class Sched, bool ALIGN_EPI = false, bool SP2 = false>
__device__ __forceinline__ void gemm_phase(PG8_LAS unsigned char* lds, const Gemm g, const Sched& S, const Epi& E) {
    int tid_l = threadIdx.x; asm volatile("" : "+v"(tid_l));
    const int tid = tid_l, wid = __builtin_amdgcn_readfirstlane(tid >> 6), lane = tid & 63, wr = wid >> 2, wc = wid & 3, fr = lane & 15, fq = lane >> 4;
    const int K = g.K, nt = K / BK;
    unsigned voffA[2], voffB[2];
#pragma unroll
    for (int i = 0; i < 2; ++i) { int R, C; stage_rc(tid * 16 + i * 8192, R, C); const int Rb = Epi::PERM ? ((R & ~31) + perm32(R & 31)) : R;
        voffA[i] = (unsigned)(R * K + C) * 2u; voffB[i] = (unsigned)(Rb * K + C) * 2u; }
    const size_t kstep = (size_t)(BK * 2);
    const size_t hstep = (size_t)HALF * K * 2;
    const size_t tstep = 2 * hstep;
    const size_t atstep = (size_t)g.a_rows * K * 2;
    const unsigned ldsw = (unsigned)wid * 1024u;
    const int aoff = lds_byte(wr * 64 + fr, fq * 8), boff = lds_byte(wc * 32 + fr, fq * 8);
#define PG8_SA(b, h) (((b) * 2 + (h)) * HTB)
#define PG8_SB(b, h) ((4 + (b) * 2 + (h)) * HTB)
#define PG8_STAGE(bufoff, gbase, voff) do { _Pragma("unroll") for (int _i = 0; _i < 2; ++_i) \
        __builtin_amdgcn_global_load_lds((const unsigned*)((const char*)(gbase) + (voff)[_i]), (PG8_LAS unsigned*)(lds + (bufoff) + ldsw + _i * 8192), 16, 0, 0); } while (0)
#define PG8_LDA(dst, b, h) do { _Pragma("unroll") for (int m = 0; m < 4; ++m) _Pragma("unroll") for (int k = 0; k < 2; ++k) dst[m][k] = *(const PG8_LAS bf16x8*)(lds + PG8_SA(b, h) + aoff + m * 2048 + k * 1024); } while (0)
#define PG8_LDB(dst, b, h) do { _Pragma("unroll") for (int n = 0; n < 2; ++n) _Pragma("unroll") for (int k = 0; k < 2; ++k) dst[n][k] = *(const PG8_LAS bf16x8*)(lds + PG8_SB(b, h) + boff + n * 2048 + k * 1024); } while (0)
#define PG8_MMA(ai, bj, At, Bt) do { __builtin_amdgcn_s_setprio(1); _Pragma("unroll") for (int m = 0; m < 4; ++m) _Pragma("unroll") for (int n = 0; n < 2; ++n) _Pragma("unroll") for (int k = 0; k < 2; ++k) \
        acc[ai][bj][m][n] = __builtin_amdgcn_mfma_f32_16x16x32_bf16(Bt[n][k], At[m][k], acc[ai][bj][m][n], 0, 0, 0); __builtin_amdgcn_s_setprio(0); } while (0)
#define PG8_WAIT_V(n) asm volatile("s_waitcnt vmcnt(" #n ")" ::: "memory")
#define PG8_WAIT_L(n) asm volatile("s_waitcnt lgkmcnt(" #n ")" ::: "memory")
#define PG8_BAR __builtin_amdgcn_s_barrier()
#define PG8_SCHED __builtin_amdgcn_sched_barrier(0)
    Unit cur, nxt; int ui = 0;
    if (!S.next(0, cur)) return;
    f32x4 acc[2][2][4][2];
#pragma unroll
    for (int a = 0; a < 2; ++a)
#pragma unroll
        for (int b = 0; b < 2; ++b)
#pragma unroll
            for (int m = 0; m < 4; ++m)
#pragma unroll
                for (int n = 0; n < 2; ++n) acc[a][b][m][n] = (f32x4){0.f, 0.f, 0.f, 0.f};
    bf16x8 At[4][2], B0[2][2], B1[2][2];
    const char* cA = (const char*)g.A + (size_t)cur.pm * atstep; const char* cB = (const char*)g.Bt + (size_t)cur.pn * tstep;
    S.a_ready(cur);
    if constexpr (SP2) {
        PG8_STAGE(PG8_SB(0, 0), cB, voffB); PG8_STAGE(PG8_SB(0, 1), cB + hstep, voffB); PG8_STAGE(PG8_SA(0, 0), cA, voffA); PG8_STAGE(PG8_SA(0, 1), cA + hstep, voffA);
        if (wr == 1) PG8_BAR;
        PG8_WAIT_V(2); PG8_BAR;
        PG8_STAGE(PG8_SB(1, 0), cB + kstep, voffB); PG8_STAGE(PG8_SA(1, 0), cA + kstep, voffA); PG8_STAGE(PG8_SB(1, 1), cB + hstep + kstep, voffB);
        PG8_WAIT_V(6); PG8_BAR;
    } else {
        PG8_STAGE(PG8_SB(0, 0), cB, voffB); PG8_STAGE(PG8_SA(0, 0), cA, voffA); PG8_STAGE(PG8_SB(0, 1), cB + hstep, voffB); PG8_STAGE(PG8_SA(0, 1), cA + hstep, voffA);
        if (wr == 1) PG8_BAR;
        PG8_WAIT_V(4); PG8_BAR;
        PG8_STAGE(PG8_SB(1, 0), cB + kstep, voffB); PG8_STAGE(PG8_SA(1, 0), cA + kstep, voffA); PG8_STAGE(PG8_SB(1, 1), cB + hstep + kstep, voffB);
        PG8_WAIT_V(6); PG8_BAR;
    }
    for (;;) {
        const bool has_next = S.next(ui + 1, nxt);
        const char* nA = has_next ? (const char*)g.A + (size_t)nxt.pm * atstep : cA; const char* nB = has_next ? (const char*)g.Bt + (size_t)nxt.pn * tstep : cB;
        for (int t = 0; t < nt; t += 2) {
            const bool last = (t == nt - 2);
            const char* a1 = cA + (size_t)(t + 1) * kstep;
            const char* a2 = last ? nA : cA + (size_t)(t + 2) * kstep; const char* b2 = last ? nB : cB + (size_t)(t + 2) * kstep;
            const char* a3 = a2 + kstep; const char* b3 = b2 + kstep;
            if (last && has_next) S.a_ready(nxt);
            if constexpr (SP2) {
            PG8_LDB(B0, 0, 0); PG8_LDB(B1, 0, 1); PG8_SCHED; PG8_LDA(At, 0, 0); PG8_STAGE(PG8_SA(1, 1), a1 + hstep, voffA);
            PG8_WAIT_V(8); PG8_WAIT_L(0); PG8_BAR; PG8_MMA(0, 0, At, B0); PG8_MMA(0, 1, At, B1); PG8_BAR; PG8_SCHED;
            PG8_LDA(At, 0, 1); PG8_STAGE(PG8_SB(0, 0), b2, voffB); PG8_STAGE(PG8_SB(0, 1), b2 + hstep, voffB); PG8_STAGE(PG8_SA(0, 0), a2, voffA);
            PG8_WAIT_V(8); PG8_WAIT_L(0); PG8_BAR; PG8_MMA(1, 0, At, B0); PG8_MMA(1, 1, At, B1); PG8_BAR; PG8_SCHED;
            PG8_LDB(B0, 1, 0); PG8_LDB(B1, 1, 1); PG8_SCHED; PG8_LDA(At, 1, 0); PG8_STAGE(PG8_SA(0, 1), a2 + hstep, voffA);
            PG8_WAIT_V(8); PG8_WAIT_L(0); PG8_BAR; PG8_MMA(0, 0, At, B0); PG8_MMA(0, 1, At, B1); PG8_BAR; PG8_SCHED;
            PG8_LDA(At, 1, 1); PG8_STAGE(PG8_SB(1, 0), b3, voffB); PG8_STAGE(PG8_SB(1, 1), b3 + hstep, voffB); PG8_STAGE(PG8_SA(1, 0), a3, voffA);
            PG8_WAIT_V(8); PG8_WAIT_L(0); PG8_BAR; PG8_MMA(1, 0, At, B0); PG8_MMA(1, 1, At, B1); PG8_BAR; PG8_SCHED;
            } else {
            PG8_LDB(B0, 0, 0); PG8_SCHED; PG8_LDA(At, 0, 0); PG8_STAGE(PG8_SA(1, 1), a1 + hstep, voffA);
            PG8_WAIT_L(8); PG8_BAR; PG8_WAIT_L(0); PG8_MMA(0, 0, At, B0); PG8_BAR; PG8_SCHED;
            PG8_LDB(B1, 0, 1); PG8_STAGE(PG8_SB(0, 0), b2, voffB);
            PG8_BAR; PG8_WAIT_L(0); PG8_MMA(0, 1, At, B1); PG8_BAR;
            PG8_LDA(At, 0, 1); PG8_STAGE(PG8_SA(0, 0), a2, voffA);
            PG8_BAR; PG8_WAIT_L(0); PG8_MMA(1, 0, At, B0); PG8_BAR; PG8_SCHED;
            PG8_STAGE(PG8_SB(0, 1), b2 + hstep, voffB);
            PG8_WAIT_V(6); PG8_BAR; PG8_MMA(1, 1, At, B1); PG8_BAR;
            PG8_LDB(B0, 1, 0); PG8_SCHED; PG8_LDA(At, 1, 0); PG8_STAGE(PG8_SA(0, 1), a2 + hstep, voffA);
            PG8_WAIT_L(8); PG8_BAR; PG8_WAIT_L(0); PG8_MMA(0, 0, At, B0); PG8_BAR; PG8_SCHED;
            PG8_LDB(B1, 1, 1); PG8_STAGE(PG8_SB(1, 0), b3, voffB);
            PG8_BAR; PG8_WAIT_L(0); PG8_MMA(0, 1, At, B1); PG8_BAR;
            PG8_LDA(At, 1, 1); PG8_STAGE(PG8_SA(1, 0), a3, voffA);
            PG8_BAR; PG8_WAIT_L(0); PG8_MMA(1, 0, At, B0); PG8_BAR; PG8_SCHED;
            PG8_STAGE(PG8_SB(1, 1), b3 + hstep, voffB);
            PG8_WAIT_V(6); PG8_BAR; PG8_MMA(1, 1, At, B1); PG8_BAR;
            }
        }
        if constexpr (ALIGN_EPI) { if (wr == 0) PG8_BAR; }
        if constexpr (!Epi::AFTER_DRAIN) { E(acc, cur, wr, wc, fr, fq); S.done(cur); }
        if (!has_next) break;
#pragma unroll
        for (int a = 0; a < 2; ++a)
#pragma unroll
            for (int b = 0; b < 2; ++b)
#pragma unroll
                for (int m = 0; m < 4; ++m)
#pragma unroll
                    for (int n = 0; n < 2; ++n) acc[a][b][m][n] = (f32x4){0.f, 0.f, 0.f, 0.f};
        cur = nxt; cA = nA; cB = nB; ++ui;
        if constexpr (ALIGN_EPI) { if (wr == 1) PG8_BAR; }
    }
    PG8_WAIT_V(0);
    if constexpr (!ALIGN_EPI) { if (wr == 0) PG8_BAR; }
    PG8_BAR;
    if constexpr (Epi::AFTER_DRAIN) { E.fused(acc, cur, wr, wc, fr, fq, lds, wid, lane); S.done(cur); }
#undef PG8_SA
#undef PG8_SB
#undef PG8_STAGE
#undef PG8_LDA
#undef PG8_LDB
#undef PG8_MMA
#undef PG8_WAIT_V
#undef PG8_WAIT_L
#undef PG8_BAR
#undef PG8_SCHED
}
}

#ifndef EN_ATT
#define EN_ATT 1
#endif
#ifndef EN_HY
#define EN_HY 1
#endif
#ifndef EN_FFN
#define EN_FFN 1
#endif
#ifndef PROBE_PH
#define PROBE_PH -1
#endif
#ifndef PHASES
#define PHASES 0xFFFF
#endif
#define PH(k) ((PHASES >> (k)) & 1)
#define LAS __attribute__((address_space(3)))
typedef unsigned short bf16_t;
typedef pg8::f32x4 f32x4;
typedef pg8::u32x4 u32x4;
typedef pg8::bf16x8 bf16x8;
typedef float f32x16 __attribute__((ext_vector_type(16)));
typedef float f32x2 __attribute__((ext_vector_type(2)));
typedef unsigned u32x2 __attribute__((ext_vector_type(2)));
typedef short s16x4 __attribute__((ext_vector_type(4)));

constexpr int D = 1024, NB = 8, SEQ = 4096, MROWS = NB * SEQ, CTX = 256, MCTX = NB * CTX, KV = CTX + SEQ;
constexpr int INC = 5120, DFF = 2816, NUP = 2 * DFF, NADA = 6 * D;
constexpr float LN_EPS = 1e-5f, RMS_EPS = 1e-5f;
constexpr float DN_ALPHA = 1.189207115002721f;
constexpr float LAM_INIT = 0.2f;
constexpr float QSCALE = 0.125f * 1.4426950408889634f;

constexpr size_t MiB = 1u << 20;
constexpr size_t WS_ST0 = 0, WS_ST1 = 256 * 1024, WS_ROPE = 512 * 1024, WS_TW = 528 * 1024, WS_MOD = 576 * 1024;
constexpr size_t WS_MODP = 1 * MiB;
constexpr size_t WS_WIN = 3 * MiB, WS_WHY = 13 * MiB, WS_WAT = 14 * MiB, WS_WOUT = 15 * MiB, WS_WUP = 17 * MiB, WS_WDN = 28 * MiB;
constexpr size_t WS_XM = 34 * MiB;
constexpr size_t WS_ON = 34 * MiB, WS_YHT = 66 * MiB, WS_HM = 34 * MiB;
constexpr size_t WS_CTXM = 98 * MiB;
constexpr size_t WS_FILT = 490 * MiB;
constexpr size_t WS_SG = 102 * MiB;
constexpr size_t WS_KSPEC = 230 * MiB;
constexpr size_t WS_MBUF = 230 * MiB;
constexpr size_t WS_ZHY = 294 * MiB;
constexpr size_t WS_YH = 294 * MiB;
constexpr size_t WS_Q = 390 * MiB, WS_K = 422 * MiB, WS_V = 456 * MiB;
constexpr size_t WS_U = 102 * MiB;
constexpr size_t WS_ACT = 278 * MiB;
constexpr size_t WS_TSC = 102 * MiB;
constexpr size_t WS_R1B = 134 * MiB;
constexpr size_t WS_END = 506 * MiB;

constexpr int LDS_MISC = 139264;
constexpr int LDS_BYTES = 139264 + 256;
constexpr size_t WS_BAR = 832 * 1024;

__device__ __forceinline__ int tid_fresh() { int t = threadIdx.x; asm volatile("" : "+v"(t)); return t; }
__device__ __forceinline__ unsigned pk2(float lo, float hi) { return pg8::cvt_pk_bf16(lo, hi); }
__device__ __forceinline__ float bflo(unsigned w) { return __uint_as_float(w << 16); }
__device__ __forceinline__ float bfhi(unsigned w) { return __uint_as_float(w & 0xffff0000u); }
__device__ __forceinline__ float bf1(bf16_t v) { return __uint_as_float((unsigned)v << 16); }
template <int MASK> __device__ __forceinline__ float xswz(float v) { return __uint_as_float((unsigned)__builtin_amdgcn_ds_swizzle((int)__float_as_uint(v), 0x1F | (MASK << 10))); }
__device__ __forceinline__ float xsum32(float v) { const unsigned u = __float_as_uint(v); auto rr = __builtin_amdgcn_permlane32_swap(u, u, false, false); return __uint_as_float(rr[0]) + __uint_as_float(rr[1]); }
__device__ __forceinline__ float xmax32(float v) { const unsigned u = __float_as_uint(v); auto rr = __builtin_amdgcn_permlane32_swap(u, u, false, false); return fmaxf(__uint_as_float(rr[0]), __uint_as_float(rr[1])); }
__device__ __forceinline__ float xget32(float v, bool upper) { const unsigned u = __float_as_uint(v); auto rr = __builtin_amdgcn_permlane32_swap(u, u, false, false); return __uint_as_float(upper ? rr[0] : rr[1]); }
__device__ __forceinline__ float wave_sum(float v) {
    v += xswz<1>(v); v += xswz<2>(v); v += xswz<4>(v); v += xswz<8>(v); v += xswz<16>(v);
    return xsum32(v);
}
__device__ __forceinline__ float fast_sigmoid(float x) { return __builtin_amdgcn_rcpf(1.0f + __builtin_amdgcn_exp2f(-1.4426950408889634f * x)); }
__device__ __forceinline__ u32x4 pack8(const f32x4& a, const f32x4& b) { u32x4 w; w.x = pk2(a[0], a[1]); w.y = pk2(a[2], a[3]); w.z = pk2(b[0], b[1]); w.w = pk2(b[2], b[3]); return w; }
__device__ __forceinline__ void unpack8(const u32x4& w, f32x4& a, f32x4& b) { a = (f32x4){bflo(w.x), bfhi(w.x), bflo(w.y), bfhi(w.y)}; b = (f32x4){bflo(w.z), bfhi(w.z), bflo(w.w), bfhi(w.w)}; }

__device__ __forceinline__ size_t koff(int pos, int d) { return ((size_t)(((pos >> 6) * 8 + (d >> 3)) * 64 + (pos & 63))) * 8 + (d & 7); }
__device__ __forceinline__ size_t voff(int pos, int dv) { return ((size_t)(((pos >> 6) * 4 + (dv >> 5)) * 64 + (pos & 63))) * 32 + (dv & 31); }
struct EpiIn {
    static constexpr bool PERM = true, AFTER_DRAIN = false;
    bf16_t *zhy, *q, *k, *v, *sg; const f32x2* rope;
    __device__ __forceinline__ void operator()(const f32x4 (&acc)[2][2][4][2], const pg8::Unit& u, int wr, int wc, int fr, int fq) const {
        const int pn = u.pn;
#pragma unroll
        for (int ai = 0; ai < 2; ++ai)
#pragma unroll
            for (int m = 0; m < 4; ++m) {
                const int r = u.pm * 256 + ai * 128 + wr * 64 + m * 16 + fr; const int b = r >> 12, t = r & 4095;
#pragma unroll
                for (int bj = 0; bj < 2; ++bj) {
                    const int c = pn * 256 + bj * 128 + wc * 32 + fq * 8;
                    const f32x4 v0 = acc[ai][bj][m][0], v1 = acc[ai][bj][m][1];
                    if (pn < 6) {
                        bf16_t* dst = zhy + ((size_t)(b * 1536 + c) * 4096 + t);
                        const u32x4 w = pack8(v0, v1);
                        dst[0] = (bf16_t)(w.x & 0xffff); dst[4096] = (bf16_t)(w.x >> 16); dst[2 * 4096] = (bf16_t)(w.y & 0xffff); dst[3 * 4096] = (bf16_t)(w.y >> 16);
                        dst[4 * 4096] = (bf16_t)(w.z & 0xffff); dst[5 * 4096] = (bf16_t)(w.z >> 16); dst[6 * 4096] = (bf16_t)(w.w & 0xffff); dst[7 * 4096] = (bf16_t)(w.w >> 16);
                    } else if (pn < 10) {
                        const bool isq = pn < 8; const int cq = c - (isq ? 1536 : 2048);
                        const int h = cq >> 7, cc = (cq >> 6) & 1, d = cq & 63, axis = (cq >> 5) & 1;
                        const int pos = axis ? (t & 63) : (t >> 6);
                        const f32x4* rt = (const f32x4*)(rope + pos * 16 + (fq & 1) * 8);
                        const f32x4 t0 = rt[0], t1 = rt[1], t2 = rt[2], t3 = rt[3];
                        const float sgn = (fq < 2) ? -1.0f : 1.0f;
                        f32x4 p0, p1;
#pragma unroll
                        for (int e = 0; e < 4; ++e) { p0[e] = xget32(v0[e], fq >= 2); p1[e] = xget32(v1[e], fq >= 2); }
                        f32x4 o0, o1;
                        o0[0] = v0[0] * t0[0] + sgn * p0[0] * t0[1]; o0[1] = v0[1] * t0[2] + sgn * p0[1] * t0[3];
                        o0[2] = v0[2] * t1[0] + sgn * p0[2] * t1[1]; o0[3] = v0[3] * t1[2] + sgn * p0[3] * t1[3];
                        o1[0] = v1[0] * t2[0] + sgn * p1[0] * t2[1]; o1[1] = v1[1] * t2[2] + sgn * p1[1] * t2[3];
                        o1[2] = v1[2] * t3[0] + sgn * p1[2] * t3[1]; o1[3] = v1[3] * t3[2] + sgn * p1[3] * t3[3];
                        if (isq) { o0 = o0 * QSCALE; o1 = o1 * QSCALE; *(u32x4*)(q + ((size_t)((b * 4 + h) * 2 + cc) * SEQ + t) * 64 + d) = pack8(o0, o1); }
                        else *(u32x4*)(k + (size_t)((b * 4 + h) * 2 + cc) * KV * 64 + koff(CTX + t, d)) = pack8(o0, o1);
                    } else if (pn < 12) {
                        const int cv = c - 2560, h = cv >> 7, dv = cv & 127;
                        *(u32x4*)(v + (size_t)(b * 4 + h) * KV * 128 + voff(CTX + t, dv)) = pack8(v0, v1);
                    } else {
                        f32x4 s0, s1;
#pragma unroll
                        for (int e = 0; e < 4; ++e) { s0[e] = fast_sigmoid(v0[e]); s1[e] = fast_sigmoid(v1[e]); }
                        *(u32x4*)(sg + (size_t)r * 2048 + (c - 3072)) = pack8(s0, s1);
                    }
                }
            }
    }
};
struct EpiCtx {
    static constexpr bool PERM = true, AFTER_DRAIN = false;
    bf16_t *k, *v;
    __device__ __forceinline__ void operator()(const f32x4 (&acc)[2][2][4][2], const pg8::Unit& u, int wr, int wc, int fr, int fq) const {
        const int pn = u.pn;
#pragma unroll
        for (int ai = 0; ai < 2; ++ai)
#pragma unroll
            for (int m = 0; m < 4; ++m) {
                const int r = u.pm * 256 + ai * 128 + wr * 64 + m * 16 + fr; const int b = r >> 8, t = r & 255;
#pragma unroll
                for (int bj = 0; bj < 2; ++bj) {
                    const int c = pn * 256 + bj * 128 + wc * 32 + fq * 8;
                    const u32x4 w = pack8(acc[ai][bj][m][0], acc[ai][bj][m][1]);
                    if (pn < 2) { const int h = c >> 7, cc = (c >> 6) & 1, d = c & 63; *(u32x4*)(k + (size_t)((b * 4 + h) * 2 + cc) * KV * 64 + koff(t, d)) = w; }
                    else { const int cv = c - 512, h = cv >> 7, dv = cv & 127; *(u32x4*)(v + (size_t)(b * 4 + h) * KV * 128 + voff(t, dv)) = w; }
                }
            }
    }
};
template <bool ADD> struct EpiMerge {
    static constexpr bool PERM = true, AFTER_DRAIN = false;
    bf16_t* mb; const bf16_t* sg;
    __device__ __forceinline__ void operator()(const f32x4 (&acc)[2][2][4][2], const pg8::Unit& u, int wr, int wc, int fr, int fq) const {
#pragma unroll
        for (int ai = 0; ai < 2; ++ai)
#pragma unroll
            for (int m = 0; m < 4; ++m) {
                const int r = u.pm * 256 + ai * 128 + wr * 64 + m * 16 + fr;
#pragma unroll
                for (int bj = 0; bj < 2; ++bj) {
                    const int c = u.pn * 256 + bj * 128 + wc * 32 + fq * 8;
                    f32x4 g0, g1; unpack8(*(const u32x4*)(sg + (size_t)r * 2048 + (ADD ? 1024 : 0) + c), g0, g1);
                    f32x4 o0 = acc[ai][bj][m][0] * g0, o1 = acc[ai][bj][m][1] * g1;
                    bf16_t* dst = mb + (size_t)r * D + c;
                    if (ADD) { f32x4 p0, p1; unpack8(*(const u32x4*)dst, p0, p1); o0 = o0 + p0; o1 = o1 + p1; }
                    *(u32x4*)dst = pack8(o0, o1);
                }
            }
    }
};
struct EpiOut {
    static constexpr bool PERM = true, AFTER_DRAIN = false;
    const float *x, *st0, *lg, *lb, *mod; bf16_t* r1b;
    __device__ __forceinline__ void operator()(const f32x4 (&acc)[2][2][4][2], const pg8::Unit& u, int wr, int wc, int fr, int fq) const {
        const int b = (u.pm * 256) >> 12;
#pragma unroll
        for (int bj = 0; bj < 2; ++bj) {
            const int c = u.pn * 256 + bj * 128 + wc * 32 + fq * 8;
            f32x4 g[2], bb[2], g1[2];
#pragma unroll
            for (int n = 0; n < 2; ++n) { g[n] = *(const f32x4*)(lg + c + 4 * n); bb[n] = *(const f32x4*)(lb + c + 4 * n); g1[n] = *(const f32x4*)(mod + b * NADA + 2 * D + c + 4 * n); }
#pragma unroll
            for (int ai = 0; ai < 2; ++ai)
#pragma unroll
                for (int m = 0; m < 4; ++m) {
                    const int r = u.pm * 256 + ai * 128 + wr * 64 + m * 16 + fr;
                    const f32x2 st = *(const f32x2*)(st0 + 2 * r);
                    f32x4 rr[2];
#pragma unroll
                    for (int n = 0; n < 2; ++n) {
                        const f32x4 xv = *(const f32x4*)(x + (size_t)r * D + c + 4 * n);
                        const f32x4 xl = (xv - st.x) * st.y * g[n] + bb[n];
                        rr[n] = xl * DN_ALPHA + g1[n] * acc[ai][bj][m][n];
                    }
                    *(u32x4*)(r1b + (size_t)r * D + c) = pack8(rr[0], rr[1]);
                }
        }
    }
};
struct EpiUpGate {
    static constexpr bool PERM = true, AFTER_DRAIN = false;
    bf16_t* tsc; bf16_t* act; const float* cw; const float* cb; bf16_t* ubnd;
    __device__ __forceinline__ void operator()(const f32x4 (&acc)[2][2][4][2], const pg8::Unit& u, int wr, int wc, int fr, int fq) const {
        bf16_t* T = tsc + (size_t)blockIdx.x * 65536;
#pragma unroll
        for (int ai = 0; ai < 2; ++ai)
#pragma unroll
            for (int m = 0; m < 4; ++m) {
                const int r = ai * 128 + wr * 64 + m * 16 + fr;
#pragma unroll
                for (int bj = 0; bj < 2; ++bj) *(u32x4*)(T + r * 256 + bj * 128 + wc * 32 + fq * 8) = pack8(acc[ai][bj][m][0], acc[ai][bj][m][1]);
            }
        asm volatile("s_waitcnt vmcnt(0)" ::: "memory"); __builtin_amdgcn_s_barrier(); asm volatile("" ::: "memory");
        const int tid = (wr * 4 + wc) * 64 + fq * 16 + fr, cg_ = tid & 15, rc = tid >> 4;
        if (tid < 128) {
            const int q = tid >> 5, ch = tid & 31, rr = (q < 2) ? q : 252 + q;
            *(u32x4*)(ubnd + ((size_t)((u.pm * 22 + u.pn) * 4 + q)) * 256 + ch * 8) = *(const u32x4*)(T + rr * 256 + ch * 8);
        }
        const int ca = u.pn * 128 + cg_ * 8, cgt = DFF + ca;
        f32x4 wA[3][2], wG[3][2], bA[2], bG[2];
#pragma unroll
        for (int j = 0; j < 3; ++j)
#pragma unroll
            for (int n = 0; n < 2; ++n) { wA[j][n] = *(const f32x4*)(cw + j * NUP + ca + 4 * n); wG[j][n] = *(const f32x4*)(cw + j * NUP + cgt + 4 * n); }
#pragma unroll
        for (int n = 0; n < 2; ++n) { bA[n] = *(const f32x4*)(cb + ca + 4 * n); bG[n] = *(const f32x4*)(cb + cgt + 4 * n); }
        const f32x4 z4 = {0.f, 0.f, 0.f, 0.f};
#pragma unroll 1
        for (int hh = 0; hh < 2; ++hh) {
            u32x4 ra[6], rg[6];
#pragma unroll
            for (int i = 0; i < 6; ++i) { int r = rc * 8 + hh * 4 - 1 + i; r = r < 0 ? 0 : (r > 255 ? 255 : r);
                ra[i] = *(const u32x4*)(T + r * 256 + cg_ * 8); rg[i] = *(const u32x4*)(T + r * 256 + 128 + cg_ * 8); }
#pragma unroll
            for (int i = 0; i < 4; ++i) {
                const int r = rc * 8 + hh * 4 + i, R = 256 * u.pm + r, t = R & 4095;
                f32x4 pA[2], cA[2], nA[2], pG[2], cG[2], nG[2];
                unpack8(ra[i], pA[0], pA[1]); unpack8(ra[i + 1], cA[0], cA[1]); unpack8(ra[i + 2], nA[0], nA[1]);
                unpack8(rg[i], pG[0], pG[1]); unpack8(rg[i + 1], cG[0], cG[1]); unpack8(rg[i + 2], nG[0], nG[1]);
                if (t == 0) { pA[0] = pA[1] = pG[0] = pG[1] = z4; }
                if (t == 4095) { nA[0] = nA[1] = nG[0] = nG[1] = z4; }
                f32x4 o[2];
#pragma unroll
                for (int n = 0; n < 2; ++n) {
                    const f32x4 av = wA[0][n] * pA[n] + wA[1][n] * cA[n] + wA[2][n] * nA[n] + bA[n];
                    const f32x4 gv = wG[0][n] * pG[n] + wG[1][n] * cG[n] + wG[2][n] * nG[n] + bG[n];
#pragma unroll
                    for (int e = 0; e < 4; ++e) o[n][e] = gv[e] * fast_sigmoid(gv[e]) * av[e];
                }
                if ((r >= 1 || t == 0) && (r <= 254 || t == 4095)) *(u32x4*)(act + (size_t)R * DFF + ca) = pack8(o[0], o[1]);
            }
        }
    }
};
struct EpiDown {
    static constexpr bool PERM = true, AFTER_DRAIN = false;
    const float *st1, *lg, *lb, *mod; const bf16_t* r1b; float* out;
    __device__ __forceinline__ void operator()(const f32x4 (&acc)[2][2][4][2], const pg8::Unit& u, int wr, int wc, int fr, int fq) const {
        const int b = (u.pm * 256) >> 12;
#pragma unroll
        for (int bj = 0; bj < 2; ++bj) {
            const int c = u.pn * 256 + bj * 128 + wc * 32 + fq * 8;
            f32x4 g[2], bb[2], g2[2];
#pragma unroll
            for (int n = 0; n < 2; ++n) { g[n] = *(const f32x4*)(lg + c + 4 * n); bb[n] = *(const f32x4*)(lb + c + 4 * n); g2[n] = *(const f32x4*)(mod + b * NADA + 5 * D + c + 4 * n); }
#pragma unroll
            for (int ai = 0; ai < 2; ++ai)
#pragma unroll
                for (int m = 0; m < 4; ++m) {
                    const int r = u.pm * 256 + ai * 128 + wr * 64 + m * 16 + fr;
                    const f32x2 st = *(const f32x2*)(st1 + 2 * r);
                    f32x4 rv2[2]; unpack8(*(const u32x4*)(r1b + (size_t)r * D + c), rv2[0], rv2[1]);
#pragma unroll
                    for (int n = 0; n < 2; ++n) {
                        const f32x4 x1 = (rv2[n] - st.x) * st.y * g[n] + bb[n];
#if EN_FFN
                        *(f32x4*)(out + (size_t)r * D + c + 4 * n) = x1 * DN_ALPHA + g2[n] * acc[ai][bj][m][n];
#else
                        *(f32x4*)(out + (size_t)r * D + c + 4 * n) = x1 * DN_ALPHA;
#endif
                    }
                }
        }
    }
};

namespace att {
constexpr int NT = KV / 64, KSTG = 16384, V_BASE = 3 * 16384, VSTG = 16384;
__device__ __forceinline__ void stage_k(LAS unsigned char* dst, const bf16_t* K0, const bf16_t* K1, int key0, int wid, int lane) {
    const size_t o = ((size_t)((key0 >> 6) * 8 + wid) * 64 + lane) * 8;
    __builtin_amdgcn_global_load_lds((const unsigned*)(K0 + o), (LAS unsigned*)(dst + wid * 1024), 16, 0, 0);
    __builtin_amdgcn_global_load_lds((const unsigned*)(K1 + o), (LAS unsigned*)(dst + 8192 + wid * 1024), 16, 0, 0);
}
__device__ __forceinline__ void stage_v(LAS unsigned char* dst, const bf16_t* Vb, int key0, int wid, int lane) {
#pragma unroll
    for (int i = 0; i < 2; ++i) {
        const int pv = wid + 8 * i, db = pv >> 2, kg = pv & 3;
        __builtin_amdgcn_global_load_lds((const unsigned*)(Vb + ((size_t)((key0 >> 6) * 4 + db) * 64 + 16 * kg) * 32 + lane * 8), (LAS unsigned*)(dst + db * 4096 + kg * 1024), 16, 0, 0);
    }
}
__device__ __forceinline__ s16x4 vtr(const LAS unsigned char* p) {
    typedef short v4i16_t __attribute__((ext_vector_type(4)));
    return __builtin_bit_cast(s16x4, __builtin_amdgcn_ds_read_tr16_b64_v4i16((LAS v4i16_t*)p));
}
#define ATT_THR 8.0f
#define VTR_ASM(dst, addr, off) asm volatile("ds_read_b64_tr_b16 %0, %1 offset:%c2" : "=&v"(dst) : "v"(addr), "i"(off) : "memory")
#define VTR_BLK(blk) do { _Pragma("unroll") for (int ks = 0; ks < 4; ++ks) { VTR_ASM(la[ks], vaddr, (blk) * 4096 + ks * 1024); VTR_ASM(ha[ks], vaddr, (blk) * 4096 + ks * 1024 + 512); } } while (0)
#define VTR_WAIT() asm volatile("s_waitcnt lgkmcnt(0)" : "+v"(la[0]), "+v"(la[1]), "+v"(la[2]), "+v"(la[3]), "+v"(ha[0]), "+v"(ha[1]), "+v"(ha[2]), "+v"(ha[3]) :: "memory")
#define PV_BLK(blk) do { _Pragma("unroll") for (int ks = 0; ks < 4; ++ks) { \
        const bf16x8 vf = (bf16x8){la[ks][0], la[ks][1], la[ks][2], la[ks][3], ha[ks][0], ha[ks][1], ha[ks][2], ha[ks][3]}; \
        o[blk] = __builtin_amdgcn_mfma_f32_32x32x16_bf16(vf, pf[ks], o[blk], 0, 0, 0); } } while (0)
#define QKT(P0, P1, KSLOT) do { \
    const LAS unsigned char* Ks = lds + (KSLOT) * KSTG + (comp ? 8192 : 0); \
    _Pragma("unroll") for (int d0 = 0; d0 < 4; ++d0) { \
        const bf16x8 ka = *(const LAS bf16x8*)(Ks + (2 * d0 + hi) * 1024 + r32 * 16); \
        const bf16x8 kb = *(const LAS bf16x8*)(Ks + (2 * d0 + hi) * 1024 + 512 + r32 * 16); \
        if (d0 == 0) { P0 = __builtin_amdgcn_mfma_f32_32x32x16_bf16(ka, qr[0], negm, 0, 0, 0); P1 = __builtin_amdgcn_mfma_f32_32x32x16_bf16(kb, qr[0], negm, 0, 0, 0); } \
        else { P0 = __builtin_amdgcn_mfma_f32_32x32x16_bf16(ka, qr[d0], P0, 0, 0, 0); P1 = __builtin_amdgcn_mfma_f32_32x32x16_bf16(kb, qr[d0], P1, 0, 0, 0); } } \
} while (0)
#define EXP8(P, B) do { _Pragma("unroll") for (int r = (B); r < (B) + 8; ++r) { P[r] = __builtin_amdgcn_exp2f(P[r]); } } while (0)
#define WAITBAR(n) asm volatile("s_waitcnt vmcnt(" #n ") lgkmcnt(0)\n\ts_barrier" ::: "memory")
__device__ __forceinline__ void attn_unit(int b, int h, int qb, const bf16_t* Q, const bf16_t* Kg, const bf16_t* Vg, bf16_t* On, float lam, const float* subln, LAS unsigned char* lds) {
    const int tid = tid_fresh(), lane = tid & 63, r32 = lane & 31, hi = lane >> 5;
    const int wid = __builtin_amdgcn_readfirstlane(tid >> 6), comp = wid >> 2, wq = wid & 3;
    const int t0 = qb * 128 + wq * 32;
    const bf16_t* Qp = Q + ((size_t)((b * 4 + h) * 2 + comp) * SEQ + t0 + r32) * 64;
    const bf16_t* K0 = Kg + (size_t)((b * 4 + h) * 2) * KV * 64; const bf16_t* K1 = K0 + (size_t)KV * 64;
    const bf16_t* Vb = Vg + (size_t)(b * 4 + h) * KV * 128;
    bf16x8 qr[4];
#pragma unroll
    for (int d0 = 0; d0 < 4; ++d0) qr[d0] = *(const bf16x8*)(Qp + d0 * 16 + hi * 8);
    asm volatile("" ::: "memory");
    stage_k(lds, K0, K1, 0, wid, lane); stage_k(lds + KSTG, K0, K1, 64, wid, lane);
    stage_k(lds + 2 * KSTG, K0, K1, 128, wid, lane); stage_v(lds + V_BASE, Vb, 0, wid, lane);
    f32x16 o[4];
#pragma unroll
    for (int i = 0; i < 4; ++i)
#pragma unroll
        for (int r = 0; r < 16; ++r) o[i][r] = 0.f;
    float mref = 0.f, lrun = 0.f, alpha_prev = 1.f;
    f32x16 negm, pc0, pc1, pn0, pn1;
#pragma unroll
    for (int r = 0; r < 16; ++r) { negm[r] = 0.f; pn0[r] = 0.f; pn1[r] = 0.f; }
    bf16x8 pf[4];
#pragma unroll
    for (int i = 0; i < 4; ++i) pf[i] = (bf16x8){0, 0, 0, 0, 0, 0, 0, 0};
    s16x4 la[4], ha[4];
    const int vlane = ((lane >> 4) & 1) * 32 + (lane & 3) * 8 + (4 * hi + ((lane & 15) >> 2)) * 64;
    const unsigned vbase = (unsigned)(uintptr_t)(lds + V_BASE + vlane);
    asm volatile("s_waitcnt vmcnt(6)" ::: "memory"); __builtin_amdgcn_s_barrier(); asm volatile("" ::: "memory");
    QKT(pc0, pc1, 0);
    int k3 = 1;
    for (int t = 0; t < NT; ++t) {
        if (t + 2 < NT) WAITBAR(4); else if (t + 1 < NT) WAITBAR(2); else WAITBAR(0);
        if (t + 3 < NT) stage_k(lds + (k3 == 0 ? 2 : k3 - 1) * KSTG, K0, K1, (t + 3) * 64, wid, lane);
        if (t + 1 < NT) stage_v(lds + V_BASE + ((t + 1) & 3) * VSTG, Vb, (t + 1) * 64, wid, lane);
        if (t + 1 < NT) QKT(pn0, pn1, k3);
        float mx = fmaxf(pc0[0], pc1[0]);
#pragma unroll
        for (int r = 1; r < 16; ++r) mx = fmaxf(fmaxf(mx, pc0[r]), pc1[r]);
        mx = xmax32(mx);
        float alpha_cur = 1.0f;
        if (__any(mx > ATT_THR)) {
            const float dl = fmaxf(mx, 0.f); mref += dl;
#pragma unroll
            for (int r = 0; r < 16; ++r) { pc0[r] -= dl; pc1[r] -= dl; pn0[r] -= dl; pn1[r] -= dl; negm[r] = -mref; }
            alpha_cur = __builtin_amdgcn_exp2f(-dl); lrun *= alpha_cur;
        }
        if (__any(alpha_prev != 1.0f)) {
#pragma unroll
            for (int i = 0; i < 4; ++i)
#pragma unroll
                for (int r = 0; r < 16; ++r) o[i][r] *= alpha_prev;
        }
        if (t > 0) {
            const unsigned vaddr = vbase + (unsigned)((t + 3) & 3) * VSTG;
            VTR_BLK(0); EXP8(pc0, 0); VTR_WAIT(); PV_BLK(0);
            VTR_BLK(1); EXP8(pc0, 8); VTR_WAIT(); PV_BLK(1);
            VTR_BLK(2); EXP8(pc1, 0); VTR_WAIT(); PV_BLK(2);
            VTR_BLK(3); EXP8(pc1, 8); VTR_WAIT(); PV_BLK(3);
        } else { EXP8(pc0, 0); EXP8(pc0, 8); EXP8(pc1, 0); EXP8(pc1, 8); }
        f32x2 ls2a = {0.f, 0.f}, ls2b = {0.f, 0.f};
#pragma unroll
        for (int r = 0; r < 16; r += 2) { ls2a += (f32x2){pc0[r], pc0[r + 1]}; ls2b += (f32x2){pc1[r], pc1[r + 1]}; }
        ls2a += ls2b; lrun += ls2a.x + ls2a.y;
        { u32x4 w;
          w.x = pk2(pc0[0], pc0[1]); w.y = pk2(pc0[2], pc0[3]); w.z = pk2(pc0[4], pc0[5]); w.w = pk2(pc0[6], pc0[7]); pf[0] = __builtin_bit_cast(bf16x8, w);
          w.x = pk2(pc0[8], pc0[9]); w.y = pk2(pc0[10], pc0[11]); w.z = pk2(pc0[12], pc0[13]); w.w = pk2(pc0[14], pc0[15]); pf[1] = __builtin_bit_cast(bf16x8, w);
          w.x = pk2(pc1[0], pc1[1]); w.y = pk2(pc1[2], pc1[3]); w.z = pk2(pc1[4], pc1[5]); w.w = pk2(pc1[6], pc1[7]); pf[2] = __builtin_bit_cast(bf16x8, w);
          w.x = pk2(pc1[8], pc1[9]); w.y = pk2(pc1[10], pc1[11]); w.z = pk2(pc1[12], pc1[13]); w.w = pk2(pc1[14], pc1[15]); pf[3] = __builtin_bit_cast(bf16x8, w); }
        pc0 = pn0; pc1 = pn1; alpha_prev = alpha_cur;
        k3 = (k3 == 2) ? 0 : k3 + 1;
    }
    WAITBAR(0);
    if (__any(alpha_prev != 1.0f)) {
#pragma unroll
        for (int i = 0; i < 4; ++i)
#pragma unroll
            for (int r = 0; r < 16; ++r) o[i][r] *= alpha_prev;
    }
    { const unsigned vaddr = vbase + (unsigned)((NT - 1) & 3) * VSTG;
      VTR_BLK(0); VTR_WAIT(); PV_BLK(0); VTR_BLK(1); VTR_WAIT(); PV_BLK(1); VTR_BLK(2); VTR_WAIT(); PV_BLK(2); VTR_BLK(3); VTR_WAIT(); PV_BLK(3); }
    lrun = xsum32(lrun);
    const float inv = 1.0f / lrun;
    __syncthreads();
    LAS float* ex = (LAS float*)lds;
    if (comp == 1) {
#pragma unroll
        for (int i = 0; i < 4; ++i)
#pragma unroll
            for (int r = 0; r < 16; ++r) ex[(wq * 64 + i * 16 + r) * 64 + lane] = o[i][r] * inv;
    }
    __syncthreads();
    if (comp == 0) {
        float ss = 0.f;
#pragma unroll
        for (int i = 0; i < 4; ++i)
#pragma unroll
            for (int r = 0; r < 16; ++r) { const float v = o[i][r] * inv - lam * ex[(wq * 64 + i * 16 + r) * 64 + lane]; o[i][r] = v; ss += v * v; }
        ss = xsum32(ss);
        const float rn = 1.0f / sqrtf(ss * (1.0f / 128.0f) + RMS_EPS) * (1.0f - LAM_INIT);
        bf16_t* dst = On + (size_t)(b * SEQ + t0 + r32) * 512 + h * 128;
#pragma unroll
        for (int i = 0; i < 4; ++i)
#pragma unroll
            for (int g = 0; g < 4; ++g) {
                const int d = 32 * i + 8 * g + 4 * hi;
                const f32x4 sg = *(const f32x4*)(subln + d);
                u32x2 w; w.x = pk2(o[i][4 * g] * rn * sg[0], o[i][4 * g + 1] * rn * sg[1]); w.y = pk2(o[i][4 * g + 2] * rn * sg[2], o[i][4 * g + 3] * rn * sg[3]);
                *(u32x2*)(dst + d) = w;
            }
    }
    __syncthreads();
}
#undef VTR_ASM
#undef VTR_BLK
#undef VTR_WAIT
#undef PV_BLK
#undef QKT
#undef EXP8
#undef WAITBAR
}

namespace hy {
__device__ const float WC[16] = {1.0f, 0.98078528040323043f, 0.92387953251128674f, 0.83146961230254524f, 0.70710678118654757f, 0.55557023301960229f, 0.38268343236508984f, 0.19509032201612833f,
                                 0.0f, -0.19509032201612833f, -0.38268343236508984f, -0.55557023301960229f, -0.70710678118654757f, -0.83146961230254524f, -0.92387953251128674f, -0.98078528040323043f};
__device__ const float WS[16] = {0.0f, 0.19509032201612825f, 0.38268343236508978f, 0.55557023301960218f, 0.70710678118654746f, 0.83146961230254524f, 0.92387953251128674f, 0.98078528040323043f,
                                 1.0f, 0.98078528040323043f, 0.92387953251128674f, 0.83146961230254546f, 0.70710678118654757f, 0.55557023301960218f, 0.38268343236508989f, 0.19509032201612861f};
__device__ __forceinline__ int PX(int i) { return i + ((i >> 5) << 1); }
template <bool CONJ> __device__ __forceinline__ f32x2 cmulw(f32x2 a, float c, float s) {
    const f32x2 sw = CONJ ? (f32x2){-a.y, a.x} : (f32x2){a.y, -a.x};
    return a * (f32x2){c, c} + sw * (f32x2){s, s};
}
template <int H, bool INV, bool ZUP = false> __device__ __forceinline__ void pass16(LAS f32x2* X, const f32x2* TW, int tid) {
    constexpr int S = H / 8, MULT = 4096 / H;
    const int j0 = tid % S, blk = tid / S, base = blk * 2 * H + j0;
    f32x2 e[16];
#pragma unroll
    for (int r = 0; r < 16; ++r) e[r] = (ZUP && r >= 8) ? (f32x2){0.f, 0.f} : X[PX(base + r * S)];
    f32x2 w[4];
#pragma unroll
    for (int k = 0; k < 4; ++k) w[k] = TW[(j0 << k) * MULT];
    if (!INV) {
#pragma unroll
        for (int k = 0; k < 4; ++k) {
            const int hk = 8 >> k;
#pragma unroll
            for (int r = 0; r < 16; ++r) if (!(r & hk)) {
                const f32x2 a = e[r], bb = e[r + hk]; e[r] = a + bb; f32x2 d = a - bb;
                const int ci = (r % hk) << (k + 1);
                if (ci != 0) d = cmulw<false>(d, WC[ci], WS[ci]);
                e[r + hk] = cmulw<false>(d, w[k].x, w[k].y);
            }
        }
    } else {
#pragma unroll
        for (int k = 3; k >= 0; --k) {
            const int hk = 8 >> k;
#pragma unroll
            for (int r = 0; r < 16; ++r) if (!(r & hk)) {
                const f32x2 a = e[r]; f32x2 bb = cmulw<true>(e[r + hk], w[k].x, w[k].y);
                const int ci = (r % hk) << (k + 1);
                if (ci != 0) bb = cmulw<true>(bb, WC[ci], WS[ci]);
                e[r] = a + bb; e[r + hk] = a - bb;
            }
        }
    }
#pragma unroll
    for (int r = 0; r < 16; ++r) X[PX(base + r * S)] = e[r];
}
template <bool FILT> __device__ __forceinline__ void pass32(LAS f32x2* X, f32x2* Kout, const f32x2* Kin, int tid) {
    if (tid < 256) {
        f32x2 e[32];
        u32x4 kvv[8];
        if (!FILT) { const u32x4* kp0 = (const u32x4*)Kin + tid;
#pragma unroll
            for (int i = 0; i < 8; ++i) kvv[i] = kp0[i * 256]; }
        const LAS f32x4* xp = (const LAS f32x4*)(X + PX(32 * tid));
#pragma unroll
        for (int i = 0; i < 16; ++i) { const f32x4 v = xp[i]; e[2 * i] = (f32x2){v[0], v[1]}; e[2 * i + 1] = (f32x2){v[2], v[3]}; }
#pragma unroll
        for (int k = 0; k < 5; ++k) {
            const int hk = 16 >> k;
#pragma unroll
            for (int r = 0; r < 32; ++r) if (!(r & hk)) {
                const f32x2 a = e[r], bb = e[r + hk]; e[r] = a + bb; f32x2 d = a - bb;
                const int ci = (r % hk) << k;
                if (ci != 0) d = cmulw<false>(d, WC[ci], WS[ci]);
                e[r + hk] = d;
            }
        }
        if (FILT) {
            u32x4* kp = (u32x4*)Kout + tid;
#pragma unroll
            for (int i = 0; i < 8; ++i) { u32x4 w; w.x = pk2(e[4 * i].x, e[4 * i].y); w.y = pk2(e[4 * i + 1].x, e[4 * i + 1].y); w.z = pk2(e[4 * i + 2].x, e[4 * i + 2].y); w.w = pk2(e[4 * i + 3].x, e[4 * i + 3].y); kp[i * 256] = w; }
        } else {
#pragma unroll
            for (int i = 0; i < 8; ++i) {
#pragma unroll
                for (int j = 0; j < 4; ++j) { const unsigned kw = kvv[i][j]; const float kr = bflo(kw), ki = bfhi(kw); const f32x2 a = e[4 * i + j];
                    e[4 * i + j] = (f32x2){a.x * kr - a.y * ki, a.x * ki + a.y * kr}; }
            }
#pragma unroll
            for (int k = 4; k >= 0; --k) {
                const int hk = 16 >> k;
#pragma unroll
                for (int r = 0; r < 32; ++r) if (!(r & hk)) {
                    const f32x2 a = e[r]; f32x2 bb = e[r + hk];
                    const int ci = (r % hk) << k;
                    if (ci != 0) bb = cmulw<true>(bb, WC[ci], WS[ci]);
                    e[r] = a + bb; e[r + hk] = a - bb;
                }
            }
            LAS f32x4* xo = (LAS f32x4*)(X + PX(32 * tid));
#pragma unroll
            for (int i = 0; i < 16; ++i) xo[i] = (f32x4){e[2 * i].x, e[2 * i].y, e[2 * i + 1].x, e[2 * i + 1].y};
        }
    }
}
__device__ __forceinline__ void conv_fft(LAS f32x2* X, const f32x2* TW, const f32x2* Ks, int tid) {
    __syncthreads(); pass16<4096, false, true>(X, TW, tid);
    __syncthreads(); pass16<256, false>(X, TW, tid);
    __syncthreads(); pass32<false>(X, nullptr, Ks, tid);
    __syncthreads(); pass16<256, true>(X, TW, tid);
    __syncthreads(); pass16<4096, true>(X, TW, tid);
    __syncthreads();
}
struct Raw { u32x4 r; float lo, hi; };
__device__ __forceinline__ Raw raw_load(const bf16_t* zrow, int tid) {
    Raw w; w.r = *(const u32x4*)(zrow + 8 * tid);
    const bf16_t lo = zrow[tid > 0 ? 8 * tid - 1 : 0], hi = zrow[tid < 511 ? 8 * tid + 8 : 4095];
    w.lo = tid > 0 ? bf1(lo) : 0.f; w.hi = tid < 511 ? bf1(hi) : 0.f; return w;
}
__device__ __forceinline__ void conv3_raw(const Raw& w, float w0, float w1, float w2, float bias, float (&out)[8]) {
    float z[10];
    z[0] = w.lo; z[9] = w.hi;
    z[1] = bflo(w.r.x); z[2] = bfhi(w.r.x); z[3] = bflo(w.r.y); z[4] = bfhi(w.r.y); z[5] = bflo(w.r.z); z[6] = bfhi(w.r.z); z[7] = bflo(w.r.w); z[8] = bfhi(w.r.w);
#pragma unroll
    for (int i = 0; i < 8; ++i) out[i] = w0 * z[i] + w1 * z[i + 1] + w2 * z[i + 2] + bias;
}
__device__ __forceinline__ void put8(LAS f32x2* X, int tid, const float (&a)[8], const float (&b)[8]) {
    LAS f32x4* lo = (LAS f32x4*)(X + PX(8 * tid));
#pragma unroll
    for (int i = 0; i < 4; ++i) lo[i] = (f32x4){a[2 * i], b[2 * i], a[2 * i + 1], b[2 * i + 1]};
}
__device__ __forceinline__ void get8(const LAS f32x2* X, int tid, float (&a)[8], float (&b)[8]) {
    const LAS f32x4* lo = (const LAS f32x4*)(X + PX(8 * tid));
#pragma unroll
    for (int i = 0; i < 4; ++i) { const f32x4 v = lo[i]; a[2 * i] = v[0] * (1.0f / 8192.0f); b[2 * i] = v[1] * (1.0f / 8192.0f); a[2 * i + 1] = v[2] * (1.0f / 8192.0f); b[2 * i + 1] = v[3] * (1.0f / 8192.0f); }
}
__device__ __forceinline__ void hyena_unit(int c, int bp, const bf16_t* zhy, const float* cw, const float* cb, const float* hbias, const f32x2* kspec, const f32x2* TW, bf16_t* yht, LAS f32x2* X) {
    const int tid = tid_fresh(); const int b0 = 2 * bp, b1 = b0 + 1; const int c1 = 512 + c, c2 = 1024 + c;
    const Raw rva = raw_load(zhy + (size_t)(b0 * 1536 + c) * 4096, tid), rvb = raw_load(zhy + (size_t)(b1 * 1536 + c) * 4096, tid);
    const Raw r1a = raw_load(zhy + (size_t)(b0 * 1536 + c1) * 4096, tid), r1b = raw_load(zhy + (size_t)(b1 * 1536 + c1) * 4096, tid);
    const float p00 = cw[c], p01 = cw[1536 + c], p02 = cw[3072 + c], p0b = cb[c];
    const float p10 = cw[c1], p11 = cw[1536 + c1], p12 = cw[3072 + c1], p1b = cb[c1], hb0 = hbias[c];
    const float p20 = cw[c2], p21 = cw[1536 + c2], p22 = cw[3072 + c2], p2b = cb[c2], hb1 = hbias[512 + c];
    float va[8], vb[8];
    { const float w0 = p00, w1 = p01, w2 = p02, bs = p0b; conv3_raw(rva, w0, w1, w2, bs, va); conv3_raw(rvb, w0, w1, w2, bs, vb); }
    put8(X, tid, va, vb);
    conv_fft(X, TW, kspec + (size_t)c * 4096, tid);
    const Raw r2a = raw_load(zhy + (size_t)(b0 * 1536 + c2) * 4096, tid), r2b = raw_load(zhy + (size_t)(b1 * 1536 + c2) * 4096, tid);
    float ca[8], cbv[8]; get8(X, tid, ca, cbv);
    float za[8], zb[8];
    { const float w0 = p10, w1 = p11, w2 = p12, bs = p1b, hb = hb0;
      float xa[8], xb[8]; conv3_raw(r1a, w0, w1, w2, bs, xa); conv3_raw(r1b, w0, w1, w2, bs, xb);
#pragma unroll
      for (int i = 0; i < 8; ++i) { za[i] = xa[i] * (ca[i] + va[i] * hb); zb[i] = xb[i] * (cbv[i] + vb[i] * hb); } }
    put8(X, tid, za, zb);
    conv_fft(X, TW, kspec + (size_t)(512 + c) * 4096, tid);
    get8(X, tid, ca, cbv);
    { const float w0 = p20, w1 = p21, w2 = p22, bs = p2b, hb = hb1;
      float xa[8], xb[8]; conv3_raw(r2a, w0, w1, w2, bs, xa); conv3_raw(r2b, w0, w1, w2, bs, xb);
      u32x4 wa, wb;
      wa.x = pk2(xa[0] * (ca[0] + za[0] * hb), xa[1] * (ca[1] + za[1] * hb)); wa.y = pk2(xa[2] * (ca[2] + za[2] * hb), xa[3] * (ca[3] + za[3] * hb));
      wa.z = pk2(xa[4] * (ca[4] + za[4] * hb), xa[5] * (ca[5] + za[5] * hb)); wa.w = pk2(xa[6] * (ca[6] + za[6] * hb), xa[7] * (ca[7] + za[7] * hb));
      wb.x = pk2(xb[0] * (cbv[0] + zb[0] * hb), xb[1] * (cbv[1] + zb[1] * hb)); wb.y = pk2(xb[2] * (cbv[2] + zb[2] * hb), xb[3] * (cbv[3] + zb[3] * hb));
      wb.z = pk2(xb[4] * (cbv[4] + zb[4] * hb), xb[5] * (cbv[5] + zb[5] * hb)); wb.w = pk2(xb[6] * (cbv[6] + zb[6] * hb), xb[7] * (cbv[7] + zb[7] * hb));
      *(u32x4*)(yht + (size_t)(b0 * 512 + c) * 4096 + 8 * tid) = wa;
      *(u32x4*)(yht + (size_t)(b1 * 512 + c) * 4096 + 8 * tid) = wb; }
    __syncthreads();
}
}

__device__ __forceinline__ void transpose_item(const float* W, int K, int N, bf16_t* WT, LAS float* scr, int item, int lane, bool UPPERM) {
    const int nblk = N / 32, kb = item / nblk, nb = item % nblk, k0 = 64 * kb, n0 = 32 * nb;
    float tv[32];
#pragma unroll
    for (int i = 0; i < 32; ++i) tv[i] = W[(size_t)(k0 + 2 * i + (lane >> 5)) * N + n0 + (lane & 31)];
#pragma unroll
    for (int i = 0; i < 32; ++i) scr[(2 * i + (lane >> 5)) * 33 + (lane & 31)] = tv[i];
    asm volatile("s_waitcnt lgkmcnt(0)" ::: "memory");
    const int c = lane & 7;
#pragma unroll
    for (int j = 0; j < 4; ++j) { const int n = (lane >> 3) + 8 * j; const LAS float* s = scr + (8 * c) * 33 + n;
        u32x4 o; o.x = pk2(s[0 * 33], s[1 * 33]); o.y = pk2(s[2 * 33], s[3 * 33]); o.z = pk2(s[4 * 33], s[5 * 33]); o.w = pk2(s[6 * 33], s[7 * 33]);
        int dn = n0 + n; if (UPPERM) { const int c2 = dn >= DFF ? dn - DFF : dn; dn = 256 * (c2 >> 7) + (dn >= DFF ? 128 : 0) + (c2 & 127); }
        *(u32x4*)(WT + (size_t)dn * K + k0 + 8 * c) = o; }
    asm volatile("s_waitcnt lgkmcnt(0)" ::: "memory");
}
__device__ __forceinline__ void ln_row(const float* xrow, const float* g, const float* bb, int lane, f32x4 (&v)[4], float& mean, float& rstd) {
    const f32x4* xr = (const f32x4*)xrow + lane; float s = 0.f;
#pragma unroll
    for (int j = 0; j < 4; ++j) { v[j] = xr[64 * j]; s += (v[j][0] + v[j][1]) + (v[j][2] + v[j][3]); }
    mean = wave_sum(s) * (1.f / D); float s2 = 0.f;
#pragma unroll
    for (int j = 0; j < 4; ++j) { v[j] = v[j] - mean; s2 += (v[j][0] * v[j][0] + v[j][1] * v[j][1]) + (v[j][2] * v[j][2] + v[j][3] * v[j][3]); }
    rstd = 1.f / sqrtf(wave_sum(s2) * (1.f / D) + LN_EPS);
#pragma unroll
    for (int j = 0; j < 4; ++j) { const f32x4 gg = ((const f32x4*)g)[64 * j + lane], b4 = ((const f32x4*)bb)[64 * j + lane]; v[j] = v[j] * rstd * gg + b4; }
}

__device__ __forceinline__ void ln_row2_bf16(const bf16_t* xa, const bf16_t* xb, const float* g, const float* bb, int lane, f32x4 (&va)[4], f32x4 (&vb)[4], float& ma, float& ra, float& mb, float& rb) {
    const u32x4 a0 = ((const u32x4*)xa)[lane], a1 = ((const u32x4*)xa)[64 + lane], b0 = ((const u32x4*)xb)[lane], b1 = ((const u32x4*)xb)[64 + lane];
    unpack8(a0, va[0], va[1]); unpack8(a1, va[2], va[3]); unpack8(b0, vb[0], vb[1]); unpack8(b1, vb[2], vb[3]);
    float sa = 0.f, sb = 0.f;
#pragma unroll
    for (int j = 0; j < 4; ++j) { sa += (va[j][0] + va[j][1]) + (va[j][2] + va[j][3]); sb += (vb[j][0] + vb[j][1]) + (vb[j][2] + vb[j][3]); }
    sa = wave_sum(sa); sb = wave_sum(sb);
    ma = sa * (1.f / D); mb = sb * (1.f / D); float qa = 0.f, qb = 0.f;
#pragma unroll
    for (int j = 0; j < 4; ++j) { va[j] = va[j] - ma; vb[j] = vb[j] - mb;
        qa += (va[j][0] * va[j][0] + va[j][1] * va[j][1]) + (va[j][2] * va[j][2] + va[j][3] * va[j][3]);
        qb += (vb[j][0] * vb[j][0] + vb[j][1] * vb[j][1]) + (vb[j][2] * vb[j][2] + vb[j][3] * vb[j][3]); }
    qa = wave_sum(qa); qb = wave_sum(qb);
    ra = 1.f / sqrtf(qa * (1.f / D) + LN_EPS); rb = 1.f / sqrtf(qb * (1.f / D) + LN_EPS);
#pragma unroll
    for (int j = 0; j < 4; ++j) { const int col = 512 * (j >> 1) + 8 * lane + 4 * (j & 1); const f32x4 gg = *(const f32x4*)(g + col), b4 = *(const f32x4*)(bb + col); va[j] = va[j] * ra * gg + b4; vb[j] = vb[j] * rb * gg + b4; }
}
__device__ __forceinline__ void ln_load2(const float* xa, const float* xb, int lane, f32x4 (&va)[4], f32x4 (&vb)[4]) {
    const f32x4* pa = (const f32x4*)xa + lane; const f32x4* pb = (const f32x4*)xb + lane;
#pragma unroll
    for (int j = 0; j < 4; ++j) { va[j] = pa[64 * j]; vb[j] = pb[64 * j]; }
}
__device__ __forceinline__ void ln_fin2(const float* g, const float* bb, int lane, f32x4 (&va)[4], f32x4 (&vb)[4], float& ma, float& ra, float& mb, float& rb) {
    float sa = 0.f, sb = 0.f;
#pragma unroll
    for (int j = 0; j < 4; ++j) { sa += (va[j][0] + va[j][1]) + (va[j][2] + va[j][3]); sb += (vb[j][0] + vb[j][1]) + (vb[j][2] + vb[j][3]); }
    sa = wave_sum(sa); sb = wave_sum(sb);
    ma = sa * (1.f / D); mb = sb * (1.f / D); float qa = 0.f, qb = 0.f;
#pragma unroll
    for (int j = 0; j < 4; ++j) { va[j] = va[j] - ma; vb[j] = vb[j] - mb;
        qa += (va[j][0] * va[j][0] + va[j][1] * va[j][1]) + (va[j][2] * va[j][2] + va[j][3] * va[j][3]);
        qb += (vb[j][0] * vb[j][0] + vb[j][1] * vb[j][1]) + (vb[j][2] * vb[j][2] + vb[j][3] * vb[j][3]); }
    qa = wave_sum(qa); qb = wave_sum(qb);
    ra = 1.f / sqrtf(qa * (1.f / D) + LN_EPS); rb = 1.f / sqrtf(qb * (1.f / D) + LN_EPS);
#pragma unroll
    for (int j = 0; j < 4; ++j) { const f32x4 gg = ((const f32x4*)g)[64 * j + lane], b4 = ((const f32x4*)bb)[64 * j + lane]; va[j] = va[j] * ra * gg + b4; vb[j] = vb[j] * rb * gg + b4; }
}

#define RLX_AGENT __ATOMIC_RELAXED, __HIP_MEMORY_SCOPE_AGENT
#define XB_TMO      128
#define XB_XCNT(j)  (256  + 64 * (j))
#define XB_XSUB(j)  (1280 + 64 * (j))
#define XB_XGEN(j)  (2304 + 64 * (j))
#define XB_TOP      3328
#define XB_TOPGEN   3392
#define XCD_BAR_WORDS 3456
#define XB_SPIN_CAP (1u << 18)

__device__ __forceinline__ unsigned xb_ld(unsigned* p)              { return __hip_atomic_load(p, __ATOMIC_RELAXED, __HIP_MEMORY_SCOPE_AGENT); }
__device__ __forceinline__ unsigned xb_add(unsigned* p, unsigned v) { return __hip_atomic_fetch_add(p, v, __ATOMIC_RELAXED, __HIP_MEMORY_SCOPE_AGENT); }
__device__ __forceinline__ unsigned xb_xcc_id() { return (unsigned)__builtin_amdgcn_s_getreg((3 << 11) | 20) & 0xFu; }
#define XB_SPIN(cond, bar) do { unsigned _sp = 0; while (cond) { __builtin_amdgcn_s_sleep(1); \
    if ((++_sp & 255u) == 0u) { if (xb_ld(&(bar)[XB_TMO])) break; if (_sp > XB_SPIN_CAP) { atomicAdd(&(bar)[XB_TMO], 1u); break; } } } } while (0)

struct XcdBarrier {
    unsigned* bar; unsigned x;
    volatile LAS unsigned* st;
};

__device__ __forceinline__ XcdBarrier xcd_barrier_post(unsigned* bar, volatile LAS unsigned* st) {
    XcdBarrier b; b.bar = bar; b.x = xb_xcc_id(); b.st = st;
    if (threadIdx.x == 0) (void)xb_add(&bar[XB_XCNT(b.x)], 1u);
    return b;
}
__device__ __forceinline__ void xcd_barrier_complete(unsigned* bar, unsigned x, unsigned& nloc, unsigned& nx) {
    const unsigned G = gridDim.x * gridDim.y * gridDim.z;
    unsigned sum, cnt, mine, sp = 0u;
    for (;;) {
        sum = 0u; cnt = 0u; mine = 0u;
#pragma unroll
        for (unsigned j = 0; j < 16; ++j) { const unsigned c = xb_ld(&bar[XB_XCNT(j)]); sum += c; cnt += (c > 0u) ? 1u : 0u; mine = (j == x) ? c : mine; }
        if (sum == G) break;
        __builtin_amdgcn_s_sleep(1);
        if ((++sp & 255u) == 0u) { if (xb_ld(&bar[XB_TMO])) break; if (sp > XB_SPIN_CAP) { atomicAdd(&bar[XB_TMO], 1u); break; } }
    }
    nloc = mine > 0u ? mine : 1u; nx = cnt > 0u ? cnt : 1u;
}

__device__ __forceinline__ void xcd_barrier(const XcdBarrier& b) {
    asm volatile("s_waitcnt vmcnt(0)" ::: "memory");
    __syncthreads();
    if (threadIdx.x == 0) {
        unsigned* bar = b.bar;
        __builtin_amdgcn_s_waitcnt(0);
        unsigned nloc = b.st[0], nx = b.st[1];
        if (nloc == 0u) { xcd_barrier_complete(bar, b.x, nloc, nx); b.st[0] = nloc; b.st[1] = nx; }
        const unsigned old = xb_add(&bar[XB_XSUB(b.x)], 1u);
        const unsigned gen = old / nloc;
        if (old + 1u == (gen + 1u) * nloc) {
            __builtin_amdgcn_fence(__ATOMIC_RELEASE, "agent");
            asm volatile("s_waitcnt vmcnt(0)" ::: "memory");
            const unsigned og = xb_add(&bar[XB_TOP], 1u);
            const unsigned tg = og / nx;
            if (og + 1u == (tg + 1u) * nx) xb_add(&bar[XB_TOPGEN], 1u);
            else XB_SPIN(xb_ld(&bar[XB_TOPGEN]) == tg, bar);
            __builtin_amdgcn_fence(__ATOMIC_ACQUIRE, "agent");
            xb_add(&bar[XB_XGEN(b.x)], 1u);
            asm volatile("s_waitcnt vmcnt(0)" ::: "memory");
        } else {
            XB_SPIN(xb_ld(&bar[XB_XGEN(b.x)]) == gen, bar);
            __builtin_amdgcn_fence(__ATOMIC_ACQUIRE, "agent");
            asm volatile("s_waitcnt vmcnt(0)" ::: "memory");
        }
    }
    __syncthreads();
}

struct Params { const float* in[36]; float* out; unsigned char* ws; };
typedef const __attribute__((address_space(4))) Params* KPtr;
__device__ __forceinline__ KPtr kargs() { KPtr k = (KPtr)__builtin_amdgcn_kernarg_segment_ptr(); asm volatile("" : "+s"(k)); return k; }
#define WSP(T, off) ((T*)(kp->ws + (off)))
#define PROBE_T(k, slot) do { if (PROBE_PH == (k) && blockIdx.x == 0 && threadIdx.x == 0) { KPtr kq = kargs(); ((unsigned long long*)(kq->ws + 800 * 1024))[slot] = __builtin_amdgcn_s_memrealtime(); } } while (0)
#define TIDS() const int tid = tid_fresh(), lane = tid & 63, wave = __builtin_amdgcn_readfirstlane(tid >> 6); const int gw = vcu * 8 + wave; (void)lane; (void)gw

__global__ void __launch_bounds__(512, 2) fwd_kernel(Params p) {
    extern __shared__ __attribute__((aligned(16))) unsigned char lds_raw[];
    LAS unsigned char* lds = (LAS unsigned char*)lds_raw;
    cg::grid_group grid = cg::this_grid();
    const int bx = blockIdx.x, G = gridDim.x;
    { volatile LAS unsigned* st = (volatile LAS unsigned*)(lds + LDS_MISC); if (threadIdx.x < 4) st[threadIdx.x] = 0u; }
    __syncthreads();
    const XcdBarrier xbar = xcd_barrier_post((unsigned*)(kargs()->ws + WS_BAR), (volatile LAS unsigned*)(lds + LDS_MISC));
    const int vcu = (G % 8 == 0) ? (bx % 8) * (G / 8) + bx / 8 : bx;
    const int NGW = G * 8;
    PROBE_T(0, 0);
    if (PH(0)) {
        KPtr kp = kargs();
        TIDS();
        f32x2* rope = WSP(f32x2, WS_ROPE); f32x2* TW = WSP(f32x2, WS_TW); float* modp = WSP(float, WS_MODP); bf16_t* FILT = WSP(bf16_t, WS_FILT);
        LAS float* SC = (LAS float*)lds;
        { const float* cin = kp->in[1]; const float* cctx = kp->in[3]; float cv[18];
#pragma unroll
          for (int j = 0; j < 16; ++j) cv[j] = cin[tid + 512 * j];
          cv[16] = cctx[tid]; cv[17] = cctx[tid + 512];
#pragma unroll
          for (int j = 0; j < 18; ++j) SC[tid + 512 * j] = cv[j] * fast_sigmoid(cv[j]); }
        { const int gt = bx * 512 + tid;
          if (gt < 4096) { float sn, cs; sincospif((float)gt * (1.0f / 4096.0f), &sn, &cs); TW[gt] = (f32x2){cs, sn}; }
          else if (gt < 5120) { const int e = gt - 4096, pos = e >> 4, j = e & 15; const float inv = powf(10000.0f, -(float)(2 * j) / 32.0f); const float ang = (float)pos * inv; rope[e] = (f32x2){cosf(ang), sinf(ang)}; } }
        {
            LAS float* zf = (LAS float*)(lds + 40960);
            LAS float* hA = zf + 16 * 33 + 16;
            LAS float* hB = hA + 1024;
            const int t0 = 16 * bx;
            for (int idx = tid; idx < 16 * 33; idx += 512) {
                const int pp = idx / 33, i = idx % 33, t = t0 + pp; float val;
                if (i == 0) val = (float)t / 4095.0f;
                else { const int band = (i - 1) & 15; const float fv = 1e-4f + (float)band * ((15.0f - 1e-4f) / 15.0f); const float wv = (6.283185307179586f / 4096.0f) * (float)t; const float arg = fv * wv; val = (i <= 16) ? cosf(arg) : -sinf(arg); }
                zf[idx] = val;
            }
            __syncthreads();
            const float *w1 = kp->in[11], *b1 = kp->in[12], *w2 = kp->in[13], *b2 = kp->in[14], *w3 = kp->in[15], *b3 = kp->in[16], *fq = kp->in[17], *wout = kp->in[18];
            LAS float* WL = hB + 1024;
            for (int i = tid; i < 33 * 64; i += 512) WL[i] = w1[i];
            __syncthreads();
            for (int idx = tid; idx < 1024; idx += 512) { const int f = idx & 63, pp = idx >> 6; float s = b1[f];
#pragma unroll 11
                for (int i = 0; i < 33; ++i) s += zf[pp * 33 + i] * WL[i * 64 + f];
                hA[f * 16 + pp] = sinf(fq[f] * s); }
            __syncthreads();
            for (int i = tid; i < 4096; i += 512) WL[i] = w2[i];
            __syncthreads();
            for (int idx = tid; idx < 1024; idx += 512) { const int f = idx & 63, pp = idx >> 6; float s = b2[f];
#pragma unroll 16
                for (int k = 0; k < 64; ++k) s += hA[k * 16 + pp] * WL[k * 64 + f];
                hB[f * 16 + pp] = sinf(fq[64 + f] * s); }
            __syncthreads();
            for (int i = tid; i < 4096; i += 512) WL[i] = w3[i];
            __syncthreads();
            for (int idx = tid; idx < 1024; idx += 512) { const int f = idx & 63, pp = idx >> 6; float s = b3[f];
#pragma unroll 16
                for (int k = 0; k < 64; ++k) s += hB[k * 16 + pp] * WL[k * 64 + f];
                hA[f * 16 + pp] = sinf(fq[128 + f] * s); }
            __syncthreads();
            for (int q = 0; q < 4; ++q) {
                const int n = wave * 256 + q * 64 + lane;
                f32x4 a0 = {0.f, 0.f, 0.f, 0.f}, a1 = a0, a2 = a0, a3 = a0;
#pragma unroll 1
                for (int kb = 0; kb < 64; kb += 16) {
                    float wv[16];
#pragma unroll
                    for (int k = 0; k < 16; ++k) wv[k] = wout[(kb + k) * 2048 + n];
#pragma unroll
                    for (int k = 0; k < 16; ++k) { const float w = wv[k]; const LAS f32x4* hp = (const LAS f32x4*)(hA + (kb + k) * 16);
                        a0 += hp[0] * w; a1 += hp[1] * w; a2 += hp[2] * w; a3 += hp[3] * w; }
                }
                const int cch = n & 511; const float mind = -3.0701134573253945f, maxd = -15.350567286626973f;
                const float delta = fabsf(mind + (float)cch * ((maxd - mind) / 511.0f));
                f32x4 dc[4];
#pragma unroll
                for (int g4 = 0; g4 < 4; ++g4)
#pragma unroll
                    for (int e = 0; e < 4; ++e) dc[g4][e] = __builtin_amdgcn_exp2f(-((float)(t0 + 4 * g4 + e) / 4095.0f) * delta * 1.4426950408889634f);
                u32x4* dst = (u32x4*)(FILT + (size_t)n * 4096 + t0);
                dst[0] = pack8(a0 * dc[0], a1 * dc[1]); dst[1] = pack8(a2 * dc[2], a3 * dc[3]);
            }
        }
        if (wave < 3) {
            const int item = bx * 3 + wave; const int kc = item / 96, nb = item % 96, n = nb * 64 + lane;
            const float* wa = kp->in[6];
            float acc[9];
#pragma unroll
            for (int i = 0; i < 9; ++i) acc[i] = 0.f;
#pragma unroll 32
            for (int k = kc * 128; k < kc * 128 + 128; ++k) { const float w = wa[(size_t)k * NADA + n];
#pragma unroll
                for (int i = 0; i < 9; ++i) acc[i] += SC[i * 1024 + k] * w; }
#pragma unroll
            for (int i = 0; i < 9; ++i) modp[(size_t)(kc * 9 + i) * NADA + n] = acc[i];
        }
        {
            LAS float* scr = (LAS float*)(lds + 65536 + wave * 8448);
            constexpr int I_IN = 16 * 160, I_HY = 8 * 32, I_AT = 8 * 32, I_OUT = 16 * 32, I_UP = 16 * 176, I_DN = 44 * 32;
            constexpr int NIT = I_IN + I_HY + I_AT + I_OUT + I_UP + I_DN;
            for (int it = gw; it < NIT; it += NGW) {
                int r = it; const float* W; bf16_t* WT; int K, N; bool up = false;
                if (r < I_IN) { W = kp->in[8]; K = 1024; N = INC; WT = WSP(bf16_t, WS_WIN); }
                else if ((r -= I_IN) < I_HY) { W = kp->in[25]; K = 512; N = 1024; WT = WSP(bf16_t, WS_WHY); }
                else if ((r -= I_HY) < I_AT) { W = kp->in[26]; K = 512; N = 1024; WT = WSP(bf16_t, WS_WAT); }
                else if ((r -= I_AT) < I_OUT) { W = kp->in[27]; K = 1024; N = 1024; WT = WSP(bf16_t, WS_WOUT); }
                else if ((r -= I_OUT) < I_UP) { W = kp->in[30]; K = 1024; N = NUP; WT = WSP(bf16_t, WS_WUP); up = true; }
                else { r -= I_UP; W = kp->in[33]; K = DFF; N = 1024; WT = WSP(bf16_t, WS_WDN); }
                transpose_item(W, K, N, WT, scr, r, lane, up);
            }
        }
    }
    if (G == 0x7fffffff) grid.sync();
    xcd_barrier(xbar);

    PROBE_T(0, 1); PROBE_T(1, 0);
    if (PH(1)) {
        KPtr kp = kargs();
        TIDS();
        const float* x = kp->in[0]; const float* ctx = kp->in[2]; const float *ln_in_g = kp->in[4], *ln_in_b = kp->in[5];
        float* st0 = WSP(float, WS_ST0); float* mod = WSP(float, WS_MOD); const float* modp = WSP(float, WS_MODP); bf16_t *XM = WSP(bf16_t, WS_XM), *CTXM = WSP(bf16_t, WS_CTXM);
        LAS float* SH = (LAS float*)(lds + 73728);
        const int b = bx >> 5;
        const float* bada = kp->in[7];
        { float sacc[8];
#pragma unroll
          for (int i = 0; i < 8; ++i) { const int j = tid + 512 * i, row = j < 2048 ? b : 8, col = j & 2047; float s = bada[col];
#pragma unroll
              for (int kc = 0; kc < 8; ++kc) s += modp[(size_t)(kc * 9 + row) * NADA + col];
              sacc[i] = s; }
#pragma unroll
          for (int i = 0; i < 8; ++i) SH[tid + 512 * i] = sacc[i]; }
        if (tid < 216) { const int e = bx * 216 + tid, row = e / NADA, col = e - row * NADA;
            float s = bada[col];
#pragma unroll
            for (int kc = 0; kc < 8; ++kc) s += modp[(size_t)(kc * 9 + row) * NADA + col];
            mod[e] = s; }
        __syncthreads();
        f32x4 na[4], nb[4];
        ln_load2(x + (size_t)(bx * 128 + wave) * D, x + (size_t)(bx * 128 + 8 + wave) * D, lane, na, nb);
        for (int ip = 0; ip < 8; ++ip) {
            const int ra_ = bx * 128 + (2 * ip) * 8 + wave, rb_ = ra_ + 8;
            f32x4 va[4], vb[4]; float ma, sa, mb, sb;
#pragma unroll
            for (int j = 0; j < 4; ++j) { va[j] = na[j]; vb[j] = nb[j]; }
            if (ip < 7) ln_load2(x + (size_t)(ra_ + 16) * D, x + (size_t)(rb_ + 16) * D, lane, na, nb);
            ln_fin2(ln_in_g, ln_in_b, lane, va, vb, ma, sa, mb, sb);
            if (lane == 0) { *(f32x2*)(st0 + 2 * ra_) = (f32x2){ma, sa}; *(f32x2*)(st0 + 2 * rb_) = (f32x2){mb, sb}; }
#pragma unroll
            for (int j = 0; j < 4; ++j) { const int col = 256 * j + 4 * lane;
                const f32x4 s4 = *(const LAS f32x4*)(SH + col), c4 = *(const LAS f32x4*)(SH + 1024 + col);
                const f32x4 oa = va[j] * (c4 + 1.0f) + s4, ob = vb[j] * (c4 + 1.0f) + s4;
                u32x2 w; w.x = pk2(oa[0], oa[1]); w.y = pk2(oa[2], oa[3]); *(u32x2*)(XM + (size_t)ra_ * D + col) = w;
                w.x = pk2(ob[0], ob[1]); w.y = pk2(ob[2], ob[3]); *(u32x2*)(XM + (size_t)rb_ * D + col) = w; }
        }
        {
            const int r = bx * 8 + wave;
            f32x4 v[4]; float mean, rstd;
            ln_row(ctx + (size_t)r * D, ln_in_g, ln_in_b, lane, v, mean, rstd);
#pragma unroll
            for (int j = 0; j < 4; ++j) { const int col = 256 * j + 4 * lane;
                const f32x4 s4 = *(const LAS f32x4*)(SH + 2048 + col), c4 = *(const LAS f32x4*)(SH + 3072 + col);
                const f32x4 o = v[j] * (c4 + 1.0f) + s4;
                u32x2 w; w.x = pk2(o[0], o[1]); w.y = pk2(o[2], o[3]); *(u32x2*)(CTXM + (size_t)r * D + col) = w; }
        }
    }
    xcd_barrier(xbar);

    PROBE_T(1, 1); PROBE_T(2, 0);
    if (PH(2)) {
        KPtr kp = kargs();
        pg8::Gemm g{WSP(bf16_t, WS_XM), WSP(bf16_t, WS_WIN), MROWS, INC, D}; pg8::StaticOrder S; S.init(MROWS, INC, G, bx);
        EpiIn E{WSP(bf16_t, WS_ZHY), WSP(bf16_t, WS_Q), WSP(bf16_t, WS_K), WSP(bf16_t, WS_V), WSP(bf16_t, WS_SG), WSP(f32x2, WS_ROPE)};
        pg8::gemm_phase<EpiIn, pg8::StaticOrder, true, true>(lds, g, S, E);
    }
    if (PH(2)) {
        KPtr kp = kargs();
        pg8::Gemm g{WSP(bf16_t, WS_CTXM), WSP(bf16_t, WS_WIN) + (size_t)2048 * D, MCTX, 1024, D}; pg8::StaticOrder S; S.init(MCTX, 1024, G, bx);
        EpiCtx E{WSP(bf16_t, WS_K), WSP(bf16_t, WS_V)};
        pg8::gemm_phase<EpiCtx, pg8::StaticOrder, true, true>(lds, g, S, E);
    }
#if EN_HY
    if (PH(2) && bx >= 32) {
        KPtr kp = kargs(); TIDS();
        const f32x2* TW = WSP(f32x2, WS_TW); const bf16_t* FILT = WSP(bf16_t, WS_FILT); f32x2* KSPEC = WSP(f32x2, WS_KSPEC);
        LAS f32x2* X = (LAS f32x2*)lds;
        LAS f32x2* XB = X + 8704;
        for (int pr = bx - 32; pr < 512; pr += G - 32) {
            __syncthreads();
#pragma unroll
            for (int u = 0; u < 2; ++u) {
                const int fid = 2 * pr + u, order = fid >> 9, c = fid & 511;
                const bf16_t* fwd = FILT + (size_t)(order * 1024 + c) * 4096; const bf16_t* bwd = fwd + (size_t)512 * 4096;
                LAS f32x2* Xu = u ? XB : X;
                float fv[16];
#pragma unroll
                for (int r = 0; r < 8; ++r) { fv[r] = bf1(fwd[tid + 512 * r]); const int jb = 4096 - tid - 512 * r; fv[8 + r] = bf1(bwd[jb > 4095 ? 4095 : jb]); }
                if (tid == 0) fv[8] = 0.f;
#pragma unroll
                for (int r = 0; r < 16; ++r) Xu[hy::PX(tid + 512 * r)] = (f32x2){fv[r], 0.f};
            }
            __syncthreads(); hy::pass16<4096, false>(X, TW, tid); hy::pass16<4096, false>(XB, TW, tid);
            __syncthreads(); hy::pass16<256, false>(X, TW, tid); hy::pass16<256, false>(XB, TW, tid);
            __syncthreads(); hy::pass32<true>(tid < 256 ? X : XB, KSPEC + (size_t)(2 * pr + (tid >> 8)) * 4096, nullptr, tid & 255);
        }
    }
#endif
    xcd_barrier(xbar);

    PROBE_T(2, 1); PROBE_T(3, 0);
    if (PH(3)) {
        KPtr kp = kargs();
        TIDS();
#if EN_ATT
        float lam;
        { const float a = kp->in[20][lane] * kp->in[21][lane], bq = kp->in[22][lane] * kp->in[23][lane]; lam = expf(wave_sum(a)) - expf(wave_sum(bq)) + LAM_INIT; }
        for (int i = 0; i < 4; ++i) { const int unit = (((vcu >> 5) * 4 + i) << 5) | (vcu & 31); if (unit < 1024) att::attn_unit(unit >> 7, (unit >> 5) & 3, unit & 31, WSP(bf16_t, WS_Q), WSP(bf16_t, WS_K), WSP(bf16_t, WS_V), WSP(bf16_t, WS_ON), lam, kp->in[24], lds); }
#else
        for (size_t i = (size_t)bx * 512 + tid; i < (size_t)MROWS * 512 / 8; i += (size_t)G * 512) (WSP(u32x4, WS_ON))[i] = (u32x4){0u, 0u, 0u, 0u};
#endif
        PROBE_T(3, 1); PROBE_T(4, 0);
#if EN_HY
        {
            unsigned* qctr = (unsigned*)(kp->ws + WS_BAR + 14336);
            volatile LAS unsigned* qs = (volatile LAS unsigned*)(lds + LDS_MISC + 16);
            for (int par = 0;; par ^= 1) {
                if (tid == 0) qs[par] = __hip_atomic_fetch_add(qctr, 1u, __ATOMIC_RELAXED, __HIP_MEMORY_SCOPE_AGENT);
                __syncthreads();
                const unsigned ch = qs[par];
                if (ch >= 2048u) break;
                for (int j = 0; j < 1; ++j) { const int unit = (int)ch;
                    hy::hyena_unit(unit >> 2, unit & 3, WSP(bf16_t, WS_ZHY), kp->in[9], kp->in[10], kp->in[19], WSP(f32x2, WS_KSPEC), WSP(f32x2, WS_TW), WSP(bf16_t, WS_YHT), (LAS f32x2*)lds); }
            }
        }
#endif
    }
    xcd_barrier(xbar);

    PROBE_T(4, 1); PROBE_T(5, 0);
    if (PH(4)) {
        KPtr kp = kargs();
        TIDS();
        const bf16_t* YHT = WSP(bf16_t, WS_YHT); bf16_t* YH = WSP(bf16_t, WS_YH);
#if EN_HY
        LAS bf16_t* scr = (LAS bf16_t*)(lds + wave * 8448);
        for (int tile = gw; tile < 4096; tile += NGW) {
            const int b = tile >> 9, cb = (tile >> 6) & 7, tb = tile & 63;
            const bf16_t* src = YHT + (size_t)(b * 512 + cb * 64) * 4096 + tb * 64;
            for (int i = 0; i < 64; ++i) scr[i * 66 + lane] = src[(size_t)i * 4096 + lane];
            asm volatile("s_waitcnt lgkmcnt(0)" ::: "memory");
            bf16_t* dst = YH + (size_t)(b * 4096 + tb * 64) * 512 + cb * 64;
            for (int j = 0; j < 64; ++j) dst[(size_t)j * 512 + lane] = scr[lane * 66 + j];
            asm volatile("s_waitcnt lgkmcnt(0)" ::: "memory");
        }
#else
        for (size_t i = (size_t)bx * 512 + tid; i < (size_t)MROWS * 512 / 8; i += (size_t)G * 512) ((u32x4*)YH)[i] = (u32x4){0u, 0u, 0u, 0u};
#endif
    }
    xcd_barrier(xbar);

    PROBE_T(5, 1); PROBE_T(6, 0);
    if (PH(5)) {
        KPtr kp = kargs();
        pg8::Gemm g{WSP(bf16_t, WS_YH), WSP(bf16_t, WS_WHY), MROWS, D, 512}; pg8::StaticOrder S; S.init(MROWS, D, G, bx);
        EpiMerge<false> E{WSP(bf16_t, WS_MBUF), WSP(bf16_t, WS_SG)};
        pg8::gemm_phase<EpiMerge<false>, pg8::StaticOrder, true, true>(lds, g, S, E);
    }
    asm volatile("s_waitcnt vmcnt(0)" ::: "memory"); __syncthreads();
    if (PH(5)) {
        KPtr kp = kargs();
        pg8::Gemm g{WSP(bf16_t, WS_ON), WSP(bf16_t, WS_WAT), MROWS, D, 512}; pg8::StaticOrder S; S.init(MROWS, D, G, bx);
        EpiMerge<true> E{WSP(bf16_t, WS_MBUF), WSP(bf16_t, WS_SG)};
        pg8::gemm_phase<EpiMerge<true>, pg8::StaticOrder, true, true>(lds, g, S, E);
    }
    xcd_barrier(xbar);

    PROBE_T(6, 1); PROBE_T(7, 0);
    if (PH(6)) {
        KPtr kp = kargs();
        pg8::Gemm g{WSP(bf16_t, WS_MBUF), WSP(bf16_t, WS_WOUT), MROWS, D, D}; pg8::StaticOrder S; S.init(MROWS, D, G, bx);
        EpiOut E{kp->in[0], WSP(float, WS_ST0), kp->in[4], kp->in[5], WSP(float, WS_MOD), WSP(bf16_t, WS_R1B)};
        pg8::gemm_phase<EpiOut, pg8::StaticOrder, true, true>(lds, g, S, E);
    }
    xcd_barrier(xbar);

    PROBE_T(7, 1); PROBE_T(8, 0);
    if (PH(7)) { KPtr kp = kargs(); TIDS(); float* st1 = WSP(float, WS_ST1); const float* mod = WSP(float, WS_MOD); bf16_t* HM = WSP(bf16_t, WS_HM); const bf16_t* r1b = WSP(bf16_t, WS_R1B); const float *l1g = kp->in[28], *l1b = kp->in[29];
    for (int r = 2 * gw; r < MROWS; r += 2 * NGW) {
        f32x4 va[4], vb[4]; float ma, sa, mb, sb; const int b = r >> 12;
        ln_row2_bf16(r1b + (size_t)r * D, r1b + (size_t)(r + 1) * D, l1g, l1b, lane, va, vb, ma, sa, mb, sb);
        if (lane == 0) *(f32x4*)(st1 + 2 * r) = (f32x4){ma, sa, mb, sb};
#pragma unroll
        for (int j = 0; j < 4; ++j) { const int col = 512 * (j >> 1) + 8 * lane + 4 * (j & 1);
            const f32x4 s4 = *(const f32x4*)(mod + b * NADA + 3 * D + col), c4 = *(const f32x4*)(mod + b * NADA + 4 * D + col);
            const f32x4 oa = va[j] * (c4 + 1.0f) + s4, ob = vb[j] * (c4 + 1.0f) + s4;
            u32x2 w; w.x = pk2(oa[0], oa[1]); w.y = pk2(oa[2], oa[3]); *(u32x2*)(HM + (size_t)r * D + col) = w;
            w.x = pk2(ob[0], ob[1]); w.y = pk2(ob[2], ob[3]); *(u32x2*)(HM + (size_t)(r + 1) * D + col) = w; }
    } }
    xcd_barrier(xbar);

    PROBE_T(8, 1);
#if EN_FFN
    PROBE_T(9, 0);
    if (PH(8)) {
        KPtr kp = kargs();
        pg8::Gemm g{WSP(bf16_t, WS_HM), WSP(bf16_t, WS_WUP), MROWS, NUP, D}; pg8::StaticOrder S; S.init(MROWS, NUP, G, bx);
        EpiUpGate E{WSP(bf16_t, WS_TSC), WSP(bf16_t, WS_ACT), kp->in[31], kp->in[32], WSP(bf16_t, WS_FILT)};
        pg8::gemm_phase<EpiUpGate, pg8::StaticOrder, true, true>(lds, g, S, E);
    }
    xcd_barrier(xbar);
    PROBE_T(9, 1);
#endif
    PROBE_T(11, 0);
    if (PH(10)) {
        KPtr kp = kargs();
        pg8::Gemm g{WSP(bf16_t, WS_ACT), WSP(bf16_t, WS_WDN), MROWS, D, DFF}; pg8::StaticOrder S; S.init(MROWS, D, G, bx);
#if EN_FFN
        {
            TIDS();
            const bf16_t* ub = WSP(bf16_t, WS_FILT); bf16_t* act = WSP(bf16_t, WS_ACT); const float* cw = kp->in[31]; const float* cb = kp->in[32];
            for (int ui = 0; ui < 2; ++ui) {
                pg8::Unit u; if (!S.next(ui, u)) break;
                for (int it = tid; it < 704; it += 512) {
                    const int which = it / 352, jg = it % 352, ca = jg * 8, pn = ca >> 7, cl = ca & 127, cgt = DFF + ca;
                    const int pm = u.pm; const bool lastrow = which != 0;
                    if (lastrow ? ((pm & 15) == 15) : ((pm & 15) == 0)) continue;
                    const int R = 256 * pm + (lastrow ? 255 : 0);
                    const bf16_t* pp = ub + ((size_t)(((lastrow ? pm : pm - 1) * 22 + pn) * 4 + (lastrow ? 2 : 3))) * 256;
                    const bf16_t* pc = ub + ((size_t)((pm * 22 + pn) * 4 + (lastrow ? 3 : 0))) * 256;
                    const bf16_t* pq = ub + ((size_t)(((lastrow ? pm + 1 : pm) * 22 + pn) * 4 + (lastrow ? 0 : 1))) * 256;
                    f32x4 pA[2], cA[2], nA[2], pG[2], cG[2], nG[2];
                    unpack8(*(const u32x4*)(pp + cl), pA[0], pA[1]); unpack8(*(const u32x4*)(pc + cl), cA[0], cA[1]); unpack8(*(const u32x4*)(pq + cl), nA[0], nA[1]);
                    unpack8(*(const u32x4*)(pp + 128 + cl), pG[0], pG[1]); unpack8(*(const u32x4*)(pc + 128 + cl), cG[0], cG[1]); unpack8(*(const u32x4*)(pq + 128 + cl), nG[0], nG[1]);
                    f32x4 o[2];
#pragma unroll
                    for (int n = 0; n < 2; ++n) {
                        const f32x4 av = *(const f32x4*)(cw + ca + 4 * n) * pA[n] + *(const f32x4*)(cw + NUP + ca + 4 * n) * cA[n] + *(const f32x4*)(cw + 2 * NUP + ca + 4 * n) * nA[n] + *(const f32x4*)(cb + ca + 4 * n);
                        const f32x4 gv = *(const f32x4*)(cw + cgt + 4 * n) * pG[n] + *(const f32x4*)(cw + NUP + cgt + 4 * n) * cG[n] + *(const f32x4*)(cw + 2 * NUP + cgt + 4 * n) * nG[n] + *(const f32x4*)(cb + cgt + 4 * n);
#pragma unroll
                        for (int e = 0; e < 4; ++e) o[n][e] = gv[e] * fast_sigmoid(gv[e]) * av[e];
                    }
                    *(u32x4*)(act + (size_t)R * DFF + ca) = pack8(o[0], o[1]);
                }
            }
            asm volatile("s_waitcnt vmcnt(0)" ::: "memory"); __syncthreads();
        }
#endif
        EpiDown E{WSP(float, WS_ST1), kp->in[28], kp->in[29], WSP(float, WS_MOD), WSP(bf16_t, WS_R1B), kp->out};
        pg8::gemm_phase<EpiDown, pg8::StaticOrder, true, true>(lds, g, S, E);
    }
    xcd_barrier(xbar);

    PROBE_T(11, 1); PROBE_T(12, 0);
    if (PH(11)) { KPtr kp = kargs(); TIDS(); float* outp = kp->out; const float *l2g = kp->in[34], *l2b = kp->in[35];
    f32x4 na[4], nb[4];
    ln_load2(outp + (size_t)(2 * gw) * D, outp + (size_t)(2 * gw + 1) * D, lane, na, nb);
    for (int r = 2 * gw; r < MROWS; r += 2 * NGW) {
        f32x4 va[4], vb[4]; float ma, sa, mb, sb;
#pragma unroll
        for (int j = 0; j < 4; ++j) { va[j] = na[j]; vb[j] = nb[j]; }
        if (r + 2 * NGW < MROWS) ln_load2(outp + (size_t)(r + 2 * NGW) * D, outp + (size_t)(r + 2 * NGW + 1) * D, lane, na, nb);
        ln_fin2(l2g, l2b, lane, va, vb, ma, sa, mb, sb);
        f32x4* oa = (f32x4*)(outp + (size_t)r * D) + lane; f32x4* ob = (f32x4*)(outp + (size_t)(r + 1) * D) + lane;
#pragma unroll
        for (int j = 0; j < 4; ++j) { oa[64 * j] = va[j]; ob[64 * j] = vb[j]; }
    } }
#ifdef EXTRA_SYNCS
    for (int i = 0; i < EXTRA_SYNCS; ++i) xcd_barrier(xbar);
#endif
    PROBE_T(12, 1);
    if (PROBE_PH >= 0 && blockIdx.x == 0 && threadIdx.x == 0) { KPtr kq = kargs(); const unsigned long long* tp = (const unsigned long long*)(kq->ws + 800 * 1024);
        const unsigned long long dt = tp[1] - tp[0], t0 = __builtin_amdgcn_s_memrealtime(); while (__builtin_amdgcn_s_memrealtime() - t0 < dt) __builtin_amdgcn_s_sleep(16); }
}

extern "C" void kernel_launch(void* const* d_in, const int* in_sizes, int n_in, void* d_out, int out_size, void* d_ws, size_t ws_size, hipStream_t stream) {
    static int grid = 0;
    if (grid == 0) {
        if (n_in != 36 || out_size != MROWS * D || ws_size < WS_END) { fprintf(stderr, "kernel_launch: unexpected shapes (n_in %d out %d ws %zu)\n", n_in, out_size, ws_size); grid = -1; return; }
        int dev = 0, cus = 0, per_cu = 0;
        hipGetDevice(&dev); hipDeviceGetAttribute(&cus, hipDeviceAttributeMultiprocessorCount, dev);
        hipFuncSetAttribute((const void*)fwd_kernel, hipFuncAttributeMaxDynamicSharedMemorySize, LDS_BYTES);
        hipOccupancyMaxActiveBlocksPerMultiprocessor(&per_cu, (const void*)fwd_kernel, 512, LDS_BYTES);
        if (per_cu < 1) { fprintf(stderr, "kernel_launch: occupancy query returned %d\n", per_cu); per_cu = 1; }
        (void)hipGetLastError();
        grid = cus;
    }
    if (grid < 0) return;
    if (hipMemsetAsync((char*)d_ws + WS_BAR, 0, 16384, stream) != hipSuccess) { fprintf(stderr, "kernel_launch: memset of the barrier words failed\n"); return; }
    Params prm{};
    for (int i = 0; i < 36; ++i) prm.in[i] = (const float*)d_in[i];
    prm.out = (float*)d_out; prm.ws = (unsigned char*)d_ws;
    void* args[] = {&prm};
    hipError_t e = hipLaunchCooperativeKernel((const void*)fwd_kernel, dim3(grid), dim3(512), args, LDS_BYTES, stream);
    if (e != hipSuccess) fprintf(stderr, "cooperative launch failed: %s (grid %d)\n", hipGetErrorString(e), grid);
}
```

```cpp
#include <hip/hip_runtime.h>
#include <hip/hip_cooperative_groups.h>
#include <cstdio>
#include <cstdint>
namespace cg = cooperative_groups;
namespace pg8 {
#define PG8_LAS __attribute__((address_space(3)))
typedef unsigned short bf16_t;
typedef short bf16x8 __attribute__((ext_vector_type(8)));
typedef float f32x4 __attribute__((ext_vector_type(4)));
typedef unsigned u32x4 __attribute__((ext_vector_type(4)));
constexpr int BM = 256, BK = 64, HALF = 128, HTB = HALF * BK * 2  , STAGE_BYTES = 8 * HTB, NXCD = 8, WGM = 4;

__host__ __device__ __forceinline__ int lds_byte(int r, int c) { const int st = (r >> 4) * 2 + (c >> 5), rr = r & 15, cc = c & 31, ob = rr * 64 + cc * 2; return st * 1024 + (ob ^ (((ob >> 9) & 1) << 5)); }
__host__ __device__ __forceinline__ void stage_rc(int b, int& R, int& C) { const int st = b / 1024, sb = b % 1024, swz = sb ^ (((sb >> 9) & 1) << 5); R = (st >> 1) * 16 + swz / 64; C = (st & 1) * 32 + (swz % 64) / 2; }
__host__ __device__ __forceinline__ int perm32(int rho) { const int n = rho >> 4, i = rho & 15; return 8 * (i >> 2) + 4 * n + (i & 3); }

struct Unit { int pm, pn; };
struct Gemm { const bf16_t* A; const bf16_t* Bt; int M, N, K; int a_rows = 256; };

struct StaticOrder {
    int nM, nN, nwg, G, c;
    __host__ __device__ void init(int M, int N, int G_, int c_) { nM = M / BM; nN = N / BM; nwg = nM * nN; G = G_; c = c_; }
    __host__ __device__ bool next(int i, Unit& u) const {
        const long L = (long)i * G + c; if (L >= nwg) return false;
        int wgid = (int)L; { const int q = nwg / NXCD, r = nwg % NXCD, xcd = wgid % NXCD, off = wgid / NXCD; wgid = (xcd < r ? xcd * (q + 1) : r * (q + 1) + (xcd - r) * q) + off; }
        const int nig = WGM * nN, gid = wgid / nig, fm = gid * WGM, gsz = (nM - fm) < WGM ? (nM - fm) : WGM;
        u.pm = fm + ((wgid % nig) % gsz); u.pn = (wgid % nig) / gsz; return true;
    }
    __device__ __forceinline__ void a_ready(const Unit&) const {}
    __device__ __forceinline__ void done(const Unit&) const {}
};
__device__ __forceinline__ unsigned cvt_pk_bf16(float lo, float hi) { unsigned r; asm volatile("v_cvt_pk_bf16_f32 %0, %1, %2" : "=v"(r) : "v"(lo), "v"(hi)); return r; }
typedef float f32x2 __attribute__((ext_vector_type(2)));
template <class Epi, class Sched, bool ALIGN_EPI = false, bool SP2 = false>
__device__ __forceinline__ void gemm_phase(PG8_LAS unsigned char* lds, const Gemm g, const Sched& S, const Epi& E) {
    int tid_l = threadIdx.x; asm volatile("" : "+v"(tid_l));
    const int tid = tid_l, wid = __builtin_amdgcn_readfirstlane(tid >> 6), lane = tid & 63, wr = wid >> 2, wc = wid & 3, fr = lane & 15, fq = lane >> 4;
    const int K = g.K, nt = K / BK;
    unsigned voffA[2], voffB[2];
#pragma unroll
    for (int i = 0; i < 2; ++i) { int R, C; stage_rc(tid * 16 + i * 8192, R, C); const int Rb = Epi::PERM ? ((R & ~31) + perm32(R & 31)) : R;
        voffA[i] = (unsigned)(R * K + C) * 2u; voffB[i] = (unsigned)(Rb * K + C) * 2u; }
    const size_t kstep = (size_t)(BK * 2);
    const size_t hstep = (size_t)HALF * K * 2;
    const size_t tstep = 2 * hstep;
    const size_t atstep = (size_t)g.a_rows * K * 2;
    const unsigned ldsw = (unsigned)wid * 1024u;
    const int aoff = lds_byte(wr * 64 + fr, fq * 8), boff = lds_byte(wc * 32 + fr, fq * 8);
#define PG8_SA(b, h) (((b) * 2 + (h)) * HTB)
#define PG8_SB(b, h) ((4 + (b) * 2 + (h)) * HTB)
#define PG8_STAGE(bufoff, gbase, voff) do { _Pragma("unroll") for (int _i = 0; _i < 2; ++_i) \
        __builtin_amdgcn_global_load_lds((const unsigned*)((const char*)(gbase) + (voff)[_i]), (PG8_LAS unsigned*)(lds + (bufoff) + ldsw + _i * 8192), 16, 0, 0); } while (0)
#define PG8_LDA(dst, b, h) do { _Pragma("unroll") for (int m = 0; m < 4; ++m) _Pragma("unroll") for (int k = 0; k < 2; ++k) dst[m][k] = *(const PG8_LAS bf16x8*)(lds + PG8_SA(b, h) + aoff + m * 2048 + k * 1024); } while (0)
#define PG8_LDB(dst, b, h) do { _Pragma("unroll") for (int n = 0; n < 2; ++n) _Pragma("unroll") for (int k = 0; k < 2; ++k) dst[n][k] = *(const PG8_LAS bf16x8*)(lds + PG8_SB(b, h) + boff + n * 2048 + k * 1024); } while (0)
#define PG8_MMA(ai, bj, At, Bt) do { __builtin_amdgcn_s_setprio(1); _Pragma("unroll") for (int m = 0; m < 4; ++m) _Pragma("unroll") for (int n = 0; n < 2; ++n) _Pragma("unroll") for (int k = 0; k < 2; ++k) \
        acc[ai][bj][m][n] = __builtin_amdgcn_mfma_f32_16x16x32_bf16(Bt[n][k], At[m][k], acc[ai][bj][m][n], 0, 0, 0); __builtin_amdgcn_s_setprio(0); } while (0)
#define PG8_WAIT_V(n) asm volatile("s_waitcnt vmcnt(" #n ")" ::: "memory")
#define PG8_WAIT_L(n) asm volatile("s_waitcnt lgkmcnt(" #n ")" ::: "memory")
#define PG8_BAR __builtin_amdgcn_s_barrier()
#define PG8_SCHED __builtin_amdgcn_sched_barrier(0)
    Unit cur, nxt; int ui = 0;
    if (!S.next(0, cur)) return;
    f32x4 acc[2][2][4][2];
#pragma unroll
    for (int a = 0; a < 2; ++a)
#pragma unroll
        for (int b = 0; b < 2; ++b)
#pragma unroll
            for (int m = 0; m < 4; ++m)
#pragma unroll
                for (int n = 0; n < 2; ++n) acc[a][b][m][n] = (f32x4){0.f, 0.f, 0.f, 0.f};
    bf16x8 At[4][2], B0[2][2], B1[2][2];
    const char* cA = (const char*)g.A + (size_t)cur.pm * atstep; const char* cB = (const char*)g.Bt + (size_t)cur.pn * tstep;
    S.a_ready(cur);
    if constexpr (SP2) {
        PG8_STAGE(PG8_SB(0, 0), cB, voffB); PG8_STAGE(PG8_SB(0, 1), cB + hstep, voffB); PG8_STAGE(PG8_SA(0, 0), cA, voffA); PG8_STAGE(PG8_SA(0, 1), cA + hstep, voffA);
        if (wr == 1) PG8_BAR;
        PG8_WAIT_V(2); PG8_BAR;
        PG8_STAGE(PG8_SB(1, 0), cB + kstep, voffB); PG8_STAGE(PG8_SA(1, 0), cA + kstep, voffA); PG8_STAGE(PG8_SB(1, 1), cB + hstep + kstep, voffB);
        PG8_WAIT_V(6); PG8_BAR;
    } else {
        PG8_STAGE(PG8_SB(0, 0), cB, voffB); PG8_STAGE(PG8_SA(0, 0), cA, voffA); PG8_STAGE(PG8_SB(0, 1), cB + hstep, voffB); PG8_STAGE(PG8_SA(0, 1), cA + hstep, voffA);
        if (wr == 1) PG8_BAR;
        PG8_WAIT_V(4); PG8_BAR;
        PG8_STAGE(PG8_SB(1, 0), cB + kstep, voffB); PG8_STAGE(PG8_SA(1, 0), cA + kstep, voffA); PG8_STAGE(PG8_SB(1, 1), cB + hstep + kstep, voffB);
        PG8_WAIT_V(6); PG8_BAR;
    }
    for (;;) {
        const bool has_next = S.next(ui + 1, nxt);
        const char* nA = has_next ? (const char*)g.A + (size_t)nxt.pm * atstep : cA; const char* nB = has_next ? (const char*)g.Bt + (size_t)nxt.pn * tstep : cB;
        for (int t = 0; t < nt; t += 2) {
            const bool last = (t == nt - 2);
            const char* a1 = cA + (size_t)(t + 1) * kstep;
            const char* a2 = last ? nA : cA + (size_t)(t + 2) * kstep; const char* b2 = last ? nB : cB + (size_t)(t + 2) * kstep;
            const char* a3 = a2 + kstep; const char* b3 = b2 + kstep;
            if (last && has_next) S.a_ready(nxt);
            if constexpr (SP2) {
            PG8_LDB(B0, 0, 0); PG8_LDB(B1, 0, 1); PG8_SCHED; PG8_LDA(At, 0, 0); PG8_STAGE(PG8_SA(1, 1), a1 + hstep, voffA);
            PG8_WAIT_V(8); PG8_WAIT_L(0); PG8_BAR; PG8_MMA(0, 0, At, B0); PG8_MMA(0, 1, At, B1); PG8_BAR; PG8_SCHED;
            PG8_LDA(At, 0, 1); PG8_STAGE(PG8_SB(0, 0), b2, voffB); PG8_STAGE(PG8_SB(0, 1), b2 + hstep, voffB); PG8_STAGE(PG8_SA(0, 0), a2, voffA);
            PG8_WAIT_V(8); PG8_WAIT_L(0); PG8_BAR; PG8_MMA(1, 0, At, B0); PG8_MMA(1, 1, At, B1); PG8_BAR; PG8_SCHED;
            PG8_LDB(B0, 1, 0); PG8_LDB(B1, 1, 1); PG8_SCHED; PG8_LDA(At, 1, 0); PG8_STAGE(PG8_SA(0, 1), a2 + hstep, voffA);
            PG8_WAIT_V(8); PG8_WAIT_L(0); PG8_BAR; PG8_MMA(0, 0, At, B0); PG8_MMA(0, 1, At, B1); PG8_BAR; PG8_SCHED;
            PG8_LDA(At, 1, 1); PG8_STAGE(PG8_SB(1, 0), b3, voffB); PG8_STAGE(PG8_SB(1, 1), b3 + hstep, voffB); PG8_STAGE(PG8_SA(1, 0), a3, voffA);
            PG8_WAIT_V(8); PG8_WAIT_L(0); PG8_BAR; PG8_MMA(1, 0, At, B0); PG8_MMA(1, 1, At, B1); PG8_BAR; PG8_SCHED;
            } else {
            PG8_LDB(B0, 0, 0); PG8_SCHED; PG8_LDA(At, 0, 0); PG8_STAGE(PG8_SA(1, 1), a1 + hstep, voffA);
            PG8_WAIT_L(8); PG8_BAR; PG8_WAIT_L(0); PG8_MMA(0, 0, At, B0); PG8_BAR; PG8_SCHED;
            PG8_LDB(B1, 0, 1); PG8_STAGE(PG8_SB(0, 0), b2, voffB);
            PG8_BAR; PG8_WAIT_L(0); PG8_MMA(0, 1, At, B1); PG8_BAR;
            PG8_LDA(At, 0, 1); PG8_STAGE(PG8_SA(0, 0), a2, voffA);
            PG8_BAR; PG8_WAIT_L(0); PG8_MMA(1, 0, At, B0); PG8_BAR; PG8_SCHED;
            PG8_STAGE(PG8_SB(0, 1), b2 + hstep, voffB);
            PG8_WAIT_V(6); PG8_BAR; PG8_MMA(1, 1, At, B1); PG8_BAR;
            PG8_LDB(B0, 1, 0); PG8_SCHED; PG8_LDA(At, 1, 0); PG8_STAGE(PG8_SA(0, 1), a2 + hstep, voffA);
            PG8_WAIT_L(8); PG8_BAR; PG8_WAIT_L(0); PG8_MMA(0, 0, At, B0); PG8_BAR; PG8_SCHED;
            PG8_LDB(B1, 1, 1); PG8_STAGE(PG8_SB(1, 0), b3, voffB);
            PG8_BAR; PG8_WAIT_L(0); PG8_MMA(0, 1, At, B1); PG8_BAR;
            PG8_LDA(At, 1, 1); PG8_STAGE(PG8_SA(1, 0), a3, voffA);
            PG8_BAR; PG8_WAIT_L(0); PG8_MMA(1, 0, At, B0); PG8_BAR; PG8_SCHED;
            PG8_STAGE(PG8_SB(1, 1), b3 + hstep, voffB);
            PG8_WAIT_V(6); PG8_BAR; PG8_MMA(1, 1, At, B1); PG8_BAR;
            }
        }
        if constexpr (ALIGN_EPI) { if (wr == 0) PG8_BAR; }
        if constexpr (!Epi::AFTER_DRAIN) { E(acc, cur, wr, wc, fr, fq); S.done(cur); }
        if (!has_next) break;
#pragma unroll
        for (int a = 0; a < 2; ++a)
#pragma unroll
            for (int b = 0; b < 2; ++b)
#pragma unroll
                for (int m = 0; m < 4; ++m)
#pragma unroll
                    for (int n = 0; n < 2; ++n) acc[a][b][m][n] = (f32x4){0.f, 0.f, 0.f, 0.f};
        cur = nxt; cA = nA; cB = nB; ++ui;
        if constexpr (ALIGN_EPI) { if (wr == 1) PG8_BAR; }
    }
    PG8_WAIT_V(0);
    if constexpr (!ALIGN_EPI) { if (wr == 0) PG8_BAR; }
    PG8_BAR;
    if constexpr (Epi::AFTER_DRAIN) { E.fused(acc, cur, wr, wc, fr, fq, lds, wid, lane); S.done(cur); }
#undef PG8_SA
#undef PG8_SB
#undef PG8_STAGE
#undef PG8_LDA
#undef PG8_LDB
#undef PG8_MMA
#undef PG8_WAIT_V
#undef PG8_WAIT_L
#undef PG8_BAR
#undef PG8_SCHED
}
}

#ifndef EN_ATT
#define EN_ATT 1
#endif
#ifndef EN_HY
#define EN_HY 1
#endif
#ifndef EN_FFN
#define EN_FFN 1
#endif
#ifndef PROBE_PH
#define PROBE_PH -1
#endif
#ifndef PHASES
#define PHASES 0xFFFF
#endif
#define PH(k) ((PHASES >> (k)) & 1)
#define LAS __attribute__((address_space(3)))
typedef unsigned short bf16_t;
typedef pg8::f32x4 f32x4;
typedef pg8::u32x4 u32x4;
typedef pg8::bf16x8 bf16x8;
typedef float f32x16 __attribute__((ext_vector_type(16)));
typedef float f32x2 __attribute__((ext_vector_type(2)));
typedef unsigned u32x2 __attribute__((ext_vector_type(2)));
typedef short s16x4 __attribute__((ext_vector_type(4)));

constexpr int D = 1024, NB = 8, SEQ = 4096, MROWS = NB * SEQ, CTX = 256, MCTX = NB * CTX, KV = CTX + SEQ;
constexpr int INC = 5120, DFF = 2816, NUP = 2 * DFF, NADA = 6 * D;
constexpr float LN_EPS = 1e-5f, RMS_EPS = 1e-5f;
constexpr float DN_ALPHA = 1.189207115002721f;
constexpr float LAM_INIT = 0.2f;
constexpr float QSCALE = 0.125f * 1.4426950408889634f;

constexpr size_t MiB = 1u << 20;
constexpr size_t WS_ST0 = 0, WS_ST1 = 256 * 1024, WS_ROPE = 512 * 1024, WS_TW = 528 * 1024, WS_MOD = 576 * 1024;
constexpr size_t WS_MODP = 1 * MiB;
constexpr size_t WS_WIN = 3 * MiB, WS_WHY = 13 * MiB, WS_WAT = 14 * MiB, WS_WOUT = 15 * MiB, WS_WUP = 17 * MiB, WS_WDN = 28 * MiB;
constexpr size_t WS_XM = 34 * MiB;
constexpr size_t WS_ON = 34 * MiB, WS_YHT = 66 * MiB, WS_HM = 34 * MiB;
constexpr size_t WS_CTXM = 98 * MiB;
constexpr size_t WS_FILT = 490 * MiB;
constexpr size_t WS_SG = 102 * MiB;
constexpr size_t WS_KSPEC = 230 * MiB;
constexpr size_t WS_MBUF = 230 * MiB;
constexpr size_t WS_ZHY = 294 * MiB;
constexpr size_t WS_YH = 294 * MiB;
constexpr size_t WS_Q = 390 * MiB, WS_K = 422 * MiB, WS_V = 456 * MiB;
constexpr size_t WS_U = 102 * MiB;
constexpr size_t WS_ACT = 278 * MiB;
constexpr size_t WS_TSC = 102 * MiB;
constexpr size_t WS_R1B = 134 * MiB;
constexpr size_t WS_END = 506 * MiB;

constexpr int LDS_MISC = 139264;
constexpr int LDS_BYTES = 139264 + 256;
constexpr size_t WS_BAR = 832 * 1024;

__device__ __forceinline__ int tid_fresh() { int t = threadIdx.x; asm volatile("" : "+v"(t)); return t; }
__device__ __forceinline__ unsigned pk2(float lo, float hi) { return pg8::cvt_pk_bf16(lo, hi); }
__device__ __forceinline__ float bflo(unsigned w) { return __uint_as_float(w << 16); }
__device__ __forceinline__ float bfhi(unsigned w) { return __uint_as_float(w & 0xffff0000u); }
__device__ __forceinline__ float bf1(bf16_t v) { return __uint_as_float((unsigned)v << 16); }
template <int MASK> __device__ __forceinline__ float xswz(float v) { return __uint_as_float((unsigned)__builtin_amdgcn_ds_swizzle((int)__float_as_uint(v), 0x1F | (MASK << 10))); }
__device__ __forceinline__ float xsum32(float v) { const unsigned u = __float_as_uint(v); auto rr = __builtin_amdgcn_permlane32_swap(u, u, false, false); return __uint_as_float(rr[0]) + __uint_as_float(rr[1]); }
__device__ __forceinline__ float xmax32(float v) { const unsigned u = __float_as_uint(v); auto rr = __builtin_amdgcn_permlane32_swap(u, u, false, false); return fmaxf(__uint_as_float(rr[0]), __uint_as_float(rr[1])); }
__device__ __forceinline__ float xget32(float v, bool upper) { const unsigned u = __float_as_uint(v); auto rr = __builtin_amdgcn_permlane32_swap(u, u, false, false); return __uint_as_float(upper ? rr[0] : rr[1]); }
__device__ __forceinline__ float wave_sum(float v) {
    v += xswz<1>(v); v += xswz<2>(v); v += xswz<4>(v); v += xswz<8>(v); v += xswz<16>(v);
    return xsum32(v);
}
__device__ __forceinline__ float fast_sigmoid(float x) { return __builtin_amdgcn_rcpf(1.0f + __builtin_amdgcn_exp2f(-1.4426950408889634f * x)); }
__device__ __forceinline__ u32x4 pack8(const f32x4& a, const f32x4& b) { u32x4 w; w.x = pk2(a[0], a[1]); w.y = pk2(a[2], a[3]); w.z = pk2(b[0], b[1]); w.w = pk2(b[2], b[3]); return w; }
__device__ __forceinline__ void unpack8(const u32x4& w, f32x4& a, f32x4& b) { a = (f32x4){bflo(w.x), bfhi(w.x), bflo(w.y), bfhi(w.y)}; b = (f32x4){bflo(w.z), bfhi(w.z), bflo(w.w), bfhi(w.w)}; }

__device__ __forceinline__ size_t koff(int pos, int d) { return ((size_t)(((pos >> 6) * 8 + (d >> 3)) * 64 + (pos & 63))) * 8 + (d & 7); }
__device__ __forceinline__ size_t voff(int pos, int dv) { return ((size_t)(((pos >> 6) * 4 + (dv >> 5)) * 64 + (pos & 63))) * 32 + (dv & 31); }
struct EpiIn {
    static constexpr bool PERM = true, AFTER_DRAIN = false;
    bf16_t *zhy, *q, *k, *v, *sg; const f32x2* rope;
    __device__ __forceinline__ void operator()(const f32x4 (&acc)[2][2][4][2], const pg8::Unit& u, int wr, int wc, int fr, int fq) const {
        const int pn = u.pn;
#pragma unroll
        for (int ai = 0; ai < 2; ++ai)
#pragma unroll
            for (int m = 0; m < 4; ++m) {
                const int r = u.pm * 256 + ai * 128 + wr * 64 + m * 16 + fr; const int b = r >> 12, t = r & 4095;
#pragma unroll
                for (int bj = 0; bj < 2; ++bj) {
                    const int c = pn * 256 + bj * 128 + wc * 32 + fq * 8;
                    const f32x4 v0 = acc[ai][bj][m][0], v1 = acc[ai][bj][m][1];
                    if (pn < 6) {
                        bf16_t* dst = zhy + ((size_t)(b * 1536 + c) * 4096 + t);
                        const u32x4 w = pack8(v0, v1);
                        dst[0] = (bf16_t)(w.x & 0xffff); dst[4096] = (bf16_t)(w.x >> 16); dst[2 * 4096] = (bf16_t)(w.y & 0xffff); dst[3 * 4096] = (bf16_t)(w.y >> 16);
                        dst[4 * 4096] = (bf16_t)(w.z & 0xffff); dst[5 * 4096] = (bf16_t)(w.z >> 16); dst[6 * 4096] = (bf16_t)(w.w & 0xffff); dst[7 * 4096] = (bf16_t)(w.w >> 16);
                    } else if (pn < 10) {
                        const bool isq = pn < 8; const int cq = c - (isq ? 1536 : 2048);
                        const int h = cq >> 7, cc = (cq >> 6) & 1, d = cq & 63, axis = (cq >> 5) & 1;
                        const int pos = axis ? (t & 63) : (t >> 6);
                        const f32x4* rt = (const f32x4*)(rope + pos * 16 + (fq & 1) * 8);
                        const f32x4 t0 = rt[0], t1 = rt[1], t2 = rt[2], t3 = rt[3];
                        const float sgn = (fq < 2) ? -1.0f : 1.0f;
                        f32x4 p0, p1;
#pragma unroll
                        for (int e = 0; e < 4; ++e) { p0[e] = xget32(v0[e], fq >= 2); p1[e] = xget32(v1[e], fq >= 2); }
                        f32x4 o0, o1;
                        o0[0] = v0[0] * t0[0] + sgn * p0[0] * t0[1]; o0[1] = v0[1] * t0[2] + sgn * p0[1] * t0[3];
                        o0[2] = v0[2] * t1[0] + sgn * p0[2] * t1[1]; o0[3] = v0[3] * t1[2] + sgn * p0[3] * t1[3];
                        o1[0] = v1[0] * t2[0] + sgn * p1[0] * t2[1]; o1[1] = v1[1] * t2[2] + sgn * p1[1] * t2[3];
                        o1[2] = v1[2] * t3[0] + sgn * p1[2] * t3[1]; o1[3] = v1[3] * t3[2] + sgn * p1[3] * t3[3];
                        if (isq) { o0 = o0 * QSCALE; o1 = o1 * QSCALE; *(u32x4*)(q + ((size_t)((b * 4 + h) * 2 + cc) * SEQ + t) * 64 + d) = pack8(o0, o1); }
                        else *(u32x4*)(k + (size_t)((b * 4 + h) * 2 + cc) * KV * 64 + koff(CTX + t, d)) = pack8(o0, o1);
                    } else if (pn < 12) {
                        const int cv = c - 2560, h = cv >> 7, dv = cv & 127;
                        *(u32x4*)(v + (size_t)(b * 4 + h) * KV * 128 + voff(CTX + t, dv)) = pack8(v0, v1);
                    } else {
                        f32x4 s0, s1;
#pragma unroll
                        for (int e = 0; e < 4; ++e) { s0[e] = fast_sigmoid(v0[e]); s1[e] = fast_sigmoid(v1[e]); }
                        *(u32x4*)(sg + (size_t)r * 2048 + (c - 3072)) = pack8(s0, s1);
                    }
                }
            }
    }
};
struct EpiCtx {
    static constexpr bool PERM = true, AFTER_DRAIN = false;
    bf16_t *k, *v;
    __device__ __forceinline__ void operator()(const f32x4 (&acc)[2][2][4][2], const pg8::Unit& u, int wr, int wc, int fr, int fq) const {
        const int pn = u.pn;
#pragma unroll
        for (int ai = 0; ai < 2; ++ai)
#pragma unroll
            for (int m = 0; m < 4; ++m) {
                const int r = u.pm * 256 + ai * 128 + wr * 64 + m * 16 + fr; const int b = r >> 8, t = r & 255;
#pragma unroll
                for (int bj = 0; bj < 2; ++bj) {
                    const int c = pn * 256 + bj * 128 + wc * 32 + fq * 8;
                    const u32x4 w = pack8(acc[ai][bj][m][0], acc[ai][bj][m][1]);
                    if (pn < 2) { const int h = c >> 7, cc = (c >> 6) & 1, d = c & 63; *(u32x4*)(k + (size_t)((b * 4 + h) * 2 + cc) * KV * 64 + koff(t, d)) = w; }
                    else { const int cv = c - 512, h = cv >> 7, dv = cv & 127; *(u32x4*)(v + (size_t)(b * 4 + h) * KV * 128 + voff(t, dv)) = w; }
                }
            }
    }
};
template <bool ADD> struct EpiMerge {
    static constexpr bool PERM = true, AFTER_DRAIN = false;
    bf16_t* mb; const bf16_t* sg;
    __device__ __forceinline__ void operator()(const f32x4 (&acc)[2][2][4][2], const pg8::Unit& u, int wr, int wc, int fr, int fq) const {
#pragma unroll
        for (int ai = 0; ai < 2; ++ai)
#pragma unroll
            for (int m = 0; m < 4; ++m) {
                const int r = u.pm * 256 + ai * 128 + wr * 64 + m * 16 + fr;
#pragma unroll
                for (int bj = 0; bj < 2; ++bj) {
                    const int c = u.pn * 256 + bj * 128 + wc * 32 + fq * 8;
                    f32x4 g0, g1; unpack8(*(const u32x4*)(sg + (size_t)r * 2048 + (ADD ? 1024 : 0) + c), g0, g1);
                    f32x4 o0 = acc[ai][bj][m][0] * g0, o1 = acc[ai][bj][m][1] * g1;
                    bf16_t* dst = mb + (size_t)r * D + c;
                    if (ADD) { f32x4 p0, p1; unpack8(*(const u32x4*)dst, p0, p1); o0 = o0 + p0; o1 = o1 + p1; }
                    *(u32x4*)dst = pack8(o0, o1);
                }
            }
    }
};
struct EpiOut {
    static constexpr bool PERM = true, AFTER_DRAIN = false;
    const float *x, *st0, *lg, *lb, *mod; bf16_t* r1b;
    __device__ __forceinline__ void operator()(const f32x4 (&acc)[2][2][4][2], const pg8::Unit& u, int wr, int wc, int fr, int fq) const {
        const int b = (u.pm * 256) >> 12;
#pragma unroll
        for (int bj = 0; bj < 2; ++bj) {
            const int c = u.pn * 256 + bj * 128 + wc * 32 + fq * 8;
            f32x4 g[2], bb[2], g1[2];
#pragma unroll
            for (int n = 0; n < 2; ++n) { g[n] = *(const f32x4*)(lg + c + 4 * n); bb[n] = *(const f32x4*)(lb + c + 4 * n); g1[n] = *(const f32x4*)(mod + b * NADA + 2 * D + c + 4 * n); }
#pragma unroll
            for (int ai = 0; ai < 2; ++ai)
#pragma unroll
                for (int m = 0; m < 4; ++m) {
                    const int r = u.pm * 256 + ai * 128 + wr * 64 + m * 16 + fr;
                    const f32x2 st = *(const f32x2*)(st0 + 2 * r);
                    f32x4 rr[2];
#pragma unroll
                    for (int n = 0; n < 2; ++n) {
                        const f32x4 xv = *(const f32x4*)(x + (size_t)r * D + c + 4 * n);
                        const f32x4 xl = (xv - st.x) * st.y * g[n] + bb[n];
                        rr[n] = xl * DN_ALPHA + g1[n] * acc[ai][bj][m][n];
                    }
                    *(u32x4*)(r1b + (size_t)r * D + c) = pack8(rr[0], rr[1]);
                }
        }
    }
};
struct EpiUpGate {
    static constexpr bool PERM = true, AFTER_DRAIN = false;
    bf16_t* tsc; bf16_t* act; const float* cw; const float* cb; bf16_t* ubnd;
    __device__ __forceinline__ void operator()(const f32x4 (&acc)[2][2][4][2], const pg8::Unit& u, int wr, int wc, int fr, int fq) const {
        bf16_t* T = tsc + (size_t)blockIdx.x * 65536;
#pragma unroll
        for (int ai = 0; ai < 2; ++ai)
#pragma unroll
            for (int m = 0; m < 4; ++m) {
                const int r = ai * 128 + wr * 64 + m * 16 + fr;
#pragma unroll
                for (int bj = 0; bj < 2; ++bj) *(u32x4*)(T + r * 256 + bj * 128 + wc * 32 + fq * 8) = pack8(acc[ai][bj][m][0], acc[ai][bj][m][1]);
            }
        asm volatile("s_waitcnt vmcnt(0)" ::: "memory"); __builtin_amdgcn_s_barrier(); asm volatile("" ::: "memory");
        const int tid = (wr * 4 + wc) * 64 + fq * 16 + fr, cg_ = tid & 15, rc = tid >> 4;
        if (tid < 128) {
            const int q = tid >> 5, ch = tid & 31, rr = (q < 2) ? q : 252 + q;
            *(u32x4*)(ubnd + ((size_t)((u.pm * 22 + u.pn) * 4 + q)) * 256 + ch * 8) = *(const u32x4*)(T + rr * 256 + ch * 8);
        }
        const int ca = u.pn * 128 + cg_ * 8, cgt = DFF + ca;
        f32x4 wA[3][2], wG[3][2], bA[2], bG[2];
#pragma unroll
        for (int j = 0; j < 3; ++j)
#pragma unroll
            for (int n = 0; n < 2; ++n) { wA[j][n] = *(const f32x4*)(cw + j * NUP + ca + 4 * n); wG[j][n] = *(const f32x4*)(cw + j * NUP + cgt + 4 * n); }
#pragma unroll
        for (int n = 0; n < 2; ++n) { bA[n] = *(const f32x4*)(cb + ca + 4 * n); bG[n] = *(const f32x4*)(cb + cgt + 4 * n); }
        const f32x4 z4 = {0.f, 0.f, 0.f, 0.f};
#pragma unroll 1
        for (int hh = 0; hh < 2; ++hh) {
            u32x4 ra[6], rg[6];
#pragma unroll
            for (int i = 0; i < 6; ++i) { int r = rc * 8 + hh * 4 - 1 + i; r = r < 0 ? 0 : (r > 255 ? 255 : r);
                ra[i] = *(const u32x4*)(T + r * 256 + cg_ * 8); rg[i] = *(const u32x4*)(T + r * 256 + 128 + cg_ * 8); }
#pragma unroll
            for (int i = 0; i < 4; ++i) {
                const int r = rc * 8 + hh * 4 + i, R = 256 * u.pm + r, t = R & 4095;
                f32x4 pA[2], cA[2], nA[2], pG[2], cG[2], nG[2];
                unpack8(ra[i], pA[0], pA[1]); unpack8(ra[i + 1], cA[0], cA[1]); unpack8(ra[i + 2], nA[0], nA[1]);
                unpack8(rg[i], pG[0], pG[1]); unpack8(rg[i + 1], cG[0], cG[1]); unpack8(rg[i + 2], nG[0], nG[1]);
                if (t == 0) { pA[0] = pA[1] = pG[0] = pG[1] = z4; }
                if (t == 4095) { nA[0] = nA[1] = nG[0] = nG[1] = z4; }
                f32x4 o[2];
#pragma unroll
                for (int n = 0; n < 2; ++n) {
                    const f32x4 av = wA[0][n] * pA[n] + wA[1][n] * cA[n] + wA[2][n] * nA[n] + bA[n];
                    const f32x4 gv = wG[0][n] * pG[n] + wG[1][n] * cG[n] + wG[2][n] * nG[n] + bG[n];
#pragma unroll
                    for (int e = 0; e < 4; ++e) o[n][e] = gv[e] * fast_sigmoid(gv[e]) * av[e];
                }
                if ((r >= 1 || t == 0) && (r <= 254 || t == 4095)) *(u32x4*)(act + (size_t)R * DFF + ca) = pack8(o[0], o[1]);
            }
        }
    }
};
struct EpiDown {
    static constexpr bool PERM = true, AFTER_DRAIN = false;
    const float *st1, *lg, *lb, *mod; const bf16_t* r1b; float* out;
    __device__ __forceinline__ void operator()(const f32x4 (&acc)[2][2][4][2], const pg8::Unit& u, int wr, int wc, int fr, int fq) const {
        const int b = (u.pm * 256) >> 12;
#pragma unroll
        for (int bj = 0; bj < 2; ++bj) {
            const int c = u.pn * 256 + bj * 128 + wc * 32 + fq * 8;
            f32x4 g[2], bb[2], g2[2];
#pragma unroll
            for (int n = 0; n < 2; ++n) { g[n] = *(const f32x4*)(lg + c + 4 * n); bb[n] = *(const f32x4*)(lb + c + 4 * n); g2[n] = *(const f32x4*)(mod + b * NADA + 5 * D + c + 4 * n); }
#pragma unroll
            for (int ai = 0; ai < 2; ++ai)
#pragma unroll
                for (int m = 0; m < 4; ++m) {
                    const int r = u.pm * 256 + ai * 128 + wr * 64 + m * 16 + fr;
                    const f32x2 st = *(const f32x2*)(st1 + 2 * r);
                    f32x4 rv2[2]; unpack8(*(const u32x4*)(r1b + (size_t)r * D + c), rv2[0], rv2[1]);
#pragma unroll
                    for (int n = 0; n < 2; ++n) {
                        const f32x4 x1 = (rv2[n] - st.x) * st.y * g[n] + bb[n];
#if EN_FFN
                        *(f32x4*)(out + (size_t)r * D + c + 4 * n) = x1 * DN_ALPHA + g2[n] * acc[ai][bj][m][n];
#else
                        *(f32x4*)(out + (size_t)r * D + c + 4 * n) = x1 * DN_ALPHA;
#endif
                    }
                }
        }
    }
};

namespace att {
constexpr int NT = KV / 64, KSTG = 16384, V_BASE = 3 * 16384, VSTG = 16384;
__device__ __forceinline__ void stage_k(LAS unsigned char* dst, const bf16_t* K0, const bf16_t* K1, int key0, int wid, int lane) {
    const size_t o = ((size_t)((key0 >> 6) * 8 + wid) * 64 + lane) * 8;
    __builtin_amdgcn_global_load_lds((const unsigned*)(K0 + o), (LAS unsigned*)(dst + wid * 1024), 16, 0, 0);
    __builtin_amdgcn_global_load_lds((const unsigned*)(K1 + o), (LAS unsigned*)(dst + 8192 + wid * 1024), 16, 0, 0);
}
__device__ __forceinline__ void stage_v(LAS unsigned char* dst, const bf16_t* Vb, int key0, int wid, int lane) {
#pragma unroll
    for (int i = 0; i < 2; ++i) {
        const int pv = wid + 8 * i, db = pv >> 2, kg = pv & 3;
        __builtin_amdgcn_global_load_lds((const unsigned*)(Vb + ((size_t)((key0 >> 6) * 4 + db) * 64 + 16 * kg) * 32 + lane * 8), (LAS unsigned*)(dst + db * 4096 + kg * 1024), 16, 0, 0);
    }
}
__device__ __forceinline__ s16x4 vtr(const LAS unsigned char* p) {
    typedef short v4i16_t __attribute__((ext_vector_type(4)));
    return __builtin_bit_cast(s16x4, __builtin_amdgcn_ds_read_tr16_b64_v4i16((LAS v4i16_t*)p));
}
#define ATT_THR 8.0f
#define VTR_ASM(dst, addr, off) asm volatile("ds_read_b64_tr_b16 %0, %1 offset:%c2" : "=&v"(dst) : "v"(addr), "i"(off) : "memory")
#define VTR_BLK(blk) do { _Pragma("unroll") for (int ks = 0; ks < 4; ++ks) { VTR_ASM(la[ks], vaddr, (blk) * 4096 + ks * 1024); VTR_ASM(ha[ks], vaddr, (blk) * 4096 + ks * 1024 + 512); } } while (0)
#define VTR_WAIT() asm volatile("s_waitcnt lgkmcnt(0)" : "+v"(la[0]), "+v"(la[1]), "+v"(la[2]), "+v"(la[3]), "+v"(ha[0]), "+v"(ha[1]), "+v"(ha[2]), "+v"(ha[3]) :: "memory")
#define PV_BLK(blk) do { _Pragma("unroll") for (int ks = 0; ks < 4; ++ks) { \
        const bf16x8 vf = (bf16x8){la[ks][0], la[ks][1], la[ks][2], la[ks][3], ha[ks][0], ha[ks][1], ha[ks][2], ha[ks][3]}; \
        o[blk] = __builtin_amdgcn_mfma_f32_32x32x16_bf16(vf, pf[ks], o[blk], 0, 0, 0); } } while (0)
#define QKT(P0, P1, KSLOT) do { \
    const LAS unsigned char* Ks = lds + (KSLOT) * KSTG + (comp ? 8192 : 0); \
    _Pragma("unroll") for (int d0 = 0; d0 < 4; ++d0) { \
        const bf16x8 ka = *(const LAS bf16x8*)(Ks + (2 * d0 + hi) * 1024 + r32 * 16); \
        const bf16x8 kb = *(const LAS bf16x8*)(Ks + (2 * d0 + hi) * 1024 + 512 + r32 * 16); \
        if (d0 == 0) { P0 = __builtin_amdgcn_mfma_f32_32x32x16_bf16(ka, qr[0], negm, 0, 0, 0); P1 = __builtin_amdgcn_mfma_f32_32x32x16_bf16(kb, qr[0], negm, 0, 0, 0); } \
        else { P0 = __builtin_amdgcn_mfma_f32_32x32x16_bf16(ka, qr[d0], P0, 0, 0, 0); P1 = __builtin_amdgcn_mfma_f32_32x32x16_bf16(kb, qr[d0], P1, 0, 0, 0); } } \
} while (0)
#define EXP8(P, B) do { _Pragma("unroll") for (int r = (B); r < (B) + 8; ++r) { P[r] = __builtin_amdgcn_exp2f(P[r]); } } while (0)
#define WAITBAR(n) asm volatile("s_waitcnt vmcnt(" #n ") lgkmcnt(0)\n\ts_barrier" ::: "memory")
__device__ __forceinline__ void attn_unit(int b, int h, int qb, const bf16_t* Q, const bf16_t* Kg, const bf16_t* Vg, bf16_t* On, float lam, const float* subln, LAS unsigned char* lds) {
    const int tid = tid_fresh(), lane = tid & 63, r32 = lane & 31, hi = lane >> 5;
    const int wid = __builtin_amdgcn_readfirstlane(tid >> 6), comp = wid >> 2, wq = wid & 3;
    const int t0 = qb * 128 + wq * 32;
    const bf16_t* Qp = Q + ((size_t)((b * 4 + h) * 2 + comp) * SEQ + t0 + r32) * 64;
    const bf16_t* K0 = Kg + (size_t)((b * 4 + h) * 2) * KV * 64; const bf16_t* K1 = K0 + (size_t)KV * 64;
    const bf16_t* Vb = Vg + (size_t)(b * 4 + h) * KV * 128;
    bf16x8 qr[4];
#pragma unroll
    for (int d0 = 0; d0 < 4; ++d0) qr[d0] = *(const bf16x8*)(Qp + d0 * 16 + hi * 8);
    asm volatile("" ::: "memory");
    stage_k(lds, K0, K1, 0, wid, lane); stage_k(lds + KSTG, K0, K1, 64, wid, lane);
    stage_k(lds + 2 * KSTG, K0, K1, 128, wid, lane); stage_v(lds + V_BASE, Vb, 0, wid, lane);
    f32x16 o[4];
#pragma unroll
    for (int i = 0; i < 4; ++i)
#pragma unroll
        for (int r = 0; r < 16; ++r) o[i][r] = 0.f;
    float mref = 0.f, lrun = 0.f, alpha_prev = 1.f;
    f32x16 negm, pc0, pc1, pn0, pn1;
#pragma unroll
    for (int r = 0; r < 16; ++r) { negm[r] = 0.f; pn0[r] = 0.f; pn1[r] = 0.f; }
    bf16x8 pf[4];
#pragma unroll
    for (int i = 0; i < 4; ++i) pf[i] = (bf16x8){0, 0, 0, 0, 0, 0, 0, 0};
    s16x4 la[4], ha[4];
    const int vlane = ((lane >> 4) & 1) * 32 + (lane & 3) * 8 + (4 * hi + ((lane & 15) >> 2)) * 64;
    const unsigned vbase = (unsigned)(uintptr_t)(lds + V_BASE + vlane);
    asm volatile("s_waitcnt vmcnt(6)" ::: "memory"); __builtin_amdgcn_s_barrier(); asm volatile("" ::: "memory");
    QKT(pc0, pc1, 0);
    int k3 = 1;
    for (int t = 0; t < NT; ++t) {
        if (t + 2 < NT) WAITBAR(4); else if (t + 1 < NT) WAITBAR(2); else WAITBAR(0);
        if (t + 3 < NT) stage_k(lds + (k3 == 0 ? 2 : k3 - 1) * KSTG, K0, K1, (t + 3) * 64, wid, lane);
        if (t + 1 < NT) stage_v(lds + V_BASE + ((t + 1) & 3) * VSTG, Vb, (t + 1) * 64, wid, lane);
        if (t + 1 < NT) QKT(pn0, pn1, k3);
        float mx = fmaxf(pc0[0], pc1[0]);
#pragma unroll
        for (int r = 1; r < 16; ++r) mx = fmaxf(fmaxf(mx, pc0[r]), pc1[r]);
        mx = xmax32(mx);
        float alpha_cur = 1.0f;
        if (__any(mx > ATT_THR)) {
            const float dl = fmaxf(mx, 0.f); mref += dl;
#pragma unroll
            for (int r = 0; r < 16; ++r) { pc0[r] -= dl; pc1[r] -= dl; pn0[r] -= dl; pn1[r] -= dl; negm[r] = -mref; }
            alpha_cur = __builtin_amdgcn_exp2f(-dl); lrun *= alpha_cur;
        }
        if (__any(alpha_prev != 1.0f)) {
#pragma unroll
            for (int i = 0; i < 4; ++i)
#pragma unroll
                for (int r = 0; r < 16; ++r) o[i][r] *= alpha_prev;
        }
        if (t > 0) {
            const unsigned vaddr = vbase + (unsigned)((t + 3) & 3) * VSTG;
            VTR_BLK(0); EXP8(pc0, 0); VTR_WAIT(); PV_BLK(0);
            VTR_BLK(1); EXP8(pc0, 8); VTR_WAIT(); PV_BLK(1);
            VTR_BLK(2); EXP8(pc1, 0); VTR_WAIT(); PV_BLK(2);
            VTR_BLK(3); EXP8(pc1, 8); VTR_WAIT(); PV_BLK(3);
        } else { EXP8(pc0, 0); EXP8(pc0, 8); EXP8(pc1, 0); EXP8(pc1, 8); }
        f32x2 ls2a = {0.f, 0.f}, ls2b = {0.f, 0.f};
#pragma unroll
        for (int r = 0; r < 16; r += 2) { ls2a += (f32x2){pc0[r], pc0[r + 1]}; ls2b += (f32x2){pc1[r], pc1[r + 1]}; }
        ls2a += ls2b; lrun += ls2a.x + ls2a.y;
        { u32x4 w;
          w.x = pk2(pc0[0], pc0[1]); w.y = pk2(pc0[2], pc0[3]); w.z = pk2(pc0[4], pc0[5]); w.w = pk2(pc0[6], pc0[7]); pf[0] = __builtin_bit_cast(bf16x8, w);
          w.x = pk2(pc0[8], pc0[9]); w.y = pk2(pc0[10], pc0[11]); w.z = pk2(pc0[12], pc0[13]); w.w = pk2(pc0[14], pc0[15]); pf[1] = __builtin_bit_cast(bf16x8, w);
          w.x = pk2(pc1[0], pc1[1]); w.y = pk2(pc1[2], pc1[3]); w.z = pk2(pc1[4], pc1[5]); w.w = pk2(pc1[6], pc1[7]); pf[2] = __builtin_bit_cast(bf16x8, w);
          w.x = pk2(pc1[8], pc1[9]); w.y = pk2(pc1[10], pc1[11]); w.z = pk2(pc1[12], pc1[13]); w.w = pk2(pc1[14], pc1[15]); pf[3] = __builtin_bit_cast(bf16x8, w); }
        pc0 = pn0; pc1 = pn1; alpha_prev = alpha_cur;
        k3 = (k3 == 2) ? 0 : k3 + 1;
    }
    WAITBAR(0);
    if (__any(alpha_prev != 1.0f)) {
#pragma unroll
        for (int i = 0; i < 4; ++i)
#pragma unroll
            for (int r = 0; r < 16; ++r) o[i][r] *= alpha_prev;
    }
    { const unsigned vaddr = vbase + (unsigned)((NT - 1) & 3) * VSTG;
      VTR_BLK(0); VTR_WAIT(); PV_BLK(0); VTR_BLK(1); VTR_WAIT(); PV_BLK(1); VTR_BLK(2); VTR_WAIT(); PV_BLK(2); VTR_BLK(3); VTR_WAIT(); PV_BLK(3); }
    lrun = xsum32(lrun);
    const float inv = 1.0f / lrun;
    __syncthreads();
    LAS float* ex = (LAS float*)lds;
    if (comp == 1) {
#pragma unroll
        for (int i = 0; i < 4; ++i)
#pragma unroll
            for (int r = 0; r < 16; ++r) ex[(wq * 64 + i * 16 + r) * 64 + lane] = o[i][r] * inv;
    }
    __syncthreads();
    if (comp == 0) {
        float ss = 0.f;
#pragma unroll
        for (int i = 0; i < 4; ++i)
#pragma unroll
            for (int r = 0; r < 16; ++r) { const float v = o[i][r] * inv - lam * ex[(wq * 64 + i * 16 + r) * 64 + lane]; o[i][r] = v; ss += v * v; }
        ss = xsum32(ss);
        const float rn = 1.0f / sqrtf(ss * (1.0f / 128.0f) + RMS_EPS) * (1.0f - LAM_INIT);
        bf16_t* dst = On + (size_t)(b * SEQ + t0 + r32) * 512 + h * 128;
#pragma unroll
        for (int i = 0; i < 4; ++i)
#pragma unroll
            for (int g = 0; g < 4; ++g) {
                const int d = 32 * i + 8 * g + 4 * hi;
                const f32x4 sg = *(const f32x4*)(subln + d);
                u32x2 w; w.x = pk2(o[i][4 * g] * rn * sg[0], o[i][4 * g + 1] * rn * sg[1]); w.y = pk2(o[i][4 * g + 2] * rn * sg[2], o[i][4 * g + 3] * rn * sg[3]);
                *(u32x2*)(dst + d) = w;
            }
    }
    __syncthreads();
}
#undef VTR_ASM
#undef VTR_BLK
#undef VTR_WAIT
#undef PV_BLK
#undef QKT
#undef EXP8
#undef WAITBAR
}

namespace hy {
__device__ const float WC[16] = {1.0f, 0.98078528040323043f, 0.92387953251128674f, 0.83146961230254524f, 0.70710678118654757f, 0.55557023301960229f, 0.38268343236508984f, 0.19509032201612833f,
                                 0.0f, -0.19509032201612833f, -0.38268343236508984f, -0.55557023301960229f, -0.70710678118654757f, -0.83146961230254524f, -0.92387953251128674f, -0.98078528040323043f};
__device__ const float WS[16] = {0.0f, 0.19509032201612825f, 0.38268343236508978f, 0.55557023301960218f, 0.70710678118654746f, 0.83146961230254524f, 0.92387953251128674f, 0.98078528040323043f,
                                 1.0f, 0.98078528040323043f, 0.92387953251128674f, 0.83146961230254546f, 0.70710678118654757f, 0.55557023301960218f, 0.38268343236508989f, 0.19509032201612861f};
__device__ __forceinline__ int PX(int i) { return i + ((i >> 5) << 1); }
template <bool CONJ> __device__ __forceinline__ f32x2 cmulw(f32x2 a, float c, float s) {
    const f32x2 sw = CONJ ? (f32x2){-a.y, a.x} : (f32x2){a.y, -a.x};
    return a * (f32x2){c, c} + sw * (f32x2){s, s};
}
template <int H, bool INV, bool ZUP = false> __device__ __forceinline__ void pass16(LAS f32x2* X, const f32x2* TW, int tid) {
    constexpr int S = H / 8, MULT = 4096 / H;
    const int j0 = tid % S, blk = tid / S, base = blk * 2 * H + j0;
    f32x2 e[16];
#pragma unroll
    for (int r = 0; r < 16; ++r) e[r] = (ZUP && r >= 8) ? (f32x2){0.f, 0.f} : X[PX(base + r * S)];
    f32x2 w[4];
#pragma unroll
    for (int k = 0; k < 4; ++k) w[k] = TW[(j0 << k) * MULT];
    if (!INV) {
#pragma unroll
        for (int k = 0; k < 4; ++k) {
            const int hk = 8 >> k;
#pragma unroll
            for (int r = 0; r < 16; ++r) if (!(r & hk)) {
                const f32x2 a = e[r], bb = e[r + hk]; e[r] = a + bb; f32x2 d = a - bb;
                const int ci = (r % hk) << (k + 1);
                if (ci != 0) d = cmulw<false>(d, WC[ci], WS[ci]);
                e[r + hk] = cmulw<false>(d, w[k].x, w[k].y);
            }
        }
    } else {
#pragma unroll
        for (int k = 3; k >= 0; --k) {
            const int hk = 8 >> k;
#pragma unroll
            for (int r = 0; r < 16; ++r) if (!(r & hk)) {
                const f32x2 a = e[r]; f32x2 bb = cmulw<true>(e[r + hk], w[k].x, w[k].y);
                const int ci = (r % hk) << (k + 1);
                if (ci != 0) bb = cmulw<true>(bb, WC[ci], WS[ci]);
                e[r] = a + bb; e[r + hk] = a - bb;
            }
        }
    }
#pragma unroll
    for (int r = 0; r < 16; ++r) X[PX(base + r * S)] = e[r];
}
template <bool FILT> __device__ __forceinline__ void pass32(LAS f32x2* X, f32x2* Kout, const f32x2* Kin, int tid) {
    if (tid < 256) {
        f32x2 e[32];
        u32x4 kvv[8];
        if (!FILT) { const u32x4* kp0 = (const u32x4*)Kin + tid;
#pragma unroll
            for (int i = 0; i < 8; ++i) kvv[i] = kp0[i * 256]; }
        const LAS f32x4* xp = (const LAS f32x4*)(X + PX(32 * tid));
#pragma unroll
        for (int i = 0; i < 16; ++i) { const f32x4 v = xp[i]; e[2 * i] = (f32x2){v[0], v[1]}; e[2 * i + 1] = (f32x2){v[2], v[3]}; }
#pragma unroll
        for (int k = 0; k < 5; ++k) {
            const int hk = 16 >> k;
#pragma unroll
            for (int r = 0; r < 32; ++r) if (!(r & hk)) {
                const f32x2 a = e[r], bb = e[r + hk]; e[r] = a + bb; f32x2 d = a - bb;
                const int ci = (r % hk) << k;
                if (ci != 0) d = cmulw<false>(d, WC[ci], WS[ci]);
                e[r + hk] = d;
            }
        }
        if (FILT) {
            u32x4* kp = (u32x4*)Kout + tid;
#pragma unroll
            for (int i = 0; i < 8; ++i) { u32x4 w; w.x = pk2(e[4 * i].x, e[4 * i].y); w.y = pk2(e[4 * i + 1].x, e[4 * i + 1].y); w.z = pk2(e[4 * i + 2].x, e[4 * i + 2].y); w.w = pk2(e[4 * i + 3].x, e[4 * i + 3].y); kp[i * 256] = w; }
        } else {
#pragma unroll
            for (int i = 0; i < 8; ++i) {
#pragma unroll
                for (int j = 0; j < 4; ++j) { const unsigned kw = kvv[i][j]; const float kr = bflo(kw), ki = bfhi(kw); const f32x2 a = e[4 * i + j];
                    e[4 * i + j] = (f32x2){a.x * kr - a.y * ki, a.x * ki + a.y * kr}; }
            }
#pragma unroll
            for (int k = 4; k >= 0; --k) {
                const int hk = 16 >> k;
#pragma unroll
                for (int r = 0; r < 32; ++r) if (!(r & hk)) {
                    const f32x2 a = e[r]; f32x2 bb = e[r + hk];
                    const int ci = (r % hk) << k;
                    if (ci != 0) bb = cmulw<true>(bb, WC[ci], WS[ci]);
                    e[r] = a + bb; e[r + hk] = a - bb;
                }
            }
            LAS f32x4* xo = (LAS f32x4*)(X + PX(32 * tid));
#pragma unroll
            for (int i = 0; i < 16; ++i) xo[i] = (f32x4){e[2 * i].x, e[2 * i].y, e[2 * i + 1].x, e[2 * i + 1].y};
        }
    }
}
__device__ __forceinline__ void conv_fft(LAS f32x2* X, const f32x2* TW, const f32x2* Ks, int tid) {
    __syncthreads(); pass16<4096, false, true>(X, TW, tid);
    __syncthreads(); pass16<256, false>(X, TW, tid);
    __syncthreads(); pass32<false>(X, nullptr, Ks, tid);
    __syncthreads(); pass16<256, true>(X, TW, tid);
    __syncthreads(); pass16<4096, true>(X, TW, tid);
    __syncthreads();
}
struct Raw { u32x4 r; float lo, hi; };
__device__ __forceinline__ Raw raw_load(const bf16_t* zrow, int tid) {
    Raw w; w.r = *(const u32x4*)(zrow + 8 * tid);
    const bf16_t lo = zrow[tid > 0 ? 8 * tid - 1 : 0], hi = zrow[tid < 511 ? 8 * tid + 8 : 4095];
    w.lo = tid > 0 ? bf1(lo) : 0.f; w.hi = tid < 511 ? bf1(hi) : 0.f; return w;
}
__device__ __forceinline__ void conv3_raw(const Raw& w, float w0, float w1, float w2, float bias, float (&out)[8]) {
    float z[10];
    z[0] = w.lo; z[9] = w.hi;
    z[1] = bflo(w.r.x); z[2] = bfhi(w.r.x); z[3] = bflo(w.r.y); z[4] = bfhi(w.r.y); z[5] = bflo(w.r.z); z[6] = bfhi(w.r.z); z[7] = bflo(w.r.w); z[8] = bfhi(w.r.w);
#pragma unroll
    for (int i = 0; i < 8; ++i) out[i] = w0 * z[i] + w1 * z[i + 1] + w2 * z[i + 2] + bias;
}
__device__ __forceinline__ void put8(LAS f32x2* X, int tid, const float (&a)[8], const float (&b)[8]) {
    LAS f32x4* lo = (LAS f32x4*)(X + PX(8 * tid));
#pragma unroll
    for (int i = 0; i < 4; ++i) lo[i] = (f32x4){a[2 * i], b[2 * i], a[2 * i + 1], b[2 * i + 1]};
}
__device__ __forceinline__ void get8(const LAS f32x2* X, int tid, float (&a)[8], float (&b)[8]) {
    const LAS f32x4* lo = (const LAS f32x4*)(X + PX(8 * tid));
#pragma unroll
    for (int i = 0; i < 4; ++i) { const f32x4 v = lo[i]; a[2 * i] = v[0] * (1.0f / 8192.0f); b[2 * i] = v[1] * (1.0f / 8192.0f); a[2 * i + 1] = v[2] * (1.0f / 8192.0f); b[2 * i + 1] = v[3] * (1.0f / 8192.0f); }
}
__device__ __forceinline__ void hyena_unit(int c, int bp, const bf16_t* zhy, const float* cw, const float* cb, const float* hbias, const f32x2* kspec, const f32x2* TW, bf16_t* yht, LAS f32x2* X) {
    const int tid = tid_fresh(); const int b0 = 2 * bp, b1 = b0 + 1; const int c1 = 512 + c, c2 = 1024 + c;
    const Raw rva = raw_load(zhy + (size_t)(b0 * 1536 + c) * 4096, tid), rvb = raw_load(zhy + (size_t)(b1 * 1536 + c) * 4096, tid);
    const Raw r1a = raw_load(zhy + (size_t)(b0 * 1536 + c1) * 4096, tid), r1b = raw_load(zhy + (size_t)(b1 * 1536 + c1) * 4096, tid);
    const float p00 = cw[c], p01 = cw[1536 + c], p02 = cw[3072 + c], p0b = cb[c];
    const float p10 = cw[c1], p11 = cw[1536 + c1], p12 = cw[3072 + c1], p1b = cb[c1], hb0 = hbias[c];
    const float p20 = cw[c2], p21 = cw[1536 + c2], p22 = cw[3072 + c2], p2b = cb[c2], hb1 = hbias[512 + c];
    float va[8], vb[8];
    { const float w0 = p00, w1 = p01, w2 = p02, bs = p0b; conv3_raw(rva, w0, w1, w2, bs, va); conv3_raw(rvb, w0, w1, w2, bs, vb); }
    put8(X, tid, va, vb);
    conv_fft(X, TW, kspec + (size_t)c * 4096, tid);
    const Raw r2a = raw_load(zhy + (size_t)(b0 * 1536 + c2) * 4096, tid), r2b = raw_load(zhy + (size_t)(b1 * 1536 + c2) * 4096, tid);
    float ca[8], cbv[8]; get8(X, tid, ca, cbv);
    float za[8], zb[8];
    { const float w0 = p10, w1 = p11, w2 = p12, bs = p1b, hb = hb0;
      float xa[8], xb[8]; conv3_raw(r1a, w0, w1, w2, bs, xa); conv3_raw(r1b, w0, w1, w2, bs, xb);
#pragma unroll
      for (int i = 0; i < 8; ++i) { za[i] = xa[i] * (ca[i] + va[i] * hb); zb[i] = xb[i] * (cbv[i] + vb[i] * hb); } }
    put8(X, tid, za, zb);
    conv_fft(X, TW, kspec + (size_t)(512 + c) * 4096, tid);
    get8(X, tid, ca, cbv);
    { const float w0 = p20, w1 = p21, w2 = p22, bs = p2b, hb = hb1;
      float xa[8], xb[8]; conv3_raw(r2a, w0, w1, w2, bs, xa); conv3_raw(r2b, w0, w1, w2, bs, xb);
      u32x4 wa, wb;
      wa.x = pk2(xa[0] * (ca[0] + za[0] * hb), xa[1] * (ca[1] + za[1] * hb)); wa.y = pk2(xa[2] * (ca[2] + za[2] * hb), xa[3] * (ca[3] + za[3] * hb));
      wa.z = pk2(xa[4] * (ca[4] + za[4] * hb), xa[5] * (ca[5] + za[5] * hb)); wa.w = pk2(xa[6] * (ca[6] + za[6] * hb), xa[7] * (ca[7] + za[7] * hb));
      wb.x = pk2(xb[0] * (cbv[0] + zb[0] * hb), xb[1] * (cbv[1] + zb[1] * hb)); wb.y = pk2(xb[2] * (cbv[2] + zb[2] * hb), xb[3] * (cbv[3] + zb[3] * hb));
      wb.z = pk2(xb[4] * (cbv[4] + zb[4] * hb), xb[5] * (cbv[5] + zb[5] * hb)); wb.w = pk2(xb[6] * (cbv[6] + zb[6] * hb), xb[7] * (cbv[7] + zb[7] * hb));
      *(u32x4*)(yht + (size_t)(b0 * 512 + c) * 4096 + 8 * tid) = wa;
      *(u32x4*)(yht + (size_t)(b1 * 512 + c) * 4096 + 8 * tid) = wb; }
    __syncthreads();
}
}

__device__ __forceinline__ void transpose_item(const float* W, int K, int N, bf16_t* WT, LAS float* scr, int item, int lane, bool UPPERM) {
    const int nblk = N / 32, kb = item / nblk, nb = item % nblk, k0 = 64 * kb, n0 = 32 * nb;
    float tv[32];
#pragma unroll
    for (int i = 0; i < 32; ++i) tv[i] = W[(size_t)(k0 + 2 * i + (lane >> 5)) * N + n0 + (lane & 31)];
#pragma unroll
    for (int i = 0; i < 32; ++i) scr[(2 * i + (lane >> 5)) * 33 + (lane & 31)] = tv[i];
    asm volatile("s_waitcnt lgkmcnt(0)" ::: "memory");
    const int c = lane & 7;
#pragma unroll
    for (int j = 0; j < 4; ++j) { const int n = (lane >> 3) + 8 * j; const LAS float* s = scr + (8 * c) * 33 + n;
        u32x4 o; o.x = pk2(s[0 * 33], s[1 * 33]); o.y = pk2(s[2 * 33], s[3 * 33]); o.z = pk2(s[4 * 33], s[5 * 33]); o.w = pk2(s[6 * 33], s[7 * 33]);
        int dn = n0 + n; if (UPPERM) { const int c2 = dn >= DFF ? dn - DFF : dn; dn = 256 * (c2 >> 7) + (dn >= DFF ? 128 : 0) + (c2 & 127); }
        *(u32x4*)(WT + (size_t)dn * K + k0 + 8 * c) = o; }
    asm volatile("s_waitcnt lgkmcnt(0)" ::: "memory");
}
__device__ __forceinline__ void ln_row(const float* xrow, const float* g, const float* bb, int lane, f32x4 (&v)[4], float& mean, float& rstd) {
    const f32x4* xr = (const f32x4*)xrow + lane; float s = 0.f;
#pragma unroll
    for (int j = 0; j < 4; ++j) { v[j] = xr[64 * j]; s += (v[j][0] + v[j][1]) + (v[j][2] + v[j][3]); }
    mean = wave_sum(s) * (1.f / D); float s2 = 0.f;
#pragma unroll
    for (int j = 0; j < 4; ++j) { v[j] = v[j] - mean; s2 += (v[j][0] * v[j][0] + v[j][1] * v[j][1]) + (v[j][2] * v[j][2] + v[j][3] * v[j][3]); }
    rstd = 1.f / sqrtf(wave_sum(s2) * (1.f / D) + LN_EPS);
#pragma unroll
    for (int j = 0; j < 4; ++j) { const f32x4 gg = ((const f32x4*)g)[64 * j + lane], b4 = ((const f32x4*)bb)[64 * j + lane]; v[j] = v[j] * rstd * gg + b4; }
}

__device__ __forceinline__ void ln_row2_bf16(const bf16_t* xa, const bf16_t* xb, const float* g, const float* bb, int lane, f32x4 (&va)[4], f32x4 (&vb)[4], float& ma, float& ra, float& mb, float& rb) {
    const u32x4 a0 = ((const u32x4*)xa)[lane], a1 = ((const u32x4*)xa)[64 + lane], b0 = ((const u32x4*)xb)[lane], b1 = ((const u32x4*)xb)[64 + lane];
    unpack8(a0, va[0], va[1]); unpack8(a1, va[2], va[3]); unpack8(b0, vb[0], vb[1]); unpack8(b1, vb[2], vb[3]);
    float sa = 0.f, sb = 0.f;
#pragma unroll
    for (int j = 0; j < 4; ++j) { sa += (va[j][0] + va[j][1]) + (va[j][2] + va[j][3]); sb += (vb[j][0] + vb[j][1]) + (vb[j][2] + vb[j][3]); }
    sa = wave_sum(sa); sb = wave_sum(sb);
    ma = sa * (1.f / D); mb = sb * (1.f / D); float qa = 0.f, qb = 0.f;
#pragma unroll
    for (int j = 0; j < 4; ++j) { va[j] = va[j] - ma; vb[j] = vb[j] - mb;
        qa += (va[j][0] * va[j][0] + va[j][1] * va[j][1]) + (va[j][2] * va[j][2] + va[j][3] * va[j][3]);
        qb += (vb[j][0] * vb[j][0] + vb[j][1] * vb[j][1]) + (vb[j][2] * vb[j][2] + vb[j][3] * vb[j][3]); }
    qa = wave_sum(qa); qb = wave_sum(qb);
    ra = 1.f / sqrtf(qa * (1.f / D) + LN_EPS); rb = 1.f / sqrtf(qb * (1.f / D) + LN_EPS);
#pragma unroll
    for (int j = 0; j < 4; ++j) { const int col = 512 * (j >> 1) + 8 * lane + 4 * (j & 1); const f32x4 gg = *(const f32x4*)(g + col), b4 = *(const f32x4*)(bb + col); va[j] = va[j] * ra * gg + b4; vb[j] = vb[j] * rb * gg + b4; }
}
__device__ __forceinline__ void ln_load2(const float* xa, const float* xb, int lane, f32x4 (&va)[4], f32x4 (&vb)[4]) {
    const f32x4* pa = (const f32x4*)xa + lane; const f32x4* pb = (const f32x4*)xb + lane;
#pragma unroll
    for (int j = 0; j < 4; ++j) { va[j] = pa[64 * j]; vb[j] = pb[64 * j]; }
}
__device__ __forceinline__ void ln_fin2(const float* g, const float* bb, int lane, f32x4 (&va)[4], f32x4 (&vb)[4], float& ma, float& ra, float& mb, float& rb) {
    float sa = 0.f, sb = 0.f;
#pragma unroll
    for (int j = 0; j < 4; ++j) { sa += (va[j][0] + va[j][1]) + (va[j][2] + va[j][3]); sb += (vb[j][0] + vb[j][1]) + (vb[j][2] + vb[j][3]); }
    sa = wave_sum(sa); sb = wave_sum(sb);
    ma = sa * (1.f / D); mb = sb * (1.f / D); float qa = 0.f, qb = 0.f;
#pragma unroll
    for (int j = 0; j < 4; ++j) { va[j] = va[j] - ma; vb[j] = vb[j] - mb;
        qa += (va[j][0] * va[j][0] + va[j][1] * va[j][1]) + (va[j][2] * va[j][2] + va[j][3] * va[j][3]);
        qb += (vb[j][0] * vb[j][0] + vb[j][1] * vb[j][1]) + (vb[j][2] * vb[j][2] + vb[j][3] * vb[j][3]); }
    qa = wave_sum(qa); qb = wave_sum(qb);
    ra = 1.f / sqrtf(qa * (1.f / D) + LN_EPS); rb = 1.f / sqrtf(qb * (1.f / D) + LN_EPS);
#pragma unroll
    for (int j = 0; j < 4; ++j) { const f32x4 gg = ((const f32x4*)g)[64 * j + lane], b4 = ((const f32x4*)bb)[64 * j + lane]; va[j] = va[j] * ra * gg + b4; vb[j] = vb[j] * rb * gg + b4; }
}

#define RLX_AGENT __ATOMIC_RELAXED, __HIP_MEMORY_SCOPE_AGENT
#define XB_TMO      128
#define XB_XCNT(j)  (256  + 64 * (j))
#define XB_XSUB(j)  (1280 + 64 * (j))
#define XB_XGEN(j)  (2304 + 64 * (j))
#define XB_TOP      3328
#define XB_TOPGEN   3392
#define XCD_BAR_WORDS 3456
#define XB_SPIN_CAP (1u << 18)

__device__ __forceinline__ unsigned xb_ld(unsigned* p)              { return __hip_atomic_load(p, __ATOMIC_RELAXED, __HIP_MEMORY_SCOPE_AGENT); }
__device__ __forceinline__ unsigned xb_add(unsigned* p, unsigned v) { return __hip_atomic_fetch_add(p, v, __ATOMIC_RELAXED, __HIP_MEMORY_SCOPE_AGENT); }
__device__ __forceinline__ unsigned xb_xcc_id() { return (unsigned)__builtin_amdgcn_s_getreg((3 << 11) | 20) & 0xFu; }
#define XB_SPIN(cond, bar) do { unsigned _sp = 0; while (cond) { __builtin_amdgcn_s_sleep(1); \
    if ((++_sp & 255u) == 0u) { if (xb_ld(&(bar)[XB_TMO])) break; if (_sp > XB_SPIN_CAP) { atomicAdd(&(bar)[XB_TMO], 1u); break; } } } } while (0)

struct XcdBarrier {
    unsigned* bar; unsigned x;
    volatile LAS unsigned* st;
};

__device__ __forceinline__ XcdBarrier xcd_barrier_post(unsigned* bar, volatile LAS unsigned* st) {
    XcdBarrier b; b.bar = bar; b.x = xb_xcc_id(); b.st = st;
    if (threadIdx.x == 0) (void)xb_add(&bar[XB_XCNT(b.x)], 1u);
    return b;
}
__device__ __forceinline__ void xcd_barrier_complete(unsigned* bar, unsigned x, unsigned& nloc, unsigned& nx) {
    const unsigned G = gridDim.x * gridDim.y * gridDim.z;
    unsigned sum, cnt, mine, sp = 0u;
    for (;;) {
        sum = 0u; cnt = 0u; mine = 0u;
#pragma unroll
        for (unsigned j = 0; j < 16; ++j) { const unsigned c = xb_ld(&bar[XB_XCNT(j)]); sum += c; cnt += (c > 0u) ? 1u : 0u; mine = (j == x) ? c : mine; }
        if (sum == G) break;
        __builtin_amdgcn_s_sleep(1);
        if ((++sp & 255u) == 0u) { if (xb_ld(&bar[XB_TMO])) break; if (sp > XB_SPIN_CAP) { atomicAdd(&bar[XB_TMO], 1u); break; } }
    }
    nloc = mine > 0u ? mine : 1u; nx = cnt > 0u ? cnt : 1u;
}

__device__ __forceinline__ void xcd_barrier(const XcdBarrier& b) {
    asm volatile("s_waitcnt vmcnt(0)" ::: "memory");
    __syncthreads();
    if (threadIdx.x == 0) {
        unsigned* bar = b.bar;
        __builtin_amdgcn_s_waitcnt(0);
        unsigned nloc = b.st[0], nx = b.st[1];
        if (nloc == 0u) { xcd_barrier_complete(bar, b.x, nloc, nx); b.st[0] = nloc; b.st[1] = nx; }
        const unsigned old = xb_add(&bar[XB_XSUB(b.x)], 1u);
        const unsigned gen = old / nloc;
        if (old + 1u == (gen + 1u) * nloc) {
            __builtin_amdgcn_fence(__ATOMIC_RELEASE, "agent");
            asm volatile("s_waitcnt vmcnt(0)" ::: "memory");
            const unsigned og = xb_add(&bar[XB_TOP], 1u);
            const unsigned tg = og / nx;
            if (og + 1u == (tg + 1u) * nx) xb_add(&bar[XB_TOPGEN], 1u);
            else XB_SPIN(xb_ld(&bar[XB_TOPGEN]) == tg, bar);
            __builtin_amdgcn_fence(__ATOMIC_ACQUIRE, "agent");
            xb_add(&bar[XB_XGEN(b.x)], 1u);
            asm volatile("s_waitcnt vmcnt(0)" ::: "memory");
        } else {
            XB_SPIN(xb_ld(&bar[XB_XGEN(b.x)]) == gen, bar);
            __builtin_amdgcn_fence(__ATOMIC_ACQUIRE, "agent");
            asm volatile("s_waitcnt vmcnt(0)" ::: "memory");
        }
    }
    __syncthreads();
}

struct Params { const float* in[36]; float* out; unsigned char* ws; };
typedef const __attribute__((address_space(4))) Params* KPtr;
__device__ __forceinline__ KPtr kargs() { KPtr k = (KPtr)__builtin_amdgcn_kernarg_segment_ptr(); asm volatile("" : "+s"(k)); return k; }
#define WSP(T, off) ((T*)(kp->ws + (off)))
#define PROBE_T(k, slot) do { if (PROBE_PH == (k) && blockIdx.x == 0 && threadIdx.x == 0) { KPtr kq = kargs(); ((unsigned long long*)(kq->ws + 800 * 1024))[slot] = __builtin_amdgcn_s_memrealtime(); } } while (0)
#define TIDS() const int tid = tid_fresh(), lane = tid & 63, wave = __builtin_amdgcn_readfirstlane(tid >> 6); const int gw = vcu * 8 + wave; (void)lane; (void)gw

__global__ void __launch_bounds__(512, 2) fwd_kernel(Params p) {
    extern __shared__ __attribute__((aligned(16))) unsigned char lds_raw[];
    LAS unsigned char* lds = (LAS unsigned char*)lds_raw;
    cg::grid_group grid = cg::this_grid();
    const int bx = blockIdx.x, G = gridDim.x;
    { volatile LAS unsigned* st = (volatile LAS unsigned*)(lds + LDS_MISC); if (threadIdx.x < 4) st[threadIdx.x] = 0u; }
    __syncthreads();
    const XcdBarrier xbar = xcd_barrier_post((unsigned*)(kargs()->ws + WS_BAR), (volatile LAS unsigned*)(lds + LDS_MISC));
    const int vcu = (G % 8 == 0) ? (bx % 8) * (G / 8) + bx / 8 : bx;
    const int NGW = G * 8;
    PROBE_T(0, 0);
    if (PH(0)) {
        KPtr kp = kargs();
        TIDS();
        f32x2* rope = WSP(f32x2, WS_ROPE); f32x2* TW = WSP(f32x2, WS_TW); float* modp = WSP(float, WS_MODP); bf16_t* FILT = WSP(bf16_t, WS_FILT);
        LAS float* SC = (LAS float*)lds;
        { const float* cin = kp->in[1]; const float* cctx = kp->in[3]; float cv[18];
#pragma unroll
          for (int j = 0; j < 16; ++j) cv[j] = cin[tid + 512 * j];
          cv[16] = cctx[tid]; cv[17] = cctx[tid + 512];
#pragma unroll
          for (int j = 0; j < 18; ++j) SC[tid + 512 * j] = cv[j] * fast_sigmoid(cv[j]); }
        { const int gt = bx * 512 + tid;
          if (gt < 4096) { float sn, cs; sincospif((float)gt * (1.0f / 4096.0f), &sn, &cs); TW[gt] = (f32x2){cs, sn}; }
          else if (gt < 5120) { const int e = gt - 4096, pos = e >> 4, j = e & 15; const float inv = powf(10000.0f, -(float)(2 * j) / 32.0f); const float ang = (float)pos * inv; rope[e] = (f32x2){cosf(ang), sinf(ang)}; } }
        {
            LAS float* zf = (LAS float*)(lds + 40960);
            LAS float* hA = zf + 16 * 33 + 16;
            LAS float* hB = hA + 1024;
            const int t0 = 16 * bx;
            for (int idx = tid; idx < 16 * 33; idx += 512) {
                const int pp = idx / 33, i = idx % 33, t = t0 + pp; float val;
                if (i == 0) val = (float)t / 4095.0f;
                else { const int band = (i - 1) & 15; const float fv = 1e-4f + (float)band * ((15.0f - 1e-4f) / 15.0f); const float wv = (6.283185307179586f / 4096.0f) * (float)t; const float arg = fv * wv; val = (i <= 16) ? cosf(arg) : -sinf(arg); }
                zf[idx] = val;
            }
            __syncthreads();
            const float *w1 = kp->in[11], *b1 = kp->in[12], *w2 = kp->in[13], *b2 = kp->in[14], *w3 = kp->in[15], *b3 = kp->in[16], *fq = kp->in[17], *wout = kp->in[18];
            LAS float* WL = hB + 1024;
            for (int i = tid; i < 33 * 64; i += 512) WL[i] = w1[i];
            __syncthreads();
            for (int idx = tid; idx < 1024; idx += 512) { const int f = idx & 63, pp = idx >> 6; float s = b1[f];
#pragma unroll 11
                for (int i = 0; i < 33; ++i) s += zf[pp * 33 + i] * WL[i * 64 + f];
                hA[f * 16 + pp] = sinf(fq[f] * s); }
            __syncthreads();
            for (int i = tid; i < 4096; i += 512) WL[i] = w2[i];
            __syncthreads();
            for (int idx = tid; idx < 1024; idx += 512) { const int f = idx & 63, pp = idx >> 6; float s = b2[f];
#pragma unroll 16
                for (int k = 0; k < 64; ++k) s += hA[k * 16 + pp] * WL[k * 64 + f];
                hB[f * 16 + pp] = sinf(fq[64 + f] * s); }
            __syncthreads();
            for (int i = tid; i < 4096; i += 512) WL[i] = w3[i];
            __syncthreads();
            for (int idx = tid; idx < 1024; idx += 512) { const int f = idx & 63, pp = idx >> 6; float s = b3[f];
#pragma unroll 16
                for (int k = 0; k < 64; ++k) s += hB[k * 16 + pp] * WL[k * 64 + f];
                hA[f * 16 + pp] = sinf(fq[128 + f] * s); }
            __syncthreads();
            for (int q = 0; q < 4; ++q) {
                const int n = wave * 256 + q * 64 + lane;
                f32x4 a0 = {0.f, 0.f, 0.f, 0.f}, a1 = a0, a2 = a0, a3 = a0;
#pragma unroll 1
                for (int kb = 0; kb < 64; kb += 16) {
                    float wv[16];
#pragma unroll
                    for (int k = 0; k < 16; ++k) wv[k] = wout[(kb + k) * 2048 + n];
#pragma unroll
                    for (int k = 0; k < 16; ++k) { const float w = wv[k]; const LAS f32x4* hp = (const LAS f32x4*)(hA + (kb + k) * 16);
                        a0 += hp[0] * w; a1 += hp[1] * w; a2 += hp[2] * w; a3 += hp[3] * w; }
                }
                const int cch = n & 511; const float mind = -3.0701134573253945f, maxd = -15.350567286626973f;
                const float delta = fabsf(mind + (float)cch * ((maxd - mind) / 511.0f));
                f32x4 dc[4];
#pragma unroll
                for (int g4 = 0; g4 < 4; ++g4)
#pragma unroll
                    for (int e = 0; e < 4; ++e) dc[g4][e] = __builtin_amdgcn_exp2f(-((float)(t0 + 4 * g4 + e) / 4095.0f) * delta * 1.4426950408889634f);
                u32x4* dst = (u32x4*)(FILT + (size_t)n * 4096 + t0);
                dst[0] = pack8(a0 * dc[0], a1 * dc[1]); dst[1] = pack8(a2 * dc[2], a3 * dc[3]);
            }
        }
        if (wave < 3) {
            const int item = bx * 3 + wave; const int kc = item / 96, nb = item % 96, n = nb * 64 + lane;
            const float* wa = kp->in[6];
            float acc[9];
#pragma unroll
            for (int i = 0; i < 9; ++i) acc[i] = 0.f;
#pragma unroll 32
            for (int k = kc * 128; k < kc * 128 + 128; ++k) { const float w = wa[(size_t)k * NADA + n];
#pragma unroll
                for (int i = 0; i < 9; ++i) acc[i] += SC[i * 1024 + k] * w; }
#pragma unroll
            for (int i = 0; i < 9; ++i) modp[(size_t)(kc * 9 + i) * NADA + n] = acc[i];
        }
        {
            LAS float* scr = (LAS float*)(lds + 65536 + wave * 8448);
            constexpr int I_IN = 16 * 160, I_HY = 8 * 32, I_AT = 8 * 32, I_OUT = 16 * 32, I_UP = 16 * 176, I_DN = 44 * 32;
            constexpr int NIT = I_IN + I_HY + I_AT + I_OUT + I_UP + I_DN;
            for (int it = gw; it < NIT; it += NGW) {
                int r = it; const float* W; bf16_t* WT; int K, N; bool up = false;
                if (r < I_IN) { W = kp->in[8]; K = 1024; N = INC; WT = WSP(bf16_t, WS_WIN); }
                else if ((r -= I_IN) < I_HY) { W = kp->in[25]; K = 512; N = 1024; WT = WSP(bf16_t, WS_WHY); }
                else if ((r -= I_HY) < I_AT) { W = kp->in[26]; K = 512; N = 1024; WT = WSP(bf16_t, WS_WAT); }
                else if ((r -= I_AT) < I_OUT) { W = kp->in[27]; K = 1024; N = 1024; WT = WSP(bf16_t, WS_WOUT); }
                else if ((r -= I_OUT) < I_UP) { W = kp->in[30]; K = 1024; N = NUP; WT = WSP(bf16_t, WS_WUP); up = true; }
                else { r -= I_UP; W = kp->in[33]; K = DFF; N = 1024; WT = WSP(bf16_t, WS_WDN); }
                transpose_item(W, K, N, WT, scr, r, lane, up);
            }
        }
    }
    if (G == 0x7fffffff) grid.sync();
    xcd_barrier(xbar);

    PROBE_T(0, 1); PROBE_T(1, 0);
    if (PH(1)) {
        KPtr kp = kargs();
        TIDS();
        const float* x = kp->in[0]; const float* ctx = kp->in[2]; const float *ln_in_g = kp->in[4], *ln_in_b = kp->in[5];
        float* st0 = WSP(float, WS_ST0); float* mod = WSP(float, WS_MOD); const float* modp = WSP(float, WS_MODP); bf16_t *XM = WSP(bf16_t, WS_XM), *CTXM = WSP(bf16_t, WS_CTXM);
        LAS float* SH = (LAS float*)(lds + 73728);
        const int b = bx >> 5;
        const float* bada = kp->in[7];
        { float sacc[8];
#pragma unroll
          for (int i = 0; i < 8; ++i) { const int j = tid + 512 * i, row = j < 2048 ? b : 8, col = j & 2047; float s = bada[col];
#pragma unroll
              for (int kc = 0; kc < 8; ++kc) s += modp[(size_t)(kc * 9 + row) * NADA + col];
              sacc[i] = s; }
#pragma unroll
          for (int i = 0; i < 8; ++i) SH[tid + 512 * i] = sacc[i]; }
        if (tid < 216) { const int e = bx * 216 + tid, row = e / NADA, col = e - row * NADA;
            float s = bada[col];
#pragma unroll
            for (int kc = 0; kc < 8; ++kc) s += modp[(size_t)(kc * 9 + row) * NADA + col];
            mod[e] = s; }
        __syncthreads();
        f32x4 na[4], nb[4];
        ln_load2(x + (size_t)(bx * 128 + wave) * D, x + (size_t)(bx * 128 + 8 + wave) * D, lane, na, nb);
        for (int ip = 0; ip < 8; ++ip) {
            const int ra_ = bx * 128 + (2 * ip) * 8 + wave, rb_ = ra_ + 8;
            f32x4 va[4], vb[4]; float ma, sa, mb, sb;
#pragma unroll
            for (int j = 0; j < 4; ++j) { va[j] = na[j]; vb[j] = nb[j]; }
            if (ip < 7) ln_load2(x + (size_t)(ra_ + 16) * D, x + (size_t)(rb_ + 16) * D, lane, na, nb);
            ln_fin2(ln_in_g, ln_in_b, lane, va, vb, ma, sa, mb, sb);
            if (lane == 0) { *(f32x2*)(st0 + 2 * ra_) = (f32x2){ma, sa}; *(f32x2*)(st0 + 2 * rb_) = (f32x2){mb, sb}; }
#pragma unroll
            for (int j = 0; j < 4; ++j) { const int col = 256 * j + 4 * lane;
                const f32x4 s4 = *(const LAS f32x4*)(SH + col), c4 = *(const LAS f32x4*)(SH + 1024 + col);
                const f32x4 oa = va[j] * (c4 + 1.0f) + s4, ob = vb[j] * (c4 + 1.0f) + s4;
                u32x2 w; w.x = pk2(oa[0], oa[1]); w.y = pk2(oa[2], oa[3]); *(u32x2*)(XM + (size_t)ra_ * D + col) = w;
                w.x = pk2(ob[0], ob[1]); w.y = pk2(ob[2], ob[3]); *(u32x2*)(XM + (size_t)rb_ * D + col) = w; }
        }
        {
            const int r = bx * 8 + wave;
            f32x4 v[4]; float mean, rstd;
            ln_row(ctx + (size_t)r * D, ln_in_g, ln_in_b, lane, v, mean, rstd);
#pragma unroll
            for (int j = 0; j < 4; ++j) { const int col = 256 * j + 4 * lane;
                const f32x4 s4 = *(const LAS f32x4*)(SH + 2048 + col), c4 = *(const LAS f32x4*)(SH + 3072 + col);
                const f32x4 o = v[j] * (c4 + 1.0f) + s4;
                u32x2 w; w.x = pk2(o[0], o[1]); w.y = pk2(o[2], o[3]); *(u32x2*)(CTXM + (size_t)r * D + col) = w; }
        }
    }
    xcd_barrier(xbar);

    PROBE_T(1, 1); PROBE_T(2, 0);
    if (PH(2)) {
        KPtr kp = kargs();
        pg8::Gemm g{WSP(bf16_t, WS_XM), WSP(bf16_t, WS_WIN), MROWS, INC, D}; pg8::StaticOrder S; S.init(MROWS, INC, G, bx);
        EpiIn E{WSP(bf16_t, WS_ZHY), WSP(bf16_t, WS_Q), WSP(bf16_t, WS_K), WSP(bf16_t, WS_V), WSP(bf16_t, WS_SG), WSP(f32x2, WS_ROPE)};
        pg8::gemm_phase<EpiIn, pg8::StaticOrder, true, true>(lds, g, S, E);
    }
    if (PH(2)) {
        KPtr kp = kargs();
        pg8::Gemm g{WSP(bf16_t, WS_CTXM), WSP(bf16_t, WS_WIN) + (size_t)2048 * D, MCTX, 1024, D}; pg8::StaticOrder S; S.init(MCTX, 1024, G, bx);
        EpiCtx E{WSP(bf16_t, WS_K), WSP(bf16_t, WS_V)};
        pg8::gemm_phase<EpiCtx, pg8::StaticOrder, true, true>(lds, g, S, E);
    }
#if EN_HY
    if (PH(2) && bx >= 32) {
        KPtr kp = kargs(); TIDS();
        const f32x2* TW = WSP(f32x2, WS_TW); const bf16_t* FILT = WSP(bf16_t, WS_FILT); f32x2* KSPEC = WSP(f32x2, WS_KSPEC);
        LAS f32x2* X = (LAS f32x2*)lds;
        LAS f32x2* XB = X + 8704;
        for (int pr = bx - 32; pr < 512; pr += G - 32) {
            __syncthreads();
#pragma unroll
            for (int u = 0; u < 2; ++u) {
                const int fid = 2 * pr + u, order = fid >> 9, c = fid & 511;
                const bf16_t* fwd = FILT + (size_t)(order * 1024 + c) * 4096; const bf16_t* bwd = fwd + (size_t)512 * 4096;
                LAS f32x2* Xu = u ? XB : X;
                float fv[16];
#pragma unroll
                for (int r = 0; r < 8; ++r) { fv[r] = bf1(fwd[tid + 512 * r]); const int jb = 4096 - tid - 512 * r; fv[8 + r] = bf1(bwd[jb > 4095 ? 4095 : jb]); }
                if (tid == 0) fv[8] = 0.f;
#pragma unroll
                for (int r = 0; r < 16; ++r) Xu[hy::PX(tid + 512 * r)] = (f32x2){fv[r], 0.f};
            }
            __syncthreads(); hy::pass16<4096, false>(X, TW, tid); hy::pass16<4096, false>(XB, TW, tid);
            __syncthreads(); hy::pass16<256, false>(X, TW, tid); hy::pass16<256, false>(XB, TW, tid);
            __syncthreads(); hy::pass32<true>(tid < 256 ? X : XB, KSPEC + (size_t)(2 * pr + (tid >> 8)) * 4096, nullptr, tid & 255);
        }
    }
#endif
    xcd_barrier(xbar);

    PROBE_T(2, 1); PROBE_T(3, 0);
    if (PH(3)) {
        KPtr kp = kargs();
        TIDS();
#if EN_ATT
        float lam;
        { const float a = kp->in[20][lane] * kp->in[21][lane], bq = kp->in[22][lane] * kp->in[23][lane]; lam = expf(wave_sum(a)) - expf(wave_sum(bq)) + LAM_INIT; }
        for (int i = 0; i < 4; ++i) { const int unit = (((vcu >> 5) * 4 + i) << 5) | (vcu & 31); if (unit < 1024) att::attn_unit(unit >> 7, (unit >> 5) & 3, unit & 31, WSP(bf16_t, WS_Q), WSP(bf16_t, WS_K), WSP(bf16_t, WS_V), WSP(bf16_t, WS_ON), lam, kp->in[24], lds); }
#else
        for (size_t i = (size_t)bx * 512 + tid; i < (size_t)MROWS * 512 / 8; i += (size_t)G * 512) (WSP(u32x4, WS_ON))[i] = (u32x4){0u, 0u, 0u, 0u};
#endif
        PROBE_T(3, 1); PROBE_T(4, 0);
#if EN_HY
        {
            unsigned* qctr = (unsigned*)(kp->ws + WS_BAR + 14336);
            volatile LAS unsigned* qs = (volatile LAS unsigned*)(lds + LDS_MISC + 16);
            for (;;) {
                if (tid == 0) *qs = __hip_atomic_fetch_add(qctr, 1u, __ATOMIC_RELAXED, __HIP_MEMORY_SCOPE_AGENT);
                __syncthreads();
                const unsigned ch = *qs;
                __syncthreads();
                if (ch >= 2048u) break;
                for (int j = 0; j < 1; ++j) { const int unit = (int)ch;
                    hy::hyena_unit(unit >> 2, unit & 3, WSP(bf16_t, WS_ZHY), kp->in[9], kp->in[10], kp->in[19], WSP(f32x2, WS_KSPEC), WSP(f32x2, WS_TW), WSP(bf16_t, WS_YHT), (LAS f32x2*)lds); }
            }
        }
#endif
    }
    xcd_barrier(xbar);

    PROBE_T(4, 1); PROBE_T(5, 0);
    if (PH(4)) {
        KPtr kp = kargs();
        TIDS();
        const bf16_t* YHT = WSP(bf16_t, WS_YHT); bf16_t* YH = WSP(bf16_t, WS_YH);
#if EN_HY
        LAS bf16_t* scr = (LAS bf16_t*)(lds + wave * 8448);
        for (int tile = gw; tile < 4096; tile += NGW) {
            const int b = tile >> 9, cb = (tile >> 6) & 7, tb = tile & 63;
            const bf16_t* src = YHT + (size_t)(b * 512 + cb * 64) * 4096 + tb * 64;
            for (int i = 0; i < 64; ++i) scr[i * 66 + lane] = src[(size_t)i * 4096 + lane];
            asm volatile("s_waitcnt lgkmcnt(0)" ::: "memory");
            bf16_t* dst = YH + (size_t)(b * 4096 + tb * 64) * 512 + cb * 64;
            for (int j = 0; j < 64; ++j) dst[(size_t)j * 512 + lane] = scr[lane * 66 + j];
            asm volatile("s_waitcnt lgkmcnt(0)" ::: "memory");
        }
#else
        for (size_t i = (size_t)bx * 512 + tid; i < (size_t)MROWS * 512 / 8; i += (size_t)G * 512) ((u32x4*)YH)[i] = (u32x4){0u, 0u, 0u, 0u};
#endif
    }
    xcd_barrier(xbar);

    PROBE_T(5, 1); PROBE_T(6, 0);
    if (PH(5)) {
        KPtr kp = kargs();
        pg8::Gemm g{WSP(bf16_t, WS_YH), WSP(bf16_t, WS_WHY), MROWS, D, 512}; pg8::StaticOrder S; S.init(MROWS, D, G, bx);
        EpiMerge<false> E{WSP(bf16_t, WS_MBUF), WSP(bf16_t, WS_SG)};
        pg8::gemm_phase<EpiMerge<false>, pg8::StaticOrder, true, true>(lds, g, S, E);
    }
    asm volatile("s_waitcnt vmcnt(0)" ::: "memory"); __syncthreads();
    if (PH(5)) {
        KPtr kp = kargs();
        pg8::Gemm g{WSP(bf16_t, WS_ON), WSP(bf16_t, WS_WAT), MROWS, D, 512}; pg8::StaticOrder S; S.init(MROWS, D, G, bx);
        EpiMerge<true> E{WSP(bf16_t, WS_MBUF), WSP(bf16_t, WS_SG)};
        pg8::gemm_phase<EpiMerge<true>, pg8::StaticOrder, true, true>(lds, g, S, E);
    }
    xcd_barrier(xbar);

    PROBE_T(6, 1); PROBE_T(7, 0);
    if (PH(6)) {
        KPtr kp = kargs();
        pg8::Gemm g{WSP(bf16_t, WS_MBUF), WSP(bf16_t, WS_WOUT), MROWS, D, D}; pg8::StaticOrder S; S.init(MROWS, D, G, bx);
        EpiOut E{kp->in[0], WSP(float, WS_ST0), kp->in[4], kp->in[5], WSP(float, WS_MOD), WSP(bf16_t, WS_R1B)};
        pg8::gemm_phase<EpiOut, pg8::StaticOrder, true, true>(lds, g, S, E);
    }
    xcd_barrier(xbar);

    PROBE_T(7, 1); PROBE_T(8, 0);
    if (PH(7)) { KPtr kp = kargs(); TIDS(); float* st1 = WSP(float, WS_ST1); const float* mod = WSP(float, WS_MOD); bf16_t* HM = WSP(bf16_t, WS_HM); const bf16_t* r1b = WSP(bf16_t, WS_R1B); const float *l1g = kp->in[28], *l1b = kp->in[29];
    for (int r = 2 * gw; r < MROWS; r += 2 * NGW) {
        f32x4 va[4], vb[4]; float ma, sa, mb, sb; const int b = r >> 12;
        ln_row2_bf16(r1b + (size_t)r * D, r1b + (size_t)(r + 1) * D, l1g, l1b, lane, va, vb, ma, sa, mb, sb);
        if (lane == 0) *(f32x4*)(st1 + 2 * r) = (f32x4){ma, sa, mb, sb};
#pragma unroll
        for (int j = 0; j < 4; ++j) { const int col = 512 * (j >> 1) + 8 * lane + 4 * (j & 1);
            const f32x4 s4 = *(const f32x4*)(mod + b * NADA + 3 * D + col), c4 = *(const f32x4*)(mod + b * NADA + 4 * D + col);
            const f32x4 oa = va[j] * (c4 + 1.0f) + s4, ob = vb[j] * (c4 + 1.0f) + s4;
            u32x2 w; w.x = pk2(oa[0], oa[1]); w.y = pk2(oa[2], oa[3]); *(u32x2*)(HM + (size_t)r * D + col) = w;
            w.x = pk2(ob[0], ob[1]); w.y = pk2(ob[2], ob[3]); *(u32x2*)(HM + (size_t)(r + 1) * D + col) = w; }
    } }
    xcd_barrier(xbar);

    PROBE_T(8, 1);
#if EN_FFN
    PROBE_T(9, 0);
    if (PH(8)) {
        KPtr kp = kargs();
        pg8::Gemm g{WSP(bf16_t, WS_HM), WSP(bf16_t, WS_WUP), MROWS, NUP, D}; pg8::StaticOrder S; S.init(MROWS, NUP, G, bx);
        EpiUpGate E{WSP(bf16_t, WS_TSC), WSP(bf16_t, WS_ACT), kp->in[31], kp->in[32], WSP(bf16_t, WS_FILT)};
        pg8::gemm_phase<EpiUpGate, pg8::StaticOrder, true, true>(lds, g, S, E);
    }
    xcd_barrier(xbar);
    PROBE_T(9, 1);
#endif
    PROBE_T(11, 0);
    if (PH(10)) {
        KPtr kp = kargs();
        pg8::Gemm g{WSP(bf16_t, WS_ACT), WSP(bf16_t, WS_WDN), MROWS, D, DFF}; pg8::StaticOrder S; S.init(MROWS, D, G, bx);
#if EN_FFN
        {
            TIDS();
            const bf16_t* ub = WSP(bf16_t, WS_FILT); bf16_t* act = WSP(bf16_t, WS_ACT); const float* cw = kp->in[31]; const float* cb = kp->in[32];
            for (int ui = 0; ui < 2; ++ui) {
                pg8::Unit u; if (!S.next(ui, u)) break;
                for (int it = tid; it < 704; it += 512) {
                    const int which = it / 352, jg = it % 352, ca = jg * 8, pn = ca >> 7, cl = ca & 127, cgt = DFF + ca;
                    const int pm = u.pm; const bool lastrow = which != 0;
                    if (lastrow ? ((pm & 15) == 15) : ((pm & 15) == 0)) continue;
                    const int R = 256 * pm + (lastrow ? 255 : 0);
                    const bf16_t* pp = ub + ((size_t)(((lastrow ? pm : pm - 1) * 22 + pn) * 4 + (lastrow ? 2 : 3))) * 256;
                    const bf16_t* pc = ub + ((size_t)((pm * 22 + pn) * 4 + (lastrow ? 3 : 0))) * 256;
                    const bf16_t* pq = ub + ((size_t)(((lastrow ? pm + 1 : pm) * 22 + pn) * 4 + (lastrow ? 0 : 1))) * 256;
                    f32x4 pA[2], cA[2], nA[2], pG[2], cG[2], nG[2];
                    unpack8(*(const u32x4*)(pp + cl), pA[0], pA[1]); unpack8(*(const u32x4*)(pc + cl), cA[0], cA[1]); unpack8(*(const u32x4*)(pq + cl), nA[0], nA[1]);
                    unpack8(*(const u32x4*)(pp + 128 + cl), pG[0], pG[1]); unpack8(*(const u32x4*)(pc + 128 + cl), cG[0], cG[1]); unpack8(*(const u32x4*)(pq + 128 + cl), nG[0], nG[1]);
                    f32x4 o[2];
#pragma unroll
                    for (int n = 0; n < 2; ++n) {
                        const f32x4 av = *(const f32x4*)(cw + ca + 4 * n) * pA[n] + *(const f32x4*)(cw + NUP + ca + 4 * n) * cA[n] + *(const f32x4*)(cw + 2 * NUP + ca + 4 * n) * nA[n] + *(const f32x4*)(cb + ca + 4 * n);
                        const f32x4 gv = *(const f32x4*)(cw + cgt + 4 * n) * pG[n] + *(const f32x4*)(cw + NUP + cgt + 4 * n) * cG[n] + *(const f32x4*)(cw + 2 * NUP + cgt + 4 * n) * nG[n] + *(const f32x4*)(cb + cgt + 4 * n);
#pragma unroll
                        for (int e = 0; e < 4; ++e) o[n][e] = gv[e] * fast_sigmoid(gv[e]) * av[e];
                    }
                    *(u32x4*)(act + (size_t)R * DFF + ca) = pack8(o[0], o[1]);
                }
            }
            asm volatile("s_waitcnt vmcnt(0)" ::: "memory"); __syncthreads();
        }
#endif
        EpiDown E{WSP(float, WS_ST1), kp->in[28], kp->in[29], WSP(float, WS_MOD), WSP(bf16_t, WS_R1B), kp->out};
        pg8::gemm_phase<EpiDown, pg8::StaticOrder, true, true>(lds, g, S, E);
    }
    xcd_barrier(xbar);

    PROBE_T(11, 1); PROBE_T(12, 0);
    if (PH(11)) { KPtr kp = kargs(); TIDS(); float* outp = kp->out; const float *l2g = kp->in[34], *l2b = kp->in[35];
    f32x4 na[4], nb[4];
    ln_load2(outp + (size_t)(2 * gw) * D, outp + (size_t)(2 * gw + 1) * D, lane, na, nb);
    for (int r = 2 * gw; r < MROWS; r += 2 * NGW) {
        f32x4 va[4], vb[4]; float ma, sa, mb, sb;
#pragma unroll
        for (int j = 0; j < 4; ++j) { va[j] = na[j]; vb[j] = nb[j]; }
        if (r + 2 * NGW < MROWS) ln_load2(outp + (size_t)(r + 2 * NGW) * D, outp + (size_t)(r + 2 * NGW + 1) * D, lane, na, nb);
        ln_fin2(l2g, l2b, lane, va, vb, ma, sa, mb, sb);
        f32x4* oa = (f32x4*)(outp + (size_t)r * D) + lane; f32x4* ob = (f32x4*)(outp + (size_t)(r + 1) * D) + lane;
#pragma unroll
        for (int j = 0; j < 4; ++j) { oa[64 * j] = va[j]; ob[64 * j] = vb[j]; }
    } }
#ifdef EXTRA_SYNCS
    for (int i = 0; i < EXTRA_SYNCS; ++i) xcd_barrier(xbar);
#endif
    PROBE_T(12, 1);
    if (PROBE_PH >= 0 && blockIdx.x == 0 && threadIdx.x == 0) { KPtr kq = kargs(); const unsigned long long* tp = (const unsigned long long*)(kq->ws + 800 * 1024);
        const unsigned long long dt = tp[1] - tp[0], t0 = __builtin_amdgcn_s_memrealtime(); while (__builtin_amdgcn_s_memrealtime() - t0 < dt) __builtin_amdgcn_s_sleep(16); }
}

extern "C" void kernel_launch(void* const* d_in, const int* in_sizes, int n_in, void* d_out, int out_size, void* d_ws, size_t ws_size, hipStream_t stream) {
    static int grid = 0;
    if (grid == 0) {
        if (n_in != 36 || out_size != MROWS * D || ws_size < WS_END) { fprintf(stderr, "kernel_launch: unexpected shapes (n_in %d out %d ws %zu)\n", n_in, out_size, ws_size); grid = -1; return; }
        int dev = 0, cus = 0, per_cu = 0;
        hipGetDevice(&dev); hipDeviceGetAttribute(&cus, hipDeviceAttributeMultiprocessorCount, dev);
        hipFuncSetAttribute((const void*)fwd_kernel, hipFuncAttributeMaxDynamicSharedMemorySize, LDS_BYTES);
        hipOccupancyMaxActiveBlocksPerMultiprocessor(&per_cu, (const void*)fwd_kernel, 512, LDS_BYTES);
        if (per_cu < 1) { fprintf(stderr, "kernel_launch: occupancy query returned %d\n", per_cu); per_cu = 1; }
        (void)hipGetLastError();
        grid = cus;
    }
    if (grid < 0) return;
    if (hipMemsetAsync((char*)d_ws + WS_BAR, 0, 16384, stream) != hipSuccess) { fprintf(stderr, "kernel_launch: memset of the barrier words failed\n"); return; }
    Params prm{};
    for (int i = 0; i < 36; ++i) prm.in[i] = (const float*)d_in[i];
    prm.out = (float*)d_out; prm.ws = (unsigned char*)d_ws;
    void* args[] = {&prm};
    hipError_t e = hipLaunchCooperativeKernel((const void*)fwd_kernel, dim3(grid), dim3(512), args, LDS_BYTES, stream);
    if (e != hipSuccess) fprintf(stderr, "cooperative launch failed: %s (grid %d)\n", hipGetErrorString(e), grid);
}
```

```cpp
#include <hip/hip_runtime.h>
#include <hip/hip_cooperative_groups.h>
#include <cstdio>
#include <cstdint>
namespace cg = cooperative_groups;
namespace pg8 {
#define PG8_LAS __attribute__((address_space(3)))
typedef unsigned short bf16_t;
typedef short bf16x8 __attribute__((ext_vector_type(8)));
typedef float f32x4 __attribute__((ext_vector_type(4)));
typedef unsigned u32x4 __attribute__((ext_vector_type(4)));
constexpr int BM = 256, BK = 64, HALF = 128, HTB = HALF * BK * 2  , STAGE_BYTES = 8 * HTB, NXCD = 8, WGM = 2;

__host__ __device__ __forceinline__ int lds_byte(int r, int c) { const int st = (r >> 4) * 2 + (c >> 5), rr = r & 15, cc = c & 31, ob = rr * 64 + cc * 2; return st * 1024 + (ob ^ (((ob >> 9) & 1) << 5)); }
__host__ __device__ __forceinline__ void stage_rc(int b, int& R, int& C) { const int st = b / 1024, sb = b % 1024, swz = sb ^ (((sb >> 9) & 1) << 5); R = (st >> 1) * 16 + swz / 64; C = (st & 1) * 32 + (swz % 64) / 2; }
__host__ __device__ __forceinline__ int perm32(int rho) { const int n = rho >> 4, i = rho & 15; return 8 * (i >> 2) + 4 * n + (i & 3); }

struct Unit { int pm, pn; };
struct Gemm { const bf16_t* A; const bf16_t* Bt; int M, N, K; int a_rows = 256; };

struct StaticOrder {
    int nM, nN, nwg, G, c;
    __host__ __device__ void init(int M, int N, int G_, int c_) { nM = M / BM; nN = N / BM; nwg = nM * nN; G = G_; c = c_; }
    __host__ __device__ bool next(int i, Unit& u) const {
        const long L = (long)i * G + c; if (L >= nwg) return false;
        int wgid = (int)L; { const int q = nwg / NXCD, r = nwg % NXCD, xcd = wgid % NXCD, off = wgid / NXCD; wgid = (xcd < r ? xcd * (q + 1) : r * (q + 1) + (xcd - r) * q) + off; }
        const int nig = WGM * nN, gid = wgid / nig, fm = gid * WGM, gsz = (nM - fm) < WGM ? (nM - fm) : WGM;
        u.pm = fm + ((wgid % nig) % gsz); u.pn = (wgid % nig) / gsz; return true;
    }
    __device__ __forceinline__ void a_ready(const Unit&) const {}
    __device__ __forceinline__ void done(const Unit&) const {}
};
__device__ __forceinline__ unsigned cvt_pk_bf16(float lo, float hi) { unsigned r; asm volatile("v_cvt_pk_bf16_f32 %0, %1, %2" : "=v"(r) : "v"(lo), "v"(hi)); return r; }
typedef float f32x2 __attribute__((ext_vector_type(2)));
template <class Epi, class Sched, bool ALIGN_EPI = false, bool SP2 = false>
__device__ __forceinline__ void gemm_phase(PG8_LAS unsigned char* lds, const Gemm g, const Sched& S, const Epi& E) {
    int tid_l = threadIdx.x; asm volatile("" : "+v"(tid_l));
    const int tid = tid_l, wid = __builtin_amdgcn_readfirstlane(tid >> 6), lane = tid & 63, wr = wid >> 2, wc = wid & 3, fr = lane & 15, fq = lane >> 4;
    const int K = g.K, nt = K / BK;
    unsigned voffA[2], voffB[2];
#pragma unroll
    for (int i = 0; i < 2; ++i) { int R, C; stage_rc(tid * 16 + i * 8192, R, C); const int Rb = Epi::PERM ? ((R & ~31) + perm32(R & 31)) : R;
        voffA[i] = (unsigned)(R * K + C) * 2u; voffB[i] = (unsigned)(Rb * K + C) * 2u; }
    const size_t kstep = (size_t)(BK * 2);
    const size_t hstep = (size_t)HALF * K * 2;
    const size_t tstep = 2 * hstep;
    const size_t atstep = (size_t)g.a_rows * K * 2;
    const unsigned ldsw = (unsigned)wid * 1024u;
    const int aoff = lds_byte(wr * 64 + fr, fq * 8), boff = lds_byte(wc * 32 + fr, fq * 8);
#define PG8_SA(b, h) (((b) * 2 + (h)) * HTB)
#define PG8_SB(b, h) ((4 + (b) * 2 + (h)) * HTB)
#define PG8_STAGE(bufoff, gbase, voff) do { _Pragma("unroll") for (int _i = 0; _i < 2; ++_i) \
        __builtin_amdgcn_global_load_lds((const unsigned*)((const char*)(gbase) + (voff)[_i]), (PG8_LAS unsigned*)(lds + (bufoff) + ldsw + _i * 8192), 16, 0, 0); } while (0)
#define PG8_LDA(dst, b, h) do { _Pragma("unroll") for (int m = 0; m < 4; ++m) _Pragma("unroll") for (int k = 0; k < 2; ++k) dst[m][k] = *(const PG8_LAS bf16x8*)(lds + PG8_SA(b, h) + aoff + m * 2048 + k * 1024); } while (0)
#define PG8_LDB(dst, b, h) do { _Pragma("unroll") for (int n = 0; n < 2; ++n) _Pragma("unroll") for (int k = 0; k < 2; ++k) dst[n][k] = *(const PG8_LAS bf16x8*)(lds + PG8_SB(b, h) + boff + n * 2048 + k * 1024); } while (0)
#define PG8_MMA(ai, bj, At, Bt) do { __builtin_amdgcn_s_setprio(1); _Pragma("unroll") for (int m = 0; m < 4; ++m) _Pragma("unroll") for (int n = 0; n < 2; ++n) _Pragma("unroll") for (int k = 0; k < 2; ++k) \
        acc[ai][bj][m][n] = __builtin_amdgcn_mfma_f32_16x16x32_bf16(Bt[n][k], At[m][k], acc[ai][bj][m][n], 0, 0, 0); __builtin_amdgcn_s_setprio(0); } while (0)
#define PG8_WAIT_V(n) asm volatile("s_waitcnt vmcnt(" #n ")" ::: "memory")
#define PG8_WAIT_L(n) asm volatile("s_waitcnt lgkmcnt(" #n ")" ::: "memory")
#define PG8_BAR __builtin_amdgcn_s_barrier()
#define PG8_SCHED __builtin_amdgcn_sched_barrier(0)
    Unit cur, nxt; int ui = 0;
    if (!S.next(0, cur)) return;
    f32x4 acc[2][2][4][2];
#pragma unroll
    for (int a = 0; a < 2; ++a)
#pragma unroll
        for (int b = 0; b < 2; ++b)
#pragma unroll
            for (int m = 0; m < 4; ++m)
#pragma unroll
                for (int n = 0; n < 2; ++n) acc[a][b][m][n] = (f32x4){0.f, 0.f, 0.f, 0.f};
    bf16x8 At[4][2], B0[2][2], B1[2][2];
    const char* cA = (const char*)g.A + (size_t)cur.pm * atstep; const char* cB = (const char*)g.Bt + (size_t)cur.pn * tstep;
    S.a_ready(cur);
    if constexpr (SP2) {
        PG8_STAGE(PG8_SB(0, 0), cB, voffB); PG8_STAGE(PG8_SB(0, 1), cB + hstep, voffB); PG8_STAGE(PG8_SA(0, 0), cA, voffA); PG8_STAGE(PG8_SA(0, 1), cA + hstep, voffA);
        if (wr == 1) PG8_BAR;
        PG8_WAIT_V(2); PG8_BAR;
        PG8_STAGE(PG8_SB(1, 0), cB + kstep, voffB); PG8_STAGE(PG8_SA(1, 0), cA + kstep, voffA); PG8_STAGE(PG8_SB(1, 1), cB + hstep + kstep, voffB);
        PG8_WAIT_V(6); PG8_BAR;
    } else {
        PG8_STAGE(PG8_SB(0, 0), cB, voffB); PG8_STAGE(PG8_SA(0, 0), cA, voffA); PG8_STAGE(PG8_SB(0, 1), cB + hstep, voffB); PG8_STAGE(PG8_SA(0, 1), cA + hstep, voffA);
        if (wr == 1) PG8_BAR;
        PG8_WAIT_V(4); PG8_BAR;
        PG8_STAGE(PG8_SB(1, 0), cB + kstep, voffB); PG8_STAGE(PG8_SA(1, 0), cA + kstep, voffA); PG8_STAGE(PG8_SB(1, 1), cB + hstep + kstep, voffB);
        PG8_WAIT_V(6); PG8_BAR;
    }
    for (;;) {
        const bool has_next = S.next(ui + 1, nxt);
        const char* nA = has_next ? (const char*)g.A + (size_t)nxt.pm * atstep : cA; const char* nB = has_next ? (const char*)g.Bt + (size_t)nxt.pn * tstep : cB;
        for (int t = 0; t < nt; t += 2) {
            const bool last = (t == nt - 2);
            const char* a1 = cA + (size_t)(t + 1) * kstep;
            const char* a2 = last ? nA : cA + (size_t)(t + 2) * kstep; const char* b2 = last ? nB : cB + (size_t)(t + 2) * kstep;
            const char* a3 = a2 + kstep; const char* b3 = b2 + kstep;
            if (last && has_next) S.a_ready(nxt);
            if constexpr (SP2) {
            PG8_LDB(B0, 0, 0); PG8_LDB(B1, 0, 1); PG8_SCHED; PG8_LDA(At, 0, 0); PG8_STAGE(PG8_SA(1, 1), a1 + hstep, voffA);
            PG8_WAIT_V(8); PG8_WAIT_L(0); PG8_BAR; PG8_MMA(0, 0, At, B0); PG8_MMA(0, 1, At, B1); PG8_BAR; PG8_SCHED;
            PG8_LDA(At, 0, 1); PG8_STAGE(PG8_SB(0, 0), b2, voffB); PG8_STAGE(PG8_SB(0, 1), b2 + hstep, voffB); PG8_STAGE(PG8_SA(0, 0), a2, voffA);
            PG8_WAIT_V(8); PG8_WAIT_L(0); PG8_BAR; PG8_MMA(1, 0, At, B0); PG8_MMA(1, 1, At, B1); PG8_BAR; PG8_SCHED;
            PG8_LDB(B0, 1, 0); PG8_LDB(B1, 1, 1); PG8_SCHED; PG8_LDA(At, 1, 0); PG8_STAGE(PG8_SA(0, 1), a2 + hstep, voffA);
            PG8_WAIT_V(8); PG8_WAIT_L(0); PG8_BAR; PG8_MMA(0, 0, At, B0); PG8_MMA(0, 1, At, B1); PG8_BAR; PG8_SCHED;
            PG8_LDA(At, 1, 1); PG8_STAGE(PG8_SB(1, 0), b3, voffB); PG8_STAGE(PG8_SB(1, 1), b3 + hstep, voffB); PG8_STAGE(PG8_SA(1, 0), a3, voffA);
            PG8_WAIT_V(8); PG8_WAIT_L(0); PG8_BAR; PG8_MMA(1, 0, At, B0); PG8_MMA(1, 1, At, B1); PG8_BAR; PG8_SCHED;
            } else {
            PG8_LDB(B0, 0, 0); PG8_SCHED; PG8_LDA(At, 0, 0); PG8_STAGE(PG8_SA(1, 1), a1 + hstep, voffA);
            PG8_WAIT_L(8); PG8_BAR; PG8_WAIT_L(0); PG8_MMA(0, 0, At, B0); PG8_BAR; PG8_SCHED;
            PG8_LDB(B1, 0, 1); PG8_STAGE(PG8_SB(0, 0), b2, voffB);
            PG8_BAR; PG8_WAIT_L(0); PG8_MMA(0, 1, At, B1); PG8_BAR;
            PG8_LDA(At, 0, 1); PG8_STAGE(PG8_SA(0, 0), a2, voffA);
            PG8_BAR; PG8_WAIT_L(0); PG8_MMA(1, 0, At, B0); PG8_BAR; PG8_SCHED;
            PG8_STAGE(PG8_SB(0, 1), b2 + hstep, voffB);
            PG8_WAIT_V(6); PG8_BAR; PG8_MMA(1, 1, At, B1); PG8_BAR;
            PG8_LDB(B0, 1, 0); PG8_SCHED; PG8_LDA(At, 1, 0); PG8_STAGE(PG8_SA(0, 1), a2 + hstep, voffA);
            PG8_WAIT_L(8); PG8_BAR; PG8_WAIT_L(0); PG8_MMA(0, 0, At, B0); PG8_BAR; PG8_SCHED;
            PG8_LDB(B1, 1, 1); PG8_STAGE(PG8_SB(1, 0), b3, voffB);
            PG8_BAR; PG8_WAIT_L(0); PG8_MMA(0, 1, At, B1); PG8_BAR;
            PG8_LDA(At, 1, 1); PG8_STAGE(PG8_SA(1, 0), a3, voffA);
            PG8_BAR; PG8_WAIT_L(0); PG8_MMA(1, 0, At, B0); PG8_BAR; PG8_SCHED;
            PG8_STAGE(PG8_SB(1, 1), b3 + hstep, voffB);
            PG8_WAIT_V(6); PG8_BAR; PG8_MMA(1, 1, At, B1); PG8_BAR;
            }
        }
        if constexpr (ALIGN_EPI) { if (wr == 0) PG8_BAR; }
        if constexpr (!Epi::AFTER_DRAIN) { E(acc, cur, wr, wc, fr, fq); S.done(cur); }
        if (!has_next) break;
#pragma unroll
        for (int a = 0; a < 2; ++a)
#pragma unroll
            for (int b = 0; b < 2; ++b)
#pragma unroll
                for (int m = 0; m < 4; ++m)
#pragma unroll
                    for (int n = 0; n < 2; ++n) acc[a][b][m][n] = (f32x4){0.f, 0.f, 0.f, 0.f};
        cur = nxt; cA = nA; cB = nB; ++ui;
        if constexpr (ALIGN_EPI) { if (wr == 1) PG8_BAR; }
    }
    PG8_WAIT_V(0);
    if constexpr (!ALIGN_EPI) { if (wr == 0) PG8_BAR; }
    PG8_BAR;
    if constexpr (Epi::AFTER_DRAIN) { E.fused(acc, cur, wr, wc, fr, fq, lds, wid, lane); S.done(cur); }
#undef PG8_SA
#undef PG8_SB
#undef PG8_STAGE
#undef PG8_LDA
#undef PG8_LDB
#undef PG8_MMA
#undef PG8_WAIT_V
#undef PG8_WAIT_L
#undef PG8_BAR
#undef PG8_SCHED
}
}

#ifndef EN_ATT
#define EN_ATT 1
#endif
#ifndef EN_HY
#define EN_HY 1
#endif
#ifndef EN_FFN
#define EN_FFN 1
#endif
#ifndef PROBE_PH
#define PROBE_PH -1
#endif
#ifndef PHASES
#define PHASES 0xFFFF
#endif
#define PH(k) ((PHASES >> (k)) & 1)
#define LAS __attribute__((address_space(3)))
typedef unsigned short bf16_t;
typedef pg8::f32x4 f32x4;
typedef pg8::u32x4 u32x4;
typedef pg8::bf16x8 bf16x8;
typedef float f32x16 __attribute__((ext_vector_type(16)));
typedef float f32x2 __attribute__((ext_vector_type(2)));
typedef unsigned u32x2 __attribute__((ext_vector_type(2)));
typedef short s16x4 __attribute__((ext_vector_type(4)));

constexpr int D = 1024, NB = 8, SEQ = 4096, MROWS = NB * SEQ, CTX = 256, MCTX = NB * CTX, KV = CTX + SEQ;
constexpr int INC = 5120, DFF = 2816, NUP = 2 * DFF, NADA = 6 * D;
constexpr float LN_EPS = 1e-5f, RMS_EPS = 1e-5f;
constexpr float DN_ALPHA = 1.189207115002721f;
constexpr float LAM_INIT = 0.2f;
constexpr float QSCALE = 0.125f * 1.4426950408889634f;

constexpr size_t MiB = 1u << 20;
constexpr size_t WS_ST0 = 0, WS_ST1 = 256 * 1024, WS_ROPE = 512 * 1024, WS_TW = 528 * 1024, WS_MOD = 576 * 1024;
constexpr size_t WS_MODP = 1 * MiB;
constexpr size_t WS_WIN = 3 * MiB, WS_WHY = 13 * MiB, WS_WAT = 14 * MiB, WS_WOUT = 15 * MiB, WS_WUP = 17 * MiB, WS_WDN = 28 * MiB;
constexpr size_t WS_XM = 34 * MiB;
constexpr size_t WS_ON = 34 * MiB, WS_YHT = 66 * MiB, WS_HM = 34 * MiB;
constexpr size_t WS_CTXM = 98 * MiB;
constexpr size_t WS_FILT = 490 * MiB;
constexpr size_t WS_SG = 102 * MiB;
constexpr size_t WS_KSPEC = 230 * MiB;
constexpr size_t WS_MBUF = 230 * MiB;
constexpr size_t WS_ZHY = 294 * MiB;
constexpr size_t WS_YH = 294 * MiB;
constexpr size_t WS_Q = 390 * MiB, WS_K = 422 * MiB, WS_V = 456 * MiB;
constexpr size_t WS_U = 102 * MiB;
constexpr size_t WS_ACT = 278 * MiB;
constexpr size_t WS_TSC = 102 * MiB;
constexpr size_t WS_R1B = 134 * MiB;
constexpr size_t WS_END = 506 * MiB;

constexpr int LDS_MISC = 139264;
constexpr int LDS_BYTES = 139264 + 256;
constexpr size_t WS_BAR = 832 * 1024;

__device__ __forceinline__ int tid_fresh() { int t = threadIdx.x; asm volatile("" : "+v"(t)); return t; }
__device__ __forceinline__ unsigned pk2(float lo, float hi) { return pg8::cvt_pk_bf16(lo, hi); }
__device__ __forceinline__ float bflo(unsigned w) { return __uint_as_float(w << 16); }
__device__ __forceinline__ float bfhi(unsigned w) { return __uint_as_float(w & 0xffff0000u); }
__device__ __forceinline__ float bf1(bf16_t v) { return __uint_as_float((unsigned)v << 16); }
template <int MASK> __device__ __forceinline__ float xswz(float v) { return __uint_as_float((unsigned)__builtin_amdgcn_ds_swizzle((int)__float_as_uint(v), 0x1F | (MASK << 10))); }
__device__ __forceinline__ float xsum32(float v) { const unsigned u = __float_as_uint(v); auto rr = __builtin_amdgcn_permlane32_swap(u, u, false, false); return __uint_as_float(rr[0]) + __uint_as_float(rr[1]); }
__device__ __forceinline__ float xmax32(float v) { const unsigned u = __float_as_uint(v); auto rr = __builtin_amdgcn_permlane32_swap(u, u, false, false); return fmaxf(__uint_as_float(rr[0]), __uint_as_float(rr[1])); }
__device__ __forceinline__ float xget32(float v, bool upper) { const unsigned u = __float_as_uint(v); auto rr = __builtin_amdgcn_permlane32_swap(u, u, false, false); return __uint_as_float(upper ? rr[0] : rr[1]); }
__device__ __forceinline__ float wave_sum(float v) {
    v += xswz<1>(v); v += xswz<2>(v); v += xswz<4>(v); v += xswz<8>(v); v += xswz<16>(v);
    return xsum32(v);
}
__device__ __forceinline__ float fast_sigmoid(float x) { return __builtin_amdgcn_rcpf(1.0f + __builtin_amdgcn_exp2f(-1.4426950408889634f * x)); }
__device__ __forceinline__ u32x4 pack8(const f32x4& a, const f32x4& b) { u32x4 w; w.x = pk2(a[0], a[1]); w.y = pk2(a[2], a[3]); w.z = pk2(b[0], b[1]); w.w = pk2(b[2], b[3]); return w; }
__device__ __forceinline__ void unpack8(const u32x4& w, f32x4& a, f32x4& b) { a = (f32x4){bflo(w.x), bfhi(w.x), bflo(w.y), bfhi(w.y)}; b = (f32x4){bflo(w.z), bfhi(w.z), bflo(w.w), bfhi(w.w)}; }

__device__ __forceinline__ size_t koff(int pos, int d) { return ((size_t)(((pos >> 6) * 8 + (d >> 3)) * 64 + (pos & 63))) * 8 + (d & 7); }
__device__ __forceinline__ size_t voff(int pos, int dv) { return ((size_t)(((pos >> 6) * 4 + (dv >> 5)) * 64 + (pos & 63))) * 32 + (dv & 31); }
struct EpiIn {
    static constexpr bool PERM = true, AFTER_DRAIN = false;
    bf16_t *zhy, *q, *k, *v, *sg; const f32x2* rope;
    __device__ __forceinline__ void operator()(const f32x4 (&acc)[2][2][4][2], const pg8::Unit& u, int wr, int wc, int fr, int fq) const {
        const int pn = u.pn;
#pragma unroll
        for (int ai = 0; ai < 2; ++ai)
#pragma unroll
            for (int m = 0; m < 4; ++m) {
                const int r = u.pm * 256 + ai * 128 + wr * 64 + m * 16 + fr; const int b = r >> 12, t = r & 4095;
#pragma unroll
                for (int bj = 0; bj < 2; ++bj) {
                    const int c = pn * 256 + bj * 128 + wc * 32 + fq * 8;
                    const f32x4 v0 = acc[ai][bj][m][0], v1 = acc[ai][bj][m][1];
                    if (pn < 6) {
                        bf16_t* dst = zhy + ((size_t)(b * 1536 + c) * 4096 + t);
                        const u32x4 w = pack8(v0, v1);
                        dst[0] = (bf16_t)(w.x & 0xffff); dst[4096] = (bf16_t)(w.x >> 16); dst[2 * 4096] = (bf16_t)(w.y & 0xffff); dst[3 * 4096] = (bf16_t)(w.y >> 16);
                        dst[4 * 4096] = (bf16_t)(w.z & 0xffff); dst[5 * 4096] = (bf16_t)(w.z >> 16); dst[6 * 4096] = (bf16_t)(w.w & 0xffff); dst[7 * 4096] = (bf16_t)(w.w >> 16);
                    } else if (pn < 10) {
                        const bool isq = pn < 8; const int cq = c - (isq ? 1536 : 2048);
                        const int h = cq >> 7, cc = (cq >> 6) & 1, d = cq & 63, axis = (cq >> 5) & 1;
                        const int pos = axis ? (t & 63) : (t >> 6);
                        const f32x4* rt = (const f32x4*)(rope + pos * 16 + (fq & 1) * 8);
                        const f32x4 t0 = rt[0], t1 = rt[1], t2 = rt[2], t3 = rt[3];
                        const float sgn = (fq < 2) ? -1.0f : 1.0f;
                        f32x4 p0, p1;
#pragma unroll
                        for (int e = 0; e < 4; ++e) { p0[e] = xget32(v0[e], fq >= 2); p1[e] = xget32(v1[e], fq >= 2); }
                        f32x4 o0, o1;
                        o0[0] = v0[0] * t0[0] + sgn * p0[0] * t0[1]; o0[1] = v0[1] * t0[2] + sgn * p0[1] * t0[3];
                        o0[2] = v0[2] * t1[0] + sgn * p0[2] * t1[1]; o0[3] = v0[3] * t1[2] + sgn * p0[3] * t1[3];
                        o1[0] = v1[0] * t2[0] + sgn * p1[0] * t2[1]; o1[1] = v1[1] * t2[2] + sgn * p1[1] * t2[3];
                        o1[2] = v1[2] * t3[0] + sgn * p1[2] * t3[1]; o1[3] = v1[3] * t3[2] + sgn * p1[3] * t3[3];
                        if (isq) { o0 = o0 * QSCALE; o1 = o1 * QSCALE; *(u32x4*)(q + ((size_t)((b * 4 + h) * 2 + cc) * SEQ + t) * 64 + d) = pack8(o0, o1); }
                        else *(u32x4*)(k + (size_t)((b * 4 + h) * 2 + cc) * KV * 64 + koff(CTX + t, d)) = pack8(o0, o1);
                    } else if (pn < 12) {
                        const int cv = c - 2560, h = cv >> 7, dv = cv & 127;
                        *(u32x4*)(v + (size_t)(b * 4 + h) * KV * 128 + voff(CTX + t, dv)) = pack8(v0, v1);
                    } else {
                        f32x4 s0, s1;
#pragma unroll
                        for (int e = 0; e < 4; ++e) { s0[e] = fast_sigmoid(v0[e]); s1[e] = fast_sigmoid(v1[e]); }
                        *(u32x4*)(sg + (size_t)r * 2048 + (c - 3072)) = pack8(s0, s1);
                    }
                }
            }
    }
};
struct EpiCtx {
    static constexpr bool PERM = true, AFTER_DRAIN = false;
    bf16_t *k, *v;
    __device__ __forceinline__ void operator()(const f32x4 (&acc)[2][2][4][2], const pg8::Unit& u, int wr, int wc, int fr, int fq) const {
        const int pn = u.pn;
#pragma unroll
        for (int ai = 0; ai < 2; ++ai)
#pragma unroll
            for (int m = 0; m < 4; ++m) {
                const int r = u.pm * 256 + ai * 128 + wr * 64 + m * 16 + fr; const int b = r >> 8, t = r & 255;
#pragma unroll
                for (int bj = 0; bj < 2; ++bj) {
                    const int c = pn * 256 + bj * 128 + wc * 32 + fq * 8;
                    const u32x4 w = pack8(acc[ai][bj][m][0], acc[ai][bj][m][1]);
                    if (pn < 2) { const int h = c >> 7, cc = (c >> 6) & 1, d = c & 63; *(u32x4*)(k + (size_t)((b * 4 + h) * 2 + cc) * KV * 64 + koff(t, d)) = w; }
                    else { const int cv = c - 512, h = cv >> 7, dv = cv & 127; *(u32x4*)(v + (size_t)(b * 4 + h) * KV * 128 + voff(t, dv)) = w; }
                }
            }
    }
};
template <bool ADD> struct EpiMerge {
    static constexpr bool PERM = true, AFTER_DRAIN = false;
    bf16_t* mb; const bf16_t* sg;
    __device__ __forceinline__ void operator()(const f32x4 (&acc)[2][2][4][2], const pg8::Unit& u, int wr, int wc, int fr, int fq) const {
#pragma unroll
        for (int ai = 0; ai < 2; ++ai)
#pragma unroll
            for (int m = 0; m < 4; ++m) {
                const int r = u.pm * 256 + ai * 128 + wr * 64 + m * 16 + fr;
#pragma unroll
                for (int bj = 0; bj < 2; ++bj) {
                    const int c = u.pn * 256 + bj * 128 + wc * 32 + fq * 8;
                    f32x4 g0, g1; unpack8(*(const u32x4*)(sg + (size_t)r * 2048 + (ADD ? 1024 : 0) + c), g0, g1);
                    f32x4 o0 = acc[ai][bj][m][0] * g0, o1 = acc[ai][bj][m][1] * g1;
                    bf16_t* dst = mb + (size_t)r * D + c;
                    if (ADD) { f32x4 p0, p1; unpack8(*(const u32x4*)dst, p0, p1); o0 = o0 + p0; o1 = o1 + p1; }
                    *(u32x4*)dst = pack8(o0, o1);
                }
            }
    }
};
struct EpiOut {
    static constexpr bool PERM = true, AFTER_DRAIN = false;
    const float *x, *st0, *lg, *lb, *mod; bf16_t* r1b;
    __device__ __forceinline__ void operator()(const f32x4 (&acc)[2][2][4][2], const pg8::Unit& u, int wr, int wc, int fr, int fq) const {
        const int b = (u.pm * 256) >> 12;
#pragma unroll
        for (int bj = 0; bj < 2; ++bj) {
            const int c = u.pn * 256 + bj * 128 + wc * 32 + fq * 8;
            f32x4 g[2], bb[2], g1[2];
#pragma unroll
            for (int n = 0; n < 2; ++n) { g[n] = *(const f32x4*)(lg + c + 4 * n); bb[n] = *(const f32x4*)(lb + c + 4 * n); g1[n] = *(const f32x4*)(mod + b * NADA + 2 * D + c + 4 * n); }
#pragma unroll
            for (int ai = 0; ai < 2; ++ai)
#pragma unroll
                for (int m = 0; m < 4; ++m) {
                    const int r = u.pm * 256 + ai * 128 + wr * 64 + m * 16 + fr;
                    const f32x2 st = *(const f32x2*)(st0 + 2 * r);
                    f32x4 rr[2];
#pragma unroll
                    for (int n = 0; n < 2; ++n) {
                        const f32x4 xv = *(const f32x4*)(x + (size_t)r * D + c + 4 * n);
                        const f32x4 xl = (xv - st.x) * st.y * g[n] + bb[n];
                        rr[n] = xl * DN_ALPHA + g1[n] * acc[ai][bj][m][n];
                    }
                    *(u32x4*)(r1b + (size_t)r * D + c) = pack8(rr[0], rr[1]);
                }
        }
    }
};
struct EpiUpGate {
    static constexpr bool PERM = true, AFTER_DRAIN = false;
    bf16_t* tsc; bf16_t* act; const float* cw; const float* cb; bf16_t* ubnd;
    __device__ __forceinline__ void operator()(const f32x4 (&acc)[2][2][4][2], const pg8::Unit& u, int wr, int wc, int fr, int fq) const {
        bf16_t* T = tsc + (size_t)blockIdx.x * 65536;
#pragma unroll
        for (int ai = 0; ai < 2; ++ai)
#pragma unroll
            for (int m = 0; m < 4; ++m) {
                const int r = ai * 128 + wr * 64 + m * 16 + fr;
#pragma unroll
                for (int bj = 0; bj < 2; ++bj) *(u32x4*)(T + r * 256 + bj * 128 + wc * 32 + fq * 8) = pack8(acc[ai][bj][m][0], acc[ai][bj][m][1]);
            }
        asm volatile("s_waitcnt vmcnt(0)" ::: "memory"); __builtin_amdgcn_s_barrier(); asm volatile("" ::: "memory");
        const int tid = (wr * 4 + wc) * 64 + fq * 16 + fr, cg_ = tid & 15, rc = tid >> 4;
        if (tid < 128) {
            const int q = tid >> 5, ch = tid & 31, rr = (q < 2) ? q : 252 + q;
            *(u32x4*)(ubnd + ((size_t)((u.pm * 22 + u.pn) * 4 + q)) * 256 + ch * 8) = *(const u32x4*)(T + rr * 256 + ch * 8);
        }
        const int ca = u.pn * 128 + cg_ * 8, cgt = DFF + ca;
        f32x4 wA[3][2], wG[3][2], bA[2], bG[2];
#pragma unroll
        for (int j = 0; j < 3; ++j)
#pragma unroll
            for (int n = 0; n < 2; ++n) { wA[j][n] = *(const f32x4*)(cw + j * NUP + ca + 4 * n); wG[j][n] = *(const f32x4*)(cw + j * NUP + cgt + 4 * n); }
#pragma unroll
        for (int n = 0; n < 2; ++n) { bA[n] = *(const f32x4*)(cb + ca + 4 * n); bG[n] = *(const f32x4*)(cb + cgt + 4 * n); }
        const f32x4 z4 = {0.f, 0.f, 0.f, 0.f};
#pragma unroll 1
        for (int hh = 0; hh < 2; ++hh) {
            u32x4 ra[6], rg[6];
#pragma unroll
            for (int i = 0; i < 6; ++i) { int r = rc * 8 + hh * 4 - 1 + i; r = r < 0 ? 0 : (r > 255 ? 255 : r);
                ra[i] = *(const u32x4*)(T + r * 256 + cg_ * 8); rg[i] = *(const u32x4*)(T + r * 256 + 128 + cg_ * 8); }
#pragma unroll
            for (int i = 0; i < 4; ++i) {
                const int r = rc * 8 + hh * 4 + i, R = 256 * u.pm + r, t = R & 4095;
                f32x4 pA[2], cA[2], nA[2], pG[2], cG[2], nG[2];
                unpack8(ra[i], pA[0], pA[1]); unpack8(ra[i + 1], cA[0], cA[1]); unpack8(ra[i + 2], nA[0], nA[1]);
                unpack8(rg[i], pG[0], pG[1]); unpack8(rg[i + 1], cG[0], cG[1]); unpack8(rg[i + 2], nG[0], nG[1]);
                if (t == 0) { pA[0] = pA[1] = pG[0] = pG[1] = z4; }
                if (t == 4095) { nA[0] = nA[1] = nG[0] = nG[1] = z4; }
                f32x4 o[2];
#pragma unroll
                for (int n = 0; n < 2; ++n) {
                    const f32x4 av = wA[0][n] * pA[n] + wA[1][n] * cA[n] + wA[2][n] * nA[n] + bA[n];
                    const f32x4 gv = wG[0][n] * pG[n] + wG[1][n] * cG[n] + wG[2][n] * nG[n] + bG[n];
#pragma unroll
                    for (int e = 0; e < 4; ++e) o[n][e] = gv[e] * fast_sigmoid(gv[e]) * av[e];
                }
                if ((r >= 1 || t == 0) && (r <= 254 || t == 4095)) *(u32x4*)(act + (size_t)R * DFF + ca) = pack8(o[0], o[1]);
            }
        }
    }
};
struct EpiDown {
    static constexpr bool PERM = true, AFTER_DRAIN = false;
    const float *st1, *lg, *lb, *mod; const bf16_t* r1b; float* out;
    __device__ __forceinline__ void operator()(const f32x4 (&acc)[2][2][4][2], const pg8::Unit& u, int wr, int wc, int fr, int fq) const {
        const int b = (u.pm * 256) >> 12;
#pragma unroll
        for (int bj = 0; bj < 2; ++bj) {
            const int c = u.pn * 256 + bj * 128 + wc * 32 + fq * 8;
            f32x4 g[2], bb[2], g2[2];
#pragma unroll
            for (int n = 0; n < 2; ++n) { g[n] = *(const f32x4*)(lg + c + 4 * n); bb[n] = *(const f32x4*)(lb + c + 4 * n); g2[n] = *(const f32x4*)(mod + b * NADA + 5 * D + c + 4 * n); }
#pragma unroll
            for (int ai = 0; ai < 2; ++ai)
#pragma unroll
                for (int m = 0; m < 4; ++m) {
                    const int r = u.pm * 256 + ai * 128 + wr * 64 + m * 16 + fr;
                    const f32x2 st = *(const f32x2*)(st1 + 2 * r);
                    f32x4 rv2[2]; unpack8(*(const u32x4*)(r1b + (size_t)r * D + c), rv2[0], rv2[1]);
#pragma unroll
                    for (int n = 0; n < 2; ++n) {
                        const f32x4 x1 = (rv2[n] - st.x) * st.y * g[n] + bb[n];
#if EN_FFN
                        *(f32x4*)(out + (size_t)r * D + c + 4 * n) = x1 * DN_ALPHA + g2[n] * acc[ai][bj][m][n];
#else
                        *(f32x4*)(out + (size_t)r * D + c + 4 * n) = x1 * DN_ALPHA;
#endif
                    }
                }
        }
    }
};

namespace att {
constexpr int NT = KV / 64, KSTG = 16384, V_BASE = 3 * 16384, VSTG = 16384;
__device__ __forceinline__ void stage_k(LAS unsigned char* dst, const bf16_t* K0, const bf16_t* K1, int key0, int wid, int lane) {
    const size_t o = ((size_t)((key0 >> 6) * 8 + wid) * 64 + lane) * 8;
    __builtin_amdgcn_global_load_lds((const unsigned*)(K0 + o), (LAS unsigned*)(dst + wid * 1024), 16, 0, 0);
    __builtin_amdgcn_global_load_lds((const unsigned*)(K1 + o), (LAS unsigned*)(dst + 8192 + wid * 1024), 16, 0, 0);
}
__device__ __forceinline__ void stage_v(LAS unsigned char* dst, const bf16_t* Vb, int key0, int wid, int lane) {
#pragma unroll
    for (int i = 0; i < 2; ++i) {
        const int pv = wid + 8 * i, db = pv >> 2, kg = pv & 3;
        __builtin_amdgcn_global_load_lds((const unsigned*)(Vb + ((size_t)((key0 >> 6) * 4 + db) * 64 + 16 * kg) * 32 + lane * 8), (LAS unsigned*)(dst + db * 4096 + kg * 1024), 16, 0, 0);
    }
}
__device__ __forceinline__ s16x4 vtr(const LAS unsigned char* p) {
    typedef short v4i16_t __attribute__((ext_vector_type(4)));
    return __builtin_bit_cast(s16x4, __builtin_amdgcn_ds_read_tr16_b64_v4i16((LAS v4i16_t*)p));
}
#define ATT_THR 8.0f
#define VTR_ASM(dst, addr, off) asm volatile("ds_read_b64_tr_b16 %0, %1 offset:%c2" : "=&v"(dst) : "v"(addr), "i"(off) : "memory")
#define VTR_BLK(blk) do { _Pragma("unroll") for (int ks = 0; ks < 4; ++ks) { VTR_ASM(la[ks], vaddr, (blk) * 4096 + ks * 1024); VTR_ASM(ha[ks], vaddr, (blk) * 4096 + ks * 1024 + 512); } } while (0)
#define VTR_WAIT() asm volatile("s_waitcnt lgkmcnt(0)" : "+v"(la[0]), "+v"(la[1]), "+v"(la[2]), "+v"(la[3]), "+v"(ha[0]), "+v"(ha[1]), "+v"(ha[2]), "+v"(ha[3]) :: "memory")
#define PV_BLK(blk) do { _Pragma("unroll") for (int ks = 0; ks < 4; ++ks) { \
        const bf16x8 vf = (bf16x8){la[ks][0], la[ks][1], la[ks][2], la[ks][3], ha[ks][0], ha[ks][1], ha[ks][2], ha[ks][3]}; \
        o[blk] = __builtin_amdgcn_mfma_f32_32x32x16_bf16(vf, pf[ks], o[blk], 0, 0, 0); } } while (0)
#define QKT(P0, P1, KSLOT) do { \
    const LAS unsigned char* Ks = lds + (KSLOT) * KSTG + (comp ? 8192 : 0); \
    _Pragma("unroll") for (int d0 = 0; d0 < 4; ++d0) { \
        const bf16x8 ka = *(const LAS bf16x8*)(Ks + (2 * d0 + hi) * 1024 + r32 * 16); \
        const bf16x8 kb = *(const LAS bf16x8*)(Ks + (2 * d0 + hi) * 1024 + 512 + r32 * 16); \
        if (d0 == 0) { P0 = __builtin_amdgcn_mfma_f32_32x32x16_bf16(ka, qr[0], negm, 0, 0, 0); P1 = __builtin_amdgcn_mfma_f32_32x32x16_bf16(kb, qr[0], negm, 0, 0, 0); } \
        else { P0 = __builtin_amdgcn_mfma_f32_32x32x16_bf16(ka, qr[d0], P0, 0, 0, 0); P1 = __builtin_amdgcn_mfma_f32_32x32x16_bf16(kb, qr[d0], P1, 0, 0, 0); } } \
} while (0)
#define EXP8(P, B) do { _Pragma("unroll") for (int r = (B); r < (B) + 8; ++r) { P[r] = __builtin_amdgcn_exp2f(P[r]); } } while (0)
#define WAITBAR(n) asm volatile("s_waitcnt vmcnt(" #n ") lgkmcnt(0)\n\ts_barrier" ::: "memory")
__device__ __forceinline__ void attn_unit(int b, int h, int qb, const bf16_t* Q, const bf16_t* Kg, const bf16_t* Vg, bf16_t* On, float lam, const float* subln, LAS unsigned char* lds) {
    const int tid = tid_fresh(), lane = tid & 63, r32 = lane & 31, hi = lane >> 5;
    const int wid = __builtin_amdgcn_readfirstlane(tid >> 6), comp = wid >> 2, wq = wid & 3;
    const int t0 = qb * 128 + wq * 32;
    const bf16_t* Qp = Q + ((size_t)((b * 4 + h) * 2 + comp) * SEQ + t0 + r32) * 64;
    const bf16_t* K0 = Kg + (size_t)((b * 4 + h) * 2) * KV * 64; const bf16_t* K1 = K0 + (size_t)KV * 64;
    const bf16_t* Vb = Vg + (size_t)(b * 4 + h) * KV * 128;
    bf16x8 qr[4];
#pragma unroll
    for (int d0 = 0; d0 < 4; ++d0) qr[d0] = *(const bf16x8*)(Qp + d0 * 16 + hi * 8);
    asm volatile("" ::: "memory");
    stage_k(lds, K0, K1, 0, wid, lane); stage_k(lds + KSTG, K0, K1, 64, wid, lane);
    stage_k(lds + 2 * KSTG, K0, K1, 128, wid, lane); stage_v(lds + V_BASE, Vb, 0, wid, lane);
    f32x16 o[4];
#pragma unroll
    for (int i = 0; i < 4; ++i)
#pragma unroll
        for (int r = 0; r < 16; ++r) o[i][r] = 0.f;
    float mref = 0.f, lrun = 0.f, alpha_prev = 1.f;
    f32x16 negm, pc0, pc1, pn0, pn1;
#pragma unroll
    for (int r = 0; r < 16; ++r) { negm[r] = 0.f; pn0[r] = 0.f; pn1[r] = 0.f; }
    bf16x8 pf[4];
#pragma unroll
    for (int i = 0; i < 4; ++i) pf[i] = (bf16x8){0, 0, 0, 0, 0, 0, 0, 0};
    s16x4 la[4], ha[4];
    const int vlane = ((lane >> 4) & 1) * 32 + (lane & 3) * 8 + (4 * hi + ((lane & 15) >> 2)) * 64;
    const unsigned vbase = (unsigned)(uintptr_t)(lds + V_BASE + vlane);
    asm volatile("s_waitcnt vmcnt(6)" ::: "memory"); __builtin_amdgcn_s_barrier(); asm volatile("" ::: "memory");
    QKT(pc0, pc1, 0);
    int k3 = 1;
    for (int t = 0; t < NT; ++t) {
        if (t + 2 < NT) WAITBAR(4); else if (t + 1 < NT) WAITBAR(2); else WAITBAR(0);
        if (t + 3 < NT) stage_k(lds + (k3 == 0 ? 2 : k3 - 1) * KSTG, K0, K1, (t + 3) * 64, wid, lane);
        if (t + 1 < NT) stage_v(lds + V_BASE + ((t + 1) & 3) * VSTG, Vb, (t + 1) * 64, wid, lane);
        if (t + 1 < NT) QKT(pn0, pn1, k3);
        float mx = fmaxf(pc0[0], pc1[0]);
#pragma unroll
        for (int r = 1; r < 16; ++r) mx = fmaxf(fmaxf(mx, pc0[r]), pc1[r]);
        mx = xmax32(mx);
        float alpha_cur = 1.0f;
        if (__any(mx > ATT_THR)) {
            const float dl = fmaxf(mx, 0.f); mref += dl;
#pragma unroll
            for (int r = 0; r < 16; ++r) { pc0[r] -= dl; pc1[r] -= dl; pn0[r] -= dl; pn1[r] -= dl; negm[r] = -mref; }
            alpha_cur = __builtin_amdgcn_exp2f(-dl); lrun *= alpha_cur;
        }
        if (__any(alpha_prev != 1.0f)) {
#pragma unroll
            for (int i = 0; i < 4; ++i)
#pragma unroll
                for (int r = 0; r < 16; ++r) o[i][r] *= alpha_prev;
        }
        if (t > 0) {
            const unsigned vaddr = vbase + (unsigned)((t + 3) & 3) * VSTG;
            VTR_BLK(0); EXP8(pc0, 0); VTR_WAIT(); PV_BLK(0);
            VTR_BLK(1); EXP8(pc0, 8); VTR_WAIT(); PV_BLK(1);
            VTR_BLK(2); EXP8(pc1, 0); VTR_WAIT(); PV_BLK(2);
            VTR_BLK(3); EXP8(pc1, 8); VTR_WAIT(); PV_BLK(3);
        } else { EXP8(pc0, 0); EXP8(pc0, 8); EXP8(pc1, 0); EXP8(pc1, 8); }
        f32x2 ls2a = {0.f, 0.f}, ls2b = {0.f, 0.f};
#pragma unroll
        for (int r = 0; r < 16; r += 2) { ls2a += (f32x2){pc0[r], pc0[r + 1]}; ls2b += (f32x2){pc1[r], pc1[r + 1]}; }
        ls2a += ls2b; lrun += ls2a.x + ls2a.y;
        { u32x4 w;
          w.x = pk2(pc0[0], pc0[1]); w.y = pk2(pc0[2], pc0[3]); w.z = pk2(pc0[4], pc0[5]); w.w = pk2(pc0[6], pc0[7]); pf[0] = __builtin_bit_cast(bf16x8, w);
          w.x = pk2(pc0[8], pc0[9]); w.y = pk2(pc0[10], pc0[11]); w.z = pk2(pc0[12], pc0[13]); w.w = pk2(pc0[14], pc0[15]); pf[1] = __builtin_bit_cast(bf16x8, w);
          w.x = pk2(pc1[0], pc1[1]); w.y = pk2(pc1[2], pc1[3]); w.z = pk2(pc1[4], pc1[5]); w.w = pk2(pc1[6], pc1[7]); pf[2] = __builtin_bit_cast(bf16x8, w);
          w.x = pk2(pc1[8], pc1[9]); w.y = pk2(pc1[10], pc1[11]); w.z = pk2(pc1[12], pc1[13]); w.w = pk2(pc1[14], pc1[15]); pf[3] = __builtin_bit_cast(bf16x8, w); }
        pc0 = pn0; pc1 = pn1; alpha_prev = alpha_cur;
        k3 = (k3 == 2) ? 0 : k3 + 1;
    }
    WAITBAR(0);
    if (__any(alpha_prev != 1.0f)) {
#pragma unroll
        for (int i = 0; i < 4; ++i)
#pragma unroll
            for (int r = 0; r < 16; ++r) o[i][r] *= alpha_prev;
    }
    { const unsigned vaddr = vbase + (unsigned)((NT - 1) & 3) * VSTG;
      VTR_BLK(0); VTR_WAIT(); PV_BLK(0); VTR_BLK(1); VTR_WAIT(); PV_BLK(1); VTR_BLK(2); VTR_WAIT(); PV_BLK(2); VTR_BLK(3); VTR_WAIT(); PV_BLK(3); }
    lrun = xsum32(lrun);
    const float inv = 1.0f / lrun;
    __syncthreads();
    LAS float* ex = (LAS float*)lds;
    if (comp == 1) {
#pragma unroll
        for (int i = 0; i < 4; ++i)
#pragma unroll
            for (int r = 0; r < 16; ++r) ex[(wq * 64 + i * 16 + r) * 64 + lane] = o[i][r] * inv;
    }
    __syncthreads();
    if (comp == 0) {
        float ss = 0.f;
#pragma unroll
        for (int i = 0; i < 4; ++i)
#pragma unroll
            for (int r = 0; r < 16; ++r) { const float v = o[i][r] * inv - lam * ex[(wq * 64 + i * 16 + r) * 64 + lane]; o[i][r] = v; ss += v * v; }
        ss = xsum32(ss);
        const float rn = 1.0f / sqrtf(ss * (1.0f / 128.0f) + RMS_EPS) * (1.0f - LAM_INIT);
        bf16_t* dst = On + (size_t)(b * SEQ + t0 + r32) * 512 + h * 128;
#pragma unroll
        for (int i = 0; i < 4; ++i)
#pragma unroll
            for (int g = 0; g < 4; ++g) {
                const int d = 32 * i + 8 * g + 4 * hi;
                const f32x4 sg = *(const f32x4*)(subln + d);
                u32x2 w; w.x = pk2(o[i][4 * g] * rn * sg[0], o[i][4 * g + 1] * rn * sg[1]); w.y = pk2(o[i][4 * g + 2] * rn * sg[2], o[i][4 * g + 3] * rn * sg[3]);
                *(u32x2*)(dst + d) = w;
            }
    }
    __syncthreads();
}
#undef VTR_ASM
#undef VTR_BLK
#undef VTR_WAIT
#undef PV_BLK
#undef QKT
#undef EXP8
#undef WAITBAR
}

namespace hy {
__device__ const float WC[16] = {1.0f, 0.98078528040323043f, 0.92387953251128674f, 0.83146961230254524f, 0.70710678118654757f, 0.55557023301960229f, 0.38268343236508984f, 0.19509032201612833f,
                                 0.0f, -0.19509032201612833f, -0.38268343236508984f, -0.55557023301960229f, -0.70710678118654757f, -0.83146961230254524f, -0.92387953251128674f, -0.98078528040323043f};
__device__ const float WS[16] = {0.0f, 0.19509032201612825f, 0.38268343236508978f, 0.55557023301960218f, 0.70710678118654746f, 0.83146961230254524f, 0.92387953251128674f, 0.98078528040323043f,
                                 1.0f, 0.98078528040323043f, 0.92387953251128674f, 0.83146961230254546f, 0.70710678118654757f, 0.55557023301960218f, 0.38268343236508989f, 0.19509032201612861f};
__device__ __forceinline__ int PX(int i) { return i + ((i >> 5) << 1); }
template <bool CONJ> __device__ __forceinline__ f32x2 cmulw(f32x2 a, float c, float s) {
    const f32x2 sw = CONJ ? (f32x2){-a.y, a.x} : (f32x2){a.y, -a.x};
    return a * (f32x2){c, c} + sw * (f32x2){s, s};
}
template <int H, bool INV, bool ZUP = false> __device__ __forceinline__ void pass16(LAS f32x2* X, const f32x2* TW, int tid) {
    constexpr int S = H / 8, MULT = 4096 / H;
    const int j0 = tid % S, blk = tid / S, base = blk * 2 * H + j0;
    f32x2 e[16];
#pragma unroll
    for (int r = 0; r < 16; ++r) e[r] = (ZUP && r >= 8) ? (f32x2){0.f, 0.f} : X[PX(base + r * S)];
    f32x2 w[4];
#pragma unroll
    for (int k = 0; k < 4; ++k) w[k] = TW[(j0 << k) * MULT];
    if (!INV) {
#pragma unroll
        for (int k = 0; k < 4; ++k) {
            const int hk = 8 >> k;
#pragma unroll
            for (int r = 0; r < 16; ++r) if (!(r & hk)) {
                const f32x2 a = e[r], bb = e[r + hk]; e[r] = a + bb; f32x2 d = a - bb;
                const int ci = (r % hk) << (k + 1);
                if (ci != 0) d = cmulw<false>(d, WC[ci], WS[ci]);
                e[r + hk] = cmulw<false>(d, w[k].x, w[k].y);
            }
        }
    } else {
#pragma unroll
        for (int k = 3; k >= 0; --k) {
            const int hk = 8 >> k;
#pragma unroll
            for (int r = 0; r < 16; ++r) if (!(r & hk)) {
                const f32x2 a = e[r]; f32x2 bb = cmulw<true>(e[r + hk], w[k].x, w[k].y);
                const int ci = (r % hk) << (k + 1);
                if (ci != 0) bb = cmulw<true>(bb, WC[ci], WS[ci]);
                e[r] = a + bb; e[r + hk] = a - bb;
            }
        }
    }
#pragma unroll
    for (int r = 0; r < 16; ++r) X[PX(base + r * S)] = e[r];
}
template <bool FILT> __device__ __forceinline__ void pass32(LAS f32x2* X, f32x2* Kout, const f32x2* Kin, int tid) {
    if (tid < 256) {
        f32x2 e[32];
        u32x4 kvv[8];
        if (!FILT) { const u32x4* kp0 = (const u32x4*)Kin + tid;
#pragma unroll
            for (int i = 0; i < 8; ++i) kvv[i] = kp0[i * 256]; }
        const LAS f32x4* xp = (const LAS f32x4*)(X + PX(32 * tid));
#pragma unroll
        for (int i = 0; i < 16; ++i) { const f32x4 v = xp[i]; e[2 * i] = (f32x2){v[0], v[1]}; e[2 * i + 1] = (f32x2){v[2], v[3]}; }
#pragma unroll
        for (int k = 0; k < 5; ++k) {
            const int hk = 16 >> k;
#pragma unroll
            for (int r = 0; r < 32; ++r) if (!(r & hk)) {
                const f32x2 a = e[r], bb = e[r + hk]; e[r] = a + bb; f32x2 d = a - bb;
                const int ci = (r % hk) << k;
                if (ci != 0) d = cmulw<false>(d, WC[ci], WS[ci]);
                e[r + hk] = d;
            }
        }
        if (FILT) {
            u32x4* kp = (u32x4*)Kout + tid;
#pragma unroll
            for (int i = 0; i < 8; ++i) { u32x4 w; w.x = pk2(e[4 * i].x, e[4 * i].y); w.y = pk2(e[4 * i + 1].x, e[4 * i + 1].y); w.z = pk2(e[4 * i + 2].x, e[4 * i + 2].y); w.w = pk2(e[4 * i + 3].x, e[4 * i + 3].y); kp[i * 256] = w; }
        } else {
#pragma unroll
            for (int i = 0; i < 8; ++i) {
#pragma unroll
                for (int j = 0; j < 4; ++j) { const unsigned kw = kvv[i][j]; const float kr = bflo(kw), ki = bfhi(kw); const f32x2 a = e[4 * i + j];
                    e[4 * i + j] = (f32x2){a.x * kr - a.y * ki, a.x * ki + a.y * kr}; }
            }
#pragma unroll
            for (int k = 4; k >= 0; --k) {
                const int hk = 16 >> k;
#pragma unroll
                for (int r = 0; r < 32; ++r) if (!(r & hk)) {
                    const f32x2 a = e[r]; f32x2 bb = e[r + hk];
                    const int ci = (r % hk) << k;
                    if (ci != 0) bb = cmulw<true>(bb, WC[ci], WS[ci]);
                    e[r] = a + bb; e[r + hk] = a - bb;
                }
            }
            LAS f32x4* xo = (LAS f32x4*)(X + PX(32 * tid));
#pragma unroll
            for (int i = 0; i < 16; ++i) xo[i] = (f32x4){e[2 * i].x, e[2 * i].y, e[2 * i + 1].x, e[2 * i + 1].y};
        }
    }
}
__device__ __forceinline__ void conv_fft(LAS f32x2* X, const f32x2* TW, const f32x2* Ks, int tid) {
    __syncthreads(); pass16<4096, false, true>(X, TW, tid);
    __syncthreads(); pass16<256, false>(X, TW, tid);
    __syncthreads(); pass32<false>(X, nullptr, Ks, tid);
    __syncthreads(); pass16<256, true>(X, TW, tid);
    __syncthreads(); pass16<4096, true>(X, TW, tid);
    __syncthreads();
}
struct Raw { u32x4 r; float lo, hi; };
__device__ __forceinline__ Raw raw_load(const bf16_t* zrow, int tid) {
    Raw w; w.r = *(const u32x4*)(zrow + 8 * tid);
    const bf16_t lo = zrow[tid > 0 ? 8 * tid - 1 : 0], hi = zrow[tid < 511 ? 8 * tid + 8 : 4095];
    w.lo = tid > 0 ? bf1(lo) : 0.f; w.hi = tid < 511 ? bf1(hi) : 0.f; return w;
}
__device__ __forceinline__ void conv3_raw(const Raw& w, float w0, float w1, float w2, float bias, float (&out)[8]) {
    float z[10];
    z[0] = w.lo; z[9] = w.hi;
    z[1] = bflo(w.r.x); z[2] = bfhi(w.r.x); z[3] = bflo(w.r.y); z[4] = bfhi(w.r.y); z[5] = bflo(w.r.z); z[6] = bfhi(w.r.z); z[7] = bflo(w.r.w); z[8] = bfhi(w.r.w);
#pragma unroll
    for (int i = 0; i < 8; ++i) out[i] = w0 * z[i] + w1 * z[i + 1] + w2 * z[i + 2] + bias;
}
__device__ __forceinline__ void put8(LAS f32x2* X, int tid, const float (&a)[8], const float (&b)[8]) {
    LAS f32x4* lo = (LAS f32x4*)(X + PX(8 * tid));
#pragma unroll
    for (int i = 0; i < 4; ++i) lo[i] = (f32x4){a[2 * i], b[2 * i], a[2 * i + 1], b[2 * i + 1]};
}
__device__ __forceinline__ void get8(const LAS f32x2* X, int tid, float (&a)[8], float (&b)[8]) {
    const LAS f32x4* lo = (const LAS f32x4*)(X + PX(8 * tid));
#pragma unroll
    for (int i = 0; i < 4; ++i) { const f32x4 v = lo[i]; a[2 * i] = v[0] * (1.0f / 8192.0f); b[2 * i] = v[1] * (1.0f / 8192.0f); a[2 * i + 1] = v[2] * (1.0f / 8192.0f); b[2 * i + 1] = v[3] * (1.0f / 8192.0f); }
}
__device__ __forceinline__ void hyena_unit(int c, int bp, const bf16_t* zhy, const float* cw, const float* cb, const float* hbias, const f32x2* kspec, const f32x2* TW, bf16_t* yht, LAS f32x2* X) {
    const int tid = tid_fresh(); const int b0 = 2 * bp, b1 = b0 + 1; const int c1 = 512 + c, c2 = 1024 + c;
    const Raw rva = raw_load(zhy + (size_t)(b0 * 1536 + c) * 4096, tid), rvb = raw_load(zhy + (size_t)(b1 * 1536 + c) * 4096, tid);
    const Raw r1a = raw_load(zhy + (size_t)(b0 * 1536 + c1) * 4096, tid), r1b = raw_load(zhy + (size_t)(b1 * 1536 + c1) * 4096, tid);
    const float p00 = cw[c], p01 = cw[1536 + c], p02 = cw[3072 + c], p0b = cb[c];
    const float p10 = cw[c1], p11 = cw[1536 + c1], p12 = cw[3072 + c1], p1b = cb[c1], hb0 = hbias[c];
    const float p20 = cw[c2], p21 = cw[1536 + c2], p22 = cw[3072 + c2], p2b = cb[c2], hb1 = hbias[512 + c];
    float va[8], vb[8];
    { const float w0 = p00, w1 = p01, w2 = p02, bs = p0b; conv3_raw(rva, w0, w1, w2, bs, va); conv3_raw(rvb, w0, w1, w2, bs, vb); }
    put8(X, tid, va, vb);
    conv_fft(X, TW, kspec + (size_t)c * 4096, tid);
    const Raw r2a = raw_load(zhy + (size_t)(b0 * 1536 + c2) * 4096, tid), r2b = raw_load(zhy + (size_t)(b1 * 1536 + c2) * 4096, tid);
    float ca[8], cbv[8]; get8(X, tid, ca, cbv);
    float za[8], zb[8];
    { const float w0 = p10, w1 = p11, w2 = p12, bs = p1b, hb = hb0;
      float xa[8], xb[8]; conv3_raw(r1a, w0, w1, w2, bs, xa); conv3_raw(r1b, w0, w1, w2, bs, xb);
#pragma unroll
      for (int i = 0; i < 8; ++i) { za[i] = xa[i] * (ca[i] + va[i] * hb); zb[i] = xb[i] * (cbv[i] + vb[i] * hb); } }
    put8(X, tid, za, zb);
    conv_fft(X, TW, kspec + (size_t)(512 + c) * 4096, tid);
    get8(X, tid, ca, cbv);
    { const float w0 = p20, w1 = p21, w2 = p22, bs = p2b, hb = hb1;
      float xa[8], xb[8]; conv3_raw(r2a, w0, w1, w2, bs, xa); conv3_raw(r2b, w0, w1, w2, bs, xb);
      u32x4 wa, wb;
      wa.x = pk2(xa[0] * (ca[0] + za[0] * hb), xa[1] * (ca[1] + za[1] * hb)); wa.y = pk2(xa[2] * (ca[2] + za[2] * hb), xa[3] * (ca[3] + za[3] * hb));
      wa.z = pk2(xa[4] * (ca[4] + za[4] * hb), xa[5] * (ca[5] + za[5] * hb)); wa.w = pk2(xa[6] * (ca[6] + za[6] * hb), xa[7] * (ca[7] + za[7] * hb));
      wb.x = pk2(xb[0] * (cbv[0] + zb[0] * hb), xb[1] * (cbv[1] + zb[1] * hb)); wb.y = pk2(xb[2] * (cbv[2] + zb[2] * hb), xb[3] * (cbv[3] + zb[3] * hb));
      wb.z = pk2(xb[4] * (cbv[4] + zb[4] * hb), xb[5] * (cbv[5] + zb[5] * hb)); wb.w = pk2(xb[6] * (cbv[6] + zb[6] * hb), xb[7] * (cbv[7] + zb[7] * hb));
      *(u32x4*)(yht + (size_t)(b0 * 512 + c) * 4096 + 8 * tid) = wa;
      *(u32x4*)(yht + (size_t)(b1 * 512 + c) * 4096 + 8 * tid) = wb; }
    __syncthreads();
}
}

__device__ __forceinline__ void transpose_item(const float* W, int K, int N, bf16_t* WT, LAS float* scr, int item, int lane, bool UPPERM) {
    const int nblk = N / 32, kb = item / nblk, nb = item % nblk, k0 = 64 * kb, n0 = 32 * nb;
    float tv[32];
#pragma unroll
    for (int i = 0; i < 32; ++i) tv[i] = W[(size_t)(k0 + 2 * i + (lane >> 5)) * N + n0 + (lane & 31)];
#pragma unroll
    for (int i = 0; i < 32; ++i) scr[(2 * i + (lane >> 5)) * 33 + (lane & 31)] = tv[i];
    asm volatile("s_waitcnt lgkmcnt(0)" ::: "memory");
    const int c = lane & 7;
#pragma unroll
    for (int j = 0; j < 4; ++j) { const int n = (lane >> 3) + 8 * j; const LAS float* s = scr + (8 * c) * 33 + n;
        u32x4 o; o.x = pk2(s[0 * 33], s[1 * 33]); o.y = pk2(s[2 * 33], s[3 * 33]); o.z = pk2(s[4 * 33], s[5 * 33]); o.w = pk2(s[6 * 33], s[7 * 33]);
        int dn = n0 + n; if (UPPERM) { const int c2 = dn >= DFF ? dn - DFF : dn; dn = 256 * (c2 >> 7) + (dn >= DFF ? 128 : 0) + (c2 & 127); }
        *(u32x4*)(WT + (size_t)dn * K + k0 + 8 * c) = o; }
    asm volatile("s_waitcnt lgkmcnt(0)" ::: "memory");
}
__device__ __forceinline__ void ln_row(const float* xrow, const float* g, const float* bb, int lane, f32x4 (&v)[4], float& mean, float& rstd) {
    const f32x4* xr = (const f32x4*)xrow + lane; float s = 0.f;
#pragma unroll
    for (int j = 0; j < 4; ++j) { v[j] = xr[64 * j]; s += (v[j][0] + v[j][1]) + (v[j][2] + v[j][3]); }
    mean = wave_sum(s) * (1.f / D); float s2 = 0.f;
#pragma unroll
    for (int j = 0; j < 4; ++j) { v[j] = v[j] - mean; s2 += (v[j][0] * v[j][0] + v[j][1] * v[j][1]) + (v[j][2] * v[j][2] + v[j][3] * v[j][3]); }
    rstd = 1.f / sqrtf(wave_sum(s2) * (1.f / D) + LN_EPS);
#pragma unroll
    for (int j = 0; j < 4; ++j) { const f32x4 gg = ((const f32x4*)g)[64 * j + lane], b4 = ((const f32x4*)bb)[64 * j + lane]; v[j] = v[j] * rstd * gg + b4; }
}

__device__ __forceinline__ void ln_row2_bf16(const bf16_t* xa, const bf16_t* xb, const float* g, const float* bb, int lane, f32x4 (&va)[4], f32x4 (&vb)[4], float& ma, float& ra, float& mb, float& rb) {
    const u32x4 a0 = ((const u32x4*)xa)[lane], a1 = ((const u32x4*)xa)[64 + lane], b0 = ((const u32x4*)xb)[lane], b1 = ((const u32x4*)xb)[64 + lane];
    unpack8(a0, va[0], va[1]); unpack8(a1, va[2], va[3]); unpack8(b0, vb[0], vb[1]); unpack8(b1, vb[2], vb[3]);
    float sa = 0.f, sb = 0.f;
#pragma unroll
    for (int j = 0; j < 4; ++j) { sa += (va[j][0] + va[j][1]) + (va[j][2] + va[j][3]); sb += (vb[j][0] + vb[j][1]) + (vb[j][2] + vb[j][3]); }
    sa = wave_sum(sa); sb = wave_sum(sb);
    ma = sa * (1.f / D); mb = sb * (1.f / D); float qa = 0.f, qb = 0.f;
#pragma unroll
    for (int j = 0; j < 4; ++j) { va[j] = va[j] - ma; vb[j] = vb[j] - mb;
        qa += (va[j][0] * va[j][0] + va[j][1] * va[j][1]) + (va[j][2] * va[j][2] + va[j][3] * va[j][3]);
        qb += (vb[j][0] * vb[j][0] + vb[j][1] * vb[j][1]) + (vb[j][2] * vb[j][2] + vb[j][3] * vb[j][3]); }
    qa = wave_sum(qa); qb = wave_sum(qb);
    ra = 1.f / sqrtf(qa * (1.f / D) + LN_EPS); rb = 1.f / sqrtf(qb * (1.f / D) + LN_EPS);
#pragma unroll
    for (int j = 0; j < 4; ++j) { const int col = 512 * (j >> 1) + 8 * lane + 4 * (j & 1); const f32x4 gg = *(const f32x4*)(g + col), b4 = *(const f32x4*)(bb + col); va[j] = va[j] * ra * gg + b4; vb[j] = vb[j] * rb * gg + b4; }
}
__device__ __forceinline__ void ln_load2(const float* xa, const float* xb, int lane, f32x4 (&va)[4], f32x4 (&vb)[4]) {
    const f32x4* pa = (const f32x4*)xa + lane; const f32x4* pb = (const f32x4*)xb + lane;
#pragma unroll
    for (int j = 0; j < 4; ++j) { va[j] = pa[64 * j]; vb[j] = pb[64 * j]; }
}
__device__ __forceinline__ void ln_fin2(const float* g, const float* bb, int lane, f32x4 (&va)[4], f32x4 (&vb)[4], float& ma, float& ra, float& mb, float& rb) {
    float sa = 0.f, sb = 0.f;
#pragma unroll
    for (int j = 0; j < 4; ++j) { sa += (va[j][0] + va[j][1]) + (va[j][2] + va[j][3]); sb += (vb[j][0] + vb[j][1]) + (vb[j][2] + vb[j][3]); }
    sa = wave_sum(sa); sb = wave_sum(sb);
    ma = sa * (1.f / D); mb = sb * (1.f / D); float qa = 0.f, qb = 0.f;
#pragma unroll
    for (int j = 0; j < 4; ++j) { va[j] = va[j] - ma; vb[j] = vb[j] - mb;
        qa += (va[j][0] * va[j][0] + va[j][1] * va[j][1]) + (va[j][2] * va[j][2] + va[j][3] * va[j][3]);
        qb += (vb[j][0] * vb[j][0] + vb[j][1] * vb[j][1]) + (vb[j][2] * vb[j][2] + vb[j][3] * vb[j][3]); }
    qa = wave_sum(qa); qb = wave_sum(qb);
    ra = 1.f / sqrtf(qa * (1.f / D) + LN_EPS); rb = 1.f / sqrtf(qb * (1.f / D) + LN_EPS);
#pragma unroll
    for (int j = 0; j < 4; ++j) { const f32x4 gg = ((const f32x4*)g)[64 * j + lane], b4 = ((const f32x4*)bb)[64 * j + lane]; va[j] = va[j] * ra * gg + b4; vb[j] = vb[j] * rb * gg + b4; }
}

#define RLX_AGENT __ATOMIC_RELAXED, __HIP_MEMORY_SCOPE_AGENT
#define XB_TMO      128
#define XB_XCNT(j)  (256  + 64 * (j))
#define XB_XSUB(j)  (1280 + 64 * (j))
#define XB_XGEN(j)  (2304 + 64 * (j))
#define XB_TOP      3328
#define XB_TOPGEN   3392
#define XCD_BAR_WORDS 3456
#define XB_SPIN_CAP (1u << 18)

__device__ __forceinline__ unsigned xb_ld(unsigned* p)              { return __hip_atomic_load(p, __ATOMIC_RELAXED, __HIP_MEMORY_SCOPE_AGENT); }
__device__ __forceinline__ unsigned xb_add(unsigned* p, unsigned v) { return __hip_atomic_fetch_add(p, v, __ATOMIC_RELAXED, __HIP_MEMORY_SCOPE_AGENT); }
__device__ __forceinline__ unsigned xb_xcc_id() { return (unsigned)__builtin_amdgcn_s_getreg((3 << 11) | 20) & 0xFu; }
#define XB_SPIN(cond, bar) do { unsigned _sp = 0; while (cond) { __builtin_amdgcn_s_sleep(1); \
    if ((++_sp & 255u) == 0u) { if (xb_ld(&(bar)[XB_TMO])) break; if (_sp > XB_SPIN_CAP) { atomicAdd(&(bar)[XB_TMO], 1u); break; } } } } while (0)

struct XcdBarrier {
    unsigned* bar; unsigned x;
    volatile LAS unsigned* st;
};

__device__ __forceinline__ XcdBarrier xcd_barrier_post(unsigned* bar, volatile LAS unsigned* st) {
    XcdBarrier b; b.bar = bar; b.x = xb_xcc_id(); b.st = st;
    if (threadIdx.x == 0) (void)xb_add(&bar[XB_XCNT(b.x)], 1u);
    return b;
}
__device__ __forceinline__ void xcd_barrier_complete(unsigned* bar, unsigned x, unsigned& nloc, unsigned& nx) {
    const unsigned G = gridDim.x * gridDim.y * gridDim.z;
    unsigned sum, cnt, mine, sp = 0u;
    for (;;) {
        sum = 0u; cnt = 0u; mine = 0u;
#pragma unroll
        for (unsigned j = 0; j < 16; ++j) { const unsigned c = xb_ld(&bar[XB_XCNT(j)]); sum += c; cnt += (c > 0u) ? 1u : 0u; mine = (j == x) ? c : mine; }
        if (sum == G) break;
        __builtin_amdgcn_s_sleep(1);
        if ((++sp & 255u) == 0u) { if (xb_ld(&bar[XB_TMO])) break; if (sp > XB_SPIN_CAP) { atomicAdd(&bar[XB_TMO], 1u); break; } }
    }
    nloc = mine > 0u ? mine : 1u; nx = cnt > 0u ? cnt : 1u;
}

__device__ __forceinline__ void xcd_barrier(const XcdBarrier& b) {
    asm volatile("s_waitcnt vmcnt(0)" ::: "memory");
    __syncthreads();
    if (threadIdx.x == 0) {
        unsigned* bar = b.bar;
        __builtin_amdgcn_s_waitcnt(0);
        unsigned nloc = b.st[0], nx = b.st[1];
        if (nloc == 0u) { xcd_barrier_complete(bar, b.x, nloc, nx); b.st[0] = nloc; b.st[1] = nx; }
        const unsigned old = xb_add(&bar[XB_XSUB(b.x)], 1u);
        const unsigned gen = old / nloc;
        if (old + 1u == (gen + 1u) * nloc) {
            __builtin_amdgcn_fence(__ATOMIC_RELEASE, "agent");
            asm volatile("s_waitcnt vmcnt(0)" ::: "memory");
            const unsigned og = xb_add(&bar[XB_TOP], 1u);
            const unsigned tg = og / nx;
            if (og + 1u == (tg + 1u) * nx) xb_add(&bar[XB_TOPGEN], 1u);
            else XB_SPIN(xb_ld(&bar[XB_TOPGEN]) == tg, bar);
            __builtin_amdgcn_fence(__ATOMIC_ACQUIRE, "agent");
            xb_add(&bar[XB_XGEN(b.x)], 1u);
            asm volatile("s_waitcnt vmcnt(0)" ::: "memory");
        } else {
            XB_SPIN(xb_ld(&bar[XB_XGEN(b.x)]) == gen, bar);
            __builtin_amdgcn_fence(__ATOMIC_ACQUIRE, "agent");
            asm volatile("s_waitcnt vmcnt(0)" ::: "memory");
        }
    }
    __syncthreads();
}

struct Params { const float* in[36]; float* out; unsigned char* ws; };
typedef const __attribute__((address_space(4))) Params* KPtr;
__device__ __forceinline__ KPtr kargs() { KPtr k = (KPtr)__builtin_amdgcn_kernarg_segment_ptr(); asm volatile("" : "+s"(k)); return k; }
#define WSP(T, off) ((T*)(kp->ws + (off)))
#define PROBE_T(k, slot) do { if (PROBE_PH == (k) && blockIdx.x == 0 && threadIdx.x == 0) { KPtr kq = kargs(); ((unsigned long long*)(kq->ws + 800 * 1024))[slot] = __builtin_amdgcn_s_memrealtime(); } } while (0)
#define TIDS() const int tid = tid_fresh(), lane = tid & 63, wave = __builtin_amdgcn_readfirstlane(tid >> 6); const int gw = vcu * 8 + wave; (void)lane; (void)gw

__global__ void __launch_bounds__(512, 2) fwd_kernel(Params p) {
    extern __shared__ __attribute__((aligned(16))) unsigned char lds_raw[];
    LAS unsigned char* lds = (LAS unsigned char*)lds_raw;
    cg::grid_group grid = cg::this_grid();
    const int bx = blockIdx.x, G = gridDim.x;
    { volatile LAS unsigned* st = (volatile LAS unsigned*)(lds + LDS_MISC); if (threadIdx.x < 4) st[threadIdx.x] = 0u; }
    __syncthreads();
    const XcdBarrier xbar = xcd_barrier_post((unsigned*)(kargs()->ws + WS_BAR), (volatile LAS unsigned*)(lds + LDS_MISC));
    const int vcu = (G % 8 == 0) ? (bx % 8) * (G / 8) + bx / 8 : bx;
    const int NGW = G * 8;
    PROBE_T(0, 0);
    if (PH(0)) {
        KPtr kp = kargs();
        TIDS();
        f32x2* rope = WSP(f32x2, WS_ROPE); f32x2* TW = WSP(f32x2, WS_TW); float* modp = WSP(float, WS_MODP); bf16_t* FILT = WSP(bf16_t, WS_FILT);
        LAS float* SC = (LAS float*)lds;
        { const float* cin = kp->in[1]; const float* cctx = kp->in[3]; float cv[18];
#pragma unroll
          for (int j = 0; j < 16; ++j) cv[j] = cin[tid + 512 * j];
          cv[16] = cctx[tid]; cv[17] = cctx[tid + 512];
#pragma unroll
          for (int j = 0; j < 18; ++j) SC[tid + 512 * j] = cv[j] * fast_sigmoid(cv[j]); }
        { const int gt = bx * 512 + tid;
          if (gt < 4096) { float sn, cs; sincospif((float)gt * (1.0f / 4096.0f), &sn, &cs); TW[gt] = (f32x2){cs, sn}; }
          else if (gt < 5120) { const int e = gt - 4096, pos = e >> 4, j = e & 15; const float inv = powf(10000.0f, -(float)(2 * j) / 32.0f); const float ang = (float)pos * inv; rope[e] = (f32x2){cosf(ang), sinf(ang)}; } }
        {
            LAS float* zf = (LAS float*)(lds + 40960);
            LAS float* hA = zf + 16 * 33 + 16;
            LAS float* hB = hA + 1024;
            const int t0 = 16 * bx;
            for (int idx = tid; idx < 16 * 33; idx += 512) {
                const int pp = idx / 33, i = idx % 33, t = t0 + pp; float val;
                if (i == 0) val = (float)t / 4095.0f;
                else { const int band = (i - 1) & 15; const float fv = 1e-4f + (float)band * ((15.0f - 1e-4f) / 15.0f); const float wv = (6.283185307179586f / 4096.0f) * (float)t; const float arg = fv * wv; val = (i <= 16) ? cosf(arg) : -sinf(arg); }
                zf[idx] = val;
            }
            __syncthreads();
            const float *w1 = kp->in[11], *b1 = kp->in[12], *w2 = kp->in[13], *b2 = kp->in[14], *w3 = kp->in[15], *b3 = kp->in[16], *fq = kp->in[17], *wout = kp->in[18];
            LAS float* WL = hB + 1024;
            for (int i = tid; i < 33 * 64; i += 512) WL[i] = w1[i];
            __syncthreads();
            for (int idx = tid; idx < 1024; idx += 512) { const int f = idx & 63, pp = idx >> 6; float s = b1[f];
#pragma unroll 11
                for (int i = 0; i < 33; ++i) s += zf[pp * 33 + i] * WL[i * 64 + f];
                hA[f * 16 + pp] = sinf(fq[f] * s); }
            __syncthreads();
            for (int i = tid; i < 4096; i += 512) WL[i] = w2[i];
            __syncthreads();
            for (int idx = tid; idx < 1024; idx += 512) { const int f = idx & 63, pp = idx >> 6; float s = b2[f];
#pragma unroll 16
                for (int k = 0; k < 64; ++k) s += hA[k * 16 + pp] * WL[k * 64 + f];
                hB[f * 16 + pp] = sinf(fq[64 + f] * s); }
            __syncthreads();
            for (int i = tid; i < 4096; i += 512) WL[i] = w3[i];
            __syncthreads();
            for (int idx = tid; idx < 1024; idx += 512) { const int f = idx & 63, pp = idx >> 6; float s = b3[f];
#pragma unroll 16
                for (int k = 0; k < 64; ++k) s += hB[k * 16 + pp] * WL[k * 64 + f];
                hA[f * 16 + pp] = sinf(fq[128 + f] * s); }
            __syncthreads();
            for (int q = 0; q < 4; ++q) {
                const int n = wave * 256 + q * 64 + lane;
                f32x4 a0 = {0.f, 0.f, 0.f, 0.f}, a1 = a0, a2 = a0, a3 = a0;
#pragma unroll 1
                for (int kb = 0; kb < 64; kb += 16) {
                    float wv[16];
#pragma unroll
                    for (int k = 0; k < 16; ++k) wv[k] = wout[(kb + k) * 2048 + n];
#pragma unroll
                    for (int k = 0; k < 16; ++k) { const float w = wv[k]; const LAS f32x4* hp = (const LAS f32x4*)(hA + (kb + k) * 16);
                        a0 += hp[0] * w; a1 += hp[1] * w; a2 += hp[2] * w; a3 += hp[3] * w; }
                }
                const int cch = n & 511; const float mind = -3.0701134573253945f, maxd = -15.350567286626973f;
                const float delta = fabsf(mind + (float)cch * ((maxd - mind) / 511.0f));
                f32x4 dc[4];
#pragma unroll
                for (int g4 = 0; g4 < 4; ++g4)
#pragma unroll
                    for (int e = 0; e < 4; ++e) dc[g4][e] = __builtin_amdgcn_exp2f(-((float)(t0 + 4 * g4 + e) / 4095.0f) * delta * 1.4426950408889634f);
                u32x4* dst = (u32x4*)(FILT + (size_t)n * 4096 + t0);
                dst[0] = pack8(a0 * dc[0], a1 * dc[1]); dst[1] = pack8(a2 * dc[2], a3 * dc[3]);
            }
        }
        if (wave < 3) {
            const int item = bx * 3 + wave; const int kc = item / 96, nb = item % 96, n = nb * 64 + lane;
            const float* wa = kp->in[6];
            float acc[9];
#pragma unroll
            for (int i = 0; i < 9; ++i) acc[i] = 0.f;
#pragma unroll 32
            for (int k = kc * 128; k < kc * 128 + 128; ++k) { const float w = wa[(size_t)k * NADA + n];
#pragma unroll
                for (int i = 0; i < 9; ++i) acc[i] += SC[i * 1024 + k] * w; }
#pragma unroll
            for (int i = 0; i < 9; ++i) modp[(size_t)(kc * 9 + i) * NADA + n] = acc[i];
        }
        {
            LAS float* scr = (LAS float*)(lds + 65536 + wave * 8448);
            constexpr int I_IN = 16 * 160, I_HY = 8 * 32, I_AT = 8 * 32, I_OUT = 16 * 32, I_UP = 16 * 176, I_DN = 44 * 32;
            constexpr int NIT = I_IN + I_HY + I_AT + I_OUT + I_UP + I_DN;
            for (int it = gw; it < NIT; it += NGW) {
                int r = it; const float* W; bf16_t* WT; int K, N; bool up = false;
                if (r < I_IN) { W = kp->in[8]; K = 1024; N = INC; WT = WSP(bf16_t, WS_WIN); }
                else if ((r -= I_IN) < I_HY) { W = kp->in[25]; K = 512; N = 1024; WT = WSP(bf16_t, WS_WHY); }
                else if ((r -= I_HY) < I_AT) { W = kp->in[26]; K = 512; N = 1024; WT = WSP(bf16_t, WS_WAT); }
                else if ((r -= I_AT) < I_OUT) { W = kp->in[27]; K = 1024; N = 1024; WT = WSP(bf16_t, WS_WOUT); }
                else if ((r -= I_OUT) < I_UP) { W = kp->in[30]; K = 1024; N = NUP; WT = WSP(bf16_t, WS_WUP); up = true; }
                else { r -= I_UP; W = kp->in[33]; K = DFF; N = 1024; WT = WSP(bf16_t, WS_WDN); }
                transpose_item(W, K, N, WT, scr, r, lane, up);
            }
        }
    }
    if (G == 0x7fffffff) grid.sync();
    xcd_barrier(xbar);

    PROBE_T(0, 1); PROBE_T(1, 0);
    if (PH(1)) {
        KPtr kp = kargs();
        TIDS();
        const float* x = kp->in[0]; const float* ctx = kp->in[2]; const float *ln_in_g = kp->in[4], *ln_in_b = kp->in[5];
        float* st0 = WSP(float, WS_ST0); float* mod = WSP(float, WS_MOD); const float* modp = WSP(float, WS_MODP); bf16_t *XM = WSP(bf16_t, WS_XM), *CTXM = WSP(bf16_t, WS_CTXM);
        LAS float* SH = (LAS float*)(lds + 73728);
        const int b = bx >> 5;
        const float* bada = kp->in[7];
        { float sacc[8];
#pragma unroll
          for (int i = 0; i < 8; ++i) { const int j = tid + 512 * i, row = j < 2048 ? b : 8, col = j & 2047; float s = bada[col];
#pragma unroll
              for (int kc = 0; kc < 8; ++kc) s += modp[(size_t)(kc * 9 + row) * NADA + col];
              sacc[i] = s; }
#pragma unroll
          for (int i = 0; i < 8; ++i) SH[tid + 512 * i] = sacc[i]; }
        if (tid < 216) { const int e = bx * 216 + tid, row = e / NADA, col = e - row * NADA;
            float s = bada[col];
#pragma unroll
            for (int kc = 0; kc < 8; ++kc) s += modp[(size_t)(kc * 9 + row) * NADA + col];
            mod[e] = s; }
        __syncthreads();
        f32x4 na[4], nb[4];
        ln_load2(x + (size_t)(bx * 128 + wave) * D, x + (size_t)(bx * 128 + 8 + wave) * D, lane, na, nb);
        for (int ip = 0; ip < 8; ++ip) {
            const int ra_ = bx * 128 + (2 * ip) * 8 + wave, rb_ = ra_ + 8;
            f32x4 va[4], vb[4]; float ma, sa, mb, sb;
#pragma unroll
            for (int j = 0; j < 4; ++j) { va[j] = na[j]; vb[j] = nb[j]; }
            if (ip < 7) ln_load2(x + (size_t)(ra_ + 16) * D, x + (size_t)(rb_ + 16) * D, lane, na, nb);
            ln_fin2(ln_in_g, ln_in_b, lane, va, vb, ma, sa, mb, sb);
            if (lane == 0) { *(f32x2*)(st0 + 2 * ra_) = (f32x2){ma, sa}; *(f32x2*)(st0 + 2 * rb_) = (f32x2){mb, sb}; }
#pragma unroll
            for (int j = 0; j < 4; ++j) { const int col = 256 * j + 4 * lane;
                const f32x4 s4 = *(const LAS f32x4*)(SH + col), c4 = *(const LAS f32x4*)(SH + 1024 + col);
                const f32x4 oa = va[j] * (c4 + 1.0f) + s4, ob = vb[j] * (c4 + 1.0f) + s4;
                u32x2 w; w.x = pk2(oa[0], oa[1]); w.y = pk2(oa[2], oa[3]); *(u32x2*)(XM + (size_t)ra_ * D + col) = w;
                w.x = pk2(ob[0], ob[1]); w.y = pk2(ob[2], ob[3]); *(u32x2*)(XM + (size_t)rb_ * D + col) = w; }
        }
        {
            const int r = bx * 8 + wave;
            f32x4 v[4]; float mean, rstd;
            ln_row(ctx + (size_t)r * D, ln_in_g, ln_in_b, lane, v, mean, rstd);
#pragma unroll
            for (int j = 0; j < 4; ++j) { const int col = 256 * j + 4 * lane;
                const f32x4 s4 = *(const LAS f32x4*)(SH + 2048 + col), c4 = *(const LAS f32x4*)(SH + 3072 + col);
                const f32x4 o = v[j] * (c4 + 1.0f) + s4;
                u32x2 w; w.x = pk2(o[0], o[1]); w.y = pk2(o[2], o[3]); *(u32x2*)(CTXM + (size_t)r * D + col) = w; }
        }
    }
    xcd_barrier(xbar);

    PROBE_T(1, 1); PROBE_T(2, 0);
    if (PH(2)) {
        KPtr kp = kargs();
        pg8::Gemm g{WSP(bf16_t, WS_XM), WSP(bf16_t, WS_WIN), MROWS, INC, D}; pg8::StaticOrder S; S.init(MROWS, INC, G, bx);
        EpiIn E{WSP(bf16_t, WS_ZHY), WSP(bf16_t, WS_Q), WSP(bf16_t, WS_K), WSP(bf16_t, WS_V), WSP(bf16_t, WS_SG), WSP(f32x2, WS_ROPE)};
        pg8::gemm_phase<EpiIn, pg8::StaticOrder, true, true>(lds, g, S, E);
    }
    if (PH(2)) {
        KPtr kp = kargs();
        pg8::Gemm g{WSP(bf16_t, WS_CTXM), WSP(bf16_t, WS_WIN) + (size_t)2048 * D, MCTX, 1024, D}; pg8::StaticOrder S; S.init(MCTX, 1024, G, bx);
        EpiCtx E{WSP(bf16_t, WS_K), WSP(bf16_t, WS_V)};
        pg8::gemm_phase<EpiCtx, pg8::StaticOrder, true, true>(lds, g, S, E);
    }
#if EN_HY
    if (PH(2) && bx >= 32) {
        KPtr kp = kargs(); TIDS();
        const f32x2* TW = WSP(f32x2, WS_TW); const bf16_t* FILT = WSP(bf16_t, WS_FILT); f32x2* KSPEC = WSP(f32x2, WS_KSPEC);
        LAS f32x2* X = (LAS f32x2*)lds;
        LAS f32x2* XB = X + 8704;
        for (int pr = bx - 32; pr < 512; pr += G - 32) {
            __syncthreads();
#pragma unroll
            for (int u = 0; u < 2; ++u) {
                const int fid = 2 * pr + u, order = fid >> 9, c = fid & 511;
                const bf16_t* fwd = FILT + (size_t)(order * 1024 + c) * 4096; const bf16_t* bwd = fwd + (size_t)512 * 4096;
                LAS f32x2* Xu = u ? XB : X;
                float fv[16];
#pragma unroll
                for (int r = 0; r < 8; ++r) { fv[r] = bf1(fwd[tid + 512 * r]); const int jb = 4096 - tid - 512 * r; fv[8 + r] = bf1(bwd[jb > 4095 ? 4095 : jb]); }
                if (tid == 0) fv[8] = 0.f;
#pragma unroll
                for (int r = 0; r < 16; ++r) Xu[hy::PX(tid + 512 * r)] = (f32x2){fv[r], 0.f};
            }
            __syncthreads(); hy::pass16<4096, false>(X, TW, tid); hy::pass16<4096, false>(XB, TW, tid);
            __syncthreads(); hy::pass16<256, false>(X, TW, tid); hy::pass16<256, false>(XB, TW, tid);
            __syncthreads(); hy::pass32<true>(tid < 256 ? X : XB, KSPEC + (size_t)(2 * pr + (tid >> 8)) * 4096, nullptr, tid & 255);
        }
    }
#endif
    xcd_barrier(xbar);

    PROBE_T(2, 1); PROBE_T(3, 0);
    if (PH(3)) {
        KPtr kp = kargs();
        TIDS();
#if EN_ATT
        float lam;
        { const float a = kp->in[20][lane] * kp->in[21][lane], bq = kp->in[22][lane] * kp->in[23][lane]; lam = expf(wave_sum(a)) - expf(wave_sum(bq)) + LAM_INIT; }
        for (int i = 0; i < 4; ++i) { const int unit = (((vcu >> 5) * 4 + i) << 5) | (vcu & 31); if (unit < 1024) att::attn_unit(unit >> 7, (unit >> 5) & 3, unit & 31, WSP(bf16_t, WS_Q), WSP(bf16_t, WS_K), WSP(bf16_t, WS_V), WSP(bf16_t, WS_ON), lam, kp->in[24], lds); }
#else
        for (size_t i = (size_t)bx * 512 + tid; i < (size_t)MROWS * 512 / 8; i += (size_t)G * 512) (WSP(u32x4, WS_ON))[i] = (u32x4){0u, 0u, 0u, 0u};
#endif
        PROBE_T(3, 1); PROBE_T(4, 0);
#if EN_HY
        {
            unsigned* qctr = (unsigned*)(kp->ws + WS_BAR + 14336);
            volatile LAS unsigned* qs = (volatile LAS unsigned*)(lds + LDS_MISC + 16);
            for (;;) {
                if (tid == 0) *qs = __hip_atomic_fetch_add(qctr, 1u, __ATOMIC_RELAXED, __HIP_MEMORY_SCOPE_AGENT);
                __syncthreads();
                const unsigned ch = *qs;
                __syncthreads();
                if (ch >= 2048u) break;
                for (int j = 0; j < 1; ++j) { const int unit = (int)ch;
                    hy::hyena_unit(unit >> 2, unit & 3, WSP(bf16_t, WS_ZHY), kp->in[9], kp->in[10], kp->in[19], WSP(f32x2, WS_KSPEC), WSP(f32x2, WS_TW), WSP(bf16_t, WS_YHT), (LAS f32x2*)lds); }
            }
        }
#endif
    }
    xcd_barrier(xbar);

    PROBE_T(4, 1); PROBE_T(5, 0);
    if (PH(4)) {
        KPtr kp = kargs();
        TIDS();
        const bf16_t* YHT = WSP(bf16_t, WS_YHT); bf16_t* YH = WSP(bf16_t, WS_YH);
#if EN_HY
        LAS bf16_t* scr = (LAS bf16_t*)(lds + wave * 8448);
        for (int tile = gw; tile < 4096; tile += NGW) {
            const int b = tile >> 9, cb = (tile >> 6) & 7, tb = tile & 63;
            const bf16_t* src = YHT + (size_t)(b * 512 + cb * 64) * 4096 + tb * 64;
            for (int i = 0; i < 64; ++i) scr[i * 66 + lane] = src[(size_t)i * 4096 + lane];
            asm volatile("s_waitcnt lgkmcnt(0)" ::: "memory");
            bf16_t* dst = YH + (size_t)(b * 4096 + tb * 64) * 512 + cb * 64;
            for (int j = 0; j < 64; ++j) dst[(size_t)j * 512 + lane] = scr[lane * 66 + j];
            asm volatile("s_waitcnt lgkmcnt(0)" ::: "memory");
        }
#else
        for (size_t i = (size_t)bx * 512 + tid; i < (size_t)MROWS * 512 / 8; i += (size_t)G * 512) ((u32x4*)YH)[i] = (u32x4){0u, 0u, 0u, 0u};
#endif
    }
    xcd_barrier(xbar);

    PROBE_T(5, 1); PROBE_T(6, 0);
    if (PH(5)) {
        KPtr kp = kargs();
        pg8::Gemm g{WSP(bf16_t, WS_YH), WSP(bf16_t, WS_WHY), MROWS, D, 512}; pg8::StaticOrder S; S.init(MROWS, D, G, bx);
        EpiMerge<false> E{WSP(bf16_t, WS_MBUF), WSP(bf16_t, WS_SG)};
        pg8::gemm_phase<EpiMerge<false>, pg8::StaticOrder, true, true>(lds, g, S, E);
    }
    asm volatile("s_waitcnt vmcnt(0)" ::: "memory"); __syncthreads();
    if (PH(5)) {
        KPtr kp = kargs();
        pg8::Gemm g{WSP(bf16_t, WS_ON), WSP(bf16_t, WS_WAT), MROWS, D, 512}; pg8::StaticOrder S; S.init(MROWS, D, G, bx);
        EpiMerge<true> E{WSP(bf16_t, WS_MBUF), WSP(bf16_t, WS_SG)};
        pg8::gemm_phase<EpiMerge<true>, pg8::StaticOrder, true, true>(lds, g, S, E);
    }
    xcd_barrier(xbar);

    PROBE_T(6, 1); PROBE_T(7, 0);
    if (PH(6)) {
        KPtr kp = kargs();
        pg8::Gemm g{WSP(bf16_t, WS_MBUF), WSP(bf16_t, WS_WOUT), MROWS, D, D}; pg8::StaticOrder S; S.init(MROWS, D, G, bx);
        EpiOut E{kp->in[0], WSP(float, WS_ST0), kp->in[4], kp->in[5], WSP(float, WS_MOD), WSP(bf16_t, WS_R1B)};
        pg8::gemm_phase<EpiOut, pg8::StaticOrder, true, true>(lds, g, S, E);
    }
    xcd_barrier(xbar);

    PROBE_T(7, 1); PROBE_T(8, 0);
    if (PH(7)) { KPtr kp = kargs(); TIDS(); float* st1 = WSP(float, WS_ST1); const float* mod = WSP(float, WS_MOD); bf16_t* HM = WSP(bf16_t, WS_HM); const bf16_t* r1b = WSP(bf16_t, WS_R1B); const float *l1g = kp->in[28], *l1b = kp->in[29];
    for (int r = 2 * gw; r < MROWS; r += 2 * NGW) {
        f32x4 va[4], vb[4]; float ma, sa, mb, sb; const int b = r >> 12;
        ln_row2_bf16(r1b + (size_t)r * D, r1b + (size_t)(r + 1) * D, l1g, l1b, lane, va, vb, ma, sa, mb, sb);
        if (lane == 0) *(f32x4*)(st1 + 2 * r) = (f32x4){ma, sa, mb, sb};
#pragma unroll
        for (int j = 0; j < 4; ++j) { const int col = 512 * (j >> 1) + 8 * lane + 4 * (j & 1);
            const f32x4 s4 = *(const f32x4*)(mod + b * NADA + 3 * D + col), c4 = *(const f32x4*)(mod + b * NADA + 4 * D + col);
            const f32x4 oa = va[j] * (c4 + 1.0f) + s4, ob = vb[j] * (c4 + 1.0f) + s4;
            u32x2 w; w.x = pk2(oa[0], oa[1]); w.y = pk2(oa[2], oa[3]); *(u32x2*)(HM + (size_t)r * D + col) = w;
            w.x = pk2(ob[0], ob[1]); w.y = pk2(ob[2], ob[3]); *(u32x2*)(HM + (size_t)(r + 1) * D + col) = w; }
    } }
    xcd_barrier(xbar);

    PROBE_T(8, 1);
#if EN_FFN
    PROBE_T(9, 0);
    if (PH(8)) {
        KPtr kp = kargs();
        pg8::Gemm g{WSP(bf16_t, WS_HM), WSP(bf16_t, WS_WUP), MROWS, NUP, D}; pg8::StaticOrder S; S.init(MROWS, NUP, G, bx);
        EpiUpGate E{WSP(bf16_t, WS_TSC), WSP(bf16_t, WS_ACT), kp->in[31], kp->in[32], WSP(bf16_t, WS_FILT)};
        pg8::gemm_phase<EpiUpGate, pg8::StaticOrder, true, true>(lds, g, S, E);
    }
    xcd_barrier(xbar);
    PROBE_T(9, 1);
#endif
    PROBE_T(11, 0);
    if (PH(10)) {
        KPtr kp = kargs();
        pg8::Gemm g{WSP(bf16_t, WS_ACT), WSP(bf16_t, WS_WDN), MROWS, D, DFF}; pg8::StaticOrder S; S.init(MROWS, D, G, bx);
#if EN_FFN
        {
            TIDS();
            const bf16_t* ub = WSP(bf16_t, WS_FILT); bf16_t* act = WSP(bf16_t, WS_ACT); const float* cw = kp->in[31]; const float* cb = kp->in[32];
            for (int ui = 0; ui < 2; ++ui) {
                pg8::Unit u; if (!S.next(ui, u)) break;
                for (int it = tid; it < 704; it += 512) {
                    const int which = it / 352, jg = it % 352, ca = jg * 8, pn = ca >> 7, cl = ca & 127, cgt = DFF + ca;
                    const int pm = u.pm; const bool lastrow = which != 0;
                    if (lastrow ? ((pm & 15) == 15) : ((pm & 15) == 0)) continue;
                    const int R = 256 * pm + (lastrow ? 255 : 0);
                    const bf16_t* pp = ub + ((size_t)(((lastrow ? pm : pm - 1) * 22 + pn) * 4 + (lastrow ? 2 : 3))) * 256;
                    const bf16_t* pc = ub + ((size_t)((pm * 22 + pn) * 4 + (lastrow ? 3 : 0))) * 256;
                    const bf16_t* pq = ub + ((size_t)(((lastrow ? pm + 1 : pm) * 22 + pn) * 4 + (lastrow ? 0 : 1))) * 256;
                    f32x4 pA[2], cA[2], nA[2], pG[2], cG[2], nG[2];
                    unpack8(*(const u32x4*)(pp + cl), pA[0], pA[1]); unpack8(*(const u32x4*)(pc + cl), cA[0], cA[1]); unpack8(*(const u32x4*)(pq + cl), nA[0], nA[1]);
                    unpack8(*(const u32x4*)(pp + 128 + cl), pG[0], pG[1]); unpack8(*(const u32x4*)(pc + 128 + cl), cG[0], cG[1]); unpack8(*(const u32x4*)(pq + 128 + cl), nG[0], nG[1]);
                    f32x4 o[2];
#pragma unroll
                    for (int n = 0; n < 2; ++n) {
                        const f32x4 av = *(const f32x4*)(cw + ca + 4 * n) * pA[n] + *(const f32x4*)(cw + NUP + ca + 4 * n) * cA[n] + *(const f32x4*)(cw + 2 * NUP + ca + 4 * n) * nA[n] + *(const f32x4*)(cb + ca + 4 * n);
                        const f32x4 gv = *(const f32x4*)(cw + cgt + 4 * n) * pG[n] + *(const f32x4*)(cw + NUP + cgt + 4 * n) * cG[n] + *(const f32x4*)(cw + 2 * NUP + cgt + 4 * n) * nG[n] + *(const f32x4*)(cb + cgt + 4 * n);
#pragma unroll
                        for (int e = 0; e < 4; ++e) o[n][e] = gv[e] * fast_sigmoid(gv[e]) * av[e];
                    }
                    *(u32x4*)(act + (size_t)R * DFF + ca) = pack8(o[0], o[1]);
                }
            }
            asm volatile("s_waitcnt vmcnt(0)" ::: "memory"); __syncthreads();
        }
#endif
        EpiDown E{WSP(float, WS_ST1), kp->in[28], kp->in[29], WSP(float, WS_MOD), WSP(bf16_t, WS_R1B), kp->out};
        pg8::gemm_phase<EpiDown, pg8::StaticOrder, true, true>(lds, g, S, E);
    }
    xcd_barrier(xbar);

    PROBE_T(11, 1); PROBE_T(12, 0);
    if (PH(11)) { KPtr kp = kargs(); TIDS(); float* outp = kp->out; const float *l2g = kp->in[34], *l2b = kp->in[35];
    f32x4 na[4], nb[4];
    ln_load2(outp + (size_t)(2 * gw) * D, outp + (size_t)(2 * gw + 1) * D, lane, na, nb);
    for (int r = 2 * gw; r < MROWS; r += 2 * NGW) {
        f32x4 va[4], vb[4]; float ma, sa, mb, sb;
#pragma unroll
        for (int j = 0; j < 4; ++j) { va[j] = na[j]; vb[j] = nb[j]; }
        if (r + 2 * NGW < MROWS) ln_load2(outp + (size_t)(r + 2 * NGW) * D, outp + (size_t)(r + 2 * NGW + 1) * D, lane, na, nb);
        ln_fin2(l2g, l2b, lane, va, vb, ma, sa, mb, sb);
        f32x4* oa = (f32x4*)(outp + (size_t)r * D) + lane; f32x4* ob = (f32x4*)(outp + (size_t)(r + 1) * D) + lane;
#pragma unroll
        for (int j = 0; j < 4; ++j) { oa[64 * j] = va[j]; ob[64 * j] = vb[j]; }
    } }
#ifdef EXTRA_SYNCS
    for (int i = 0; i < EXTRA_SYNCS; ++i) xcd_barrier(xbar);
#endif
    PROBE_T(12, 1);
    if (PROBE_PH >= 0 && blockIdx.x == 0 && threadIdx.x == 0) { KPtr kq = kargs(); const unsigned long long* tp = (const unsigned long long*)(kq->ws + 800 * 1024);
        const unsigned long long dt = tp[1] - tp[0], t0 = __builtin_amdgcn_s_memrealtime(); while (__builtin_amdgcn_s_memrealtime() - t0 < dt) __builtin_amdgcn_s_sleep(16); }
}

extern "C" void kernel_launch(void* const* d_in, const int* in_sizes, int n_in, void* d_out, int out_size, void* d_ws, size_t ws_size, hipStream_t stream) {
    static int grid = 0;
    if (grid == 0) {
        if (n_in != 36 || out_size != MROWS * D || ws_size < WS_END) { fprintf(stderr, "kernel_launch: unexpected shapes (n_in %d out %d ws %zu)\n", n_in, out_size, ws_size); grid = -1; return; }
        int dev = 0, cus = 0, per_cu = 0;
        hipGetDevice(&dev); hipDeviceGetAttribute(&cus, hipDeviceAttributeMultiprocessorCount, dev);
        hipFuncSetAttribute((const void*)fwd_kernel, hipFuncAttributeMaxDynamicSharedMemorySize, LDS_BYTES);
        hipOccupancyMaxActiveBlocksPerMultiprocessor(&per_cu, (const void*)fwd_kernel, 512, LDS_BYTES);
        if (per_cu < 1) { fprintf(stderr, "kernel_launch: occupancy query returned %d\n", per_cu); per_cu = 1; }
        (void)hipGetLastError();
        grid = cus;
    }
    if (grid < 0) return;
    if (hipMemsetAsync((char*)d_ws + WS_BAR, 0, 16384, stream) != hipSuccess) { fprintf(stderr, "kernel_launch: memset of the barrier words failed\n"); return; }
    Params prm{};
    for (int i = 0; i < 36; ++i) prm.in[i] = (const float*)d_in[i];
    prm.out = (float*)d_out; prm.ws = (unsigned char*)d_ws;
    void* args[] = {&prm};
    hipError_t e = hipLaunchCooperativeKernel((const void*)fwd_kernel, dim3(grid), dim3(512), args, LDS_BYTES, stream);
    if (e != hipSuccess) fprintf(stderr, "cooperative launch failed: %s (grid %d)\n", hipGetErrorString(e), grid);
}
```

```cpp
#include <hip/hip_runtime.h>
#include <hip/hip_cooperative_groups.h>
#include <cstdio>
#include <cstdint>
namespace cg = cooperative_groups;
namespace pg8 {
#define PG8_LAS __attribute__((address_space(3)))
typedef unsigned short bf16_t;
typedef short bf16x8 __attribute__((ext_vector_type(8)));
typedef float f32x4 __attribute__((ext_vector_type(4)));
typedef unsigned u32x4 __attribute__((ext_vector_type(4)));
constexpr int BM = 256, BK = 64, HALF = 128, HTB = HALF * BK * 2  , STAGE_BYTES = 8 * HTB, NXCD = 8, WGM = 2;

__host__ __device__ __forceinline__ int lds_byte(int r, int c) { const int st = (r >> 4) * 2 + (c >> 5), rr = r & 15, cc = c & 31, ob = rr * 64 + cc * 2; return st * 1024 + (ob ^ (((ob >> 9) & 1) << 5)); }
__host__ __device__ __forceinline__ void stage_rc(int b, int& R, int& C) { const int st = b / 1024, sb = b % 1024, swz = sb ^ (((sb >> 9) & 1) << 5); R = (st >> 1) * 16 + swz / 64; C = (st & 1) * 32 + (swz % 64) / 2; }
__host__ __device__ __forceinline__ int perm32(int rho) { const int n = rho >> 4, i = rho & 15; return 8 * (i >> 2) + 4 * n + (i & 3); }

struct Unit { int pm, pn; };
struct Gemm { const bf16_t* A; const bf16_t* Bt; int M, N, K; int a_rows = 256; };

struct StaticOrder {
    int nM, nN, nwg, G, c;
    __host__ __device__ void init(int M, int N, int G_, int c_) { nM = M / BM; nN = N / BM; nwg = nM * nN; G = G_; c = c_; }
    __host__ __device__ bool next(int i, Unit& u) const {
        const long L = (long)i * G + c; if (L >= nwg) return false;
        int wgid = (int)L; { const int q = nwg / NXCD, r = nwg % NXCD, xcd = wgid % NXCD, off = wgid / NXCD; wgid = (xcd < r ? xcd * (q + 1) : r * (q + 1) + (xcd - r) * q) + off; }
        const int nig = WGM * nN, gid = wgid / nig, fm = gid * WGM, gsz = (nM - fm) < WGM ? (nM - fm) : WGM;
        u.pm = fm + ((wgid % nig) % gsz); u.pn = (wgid % nig) / gsz; return true;
    }
    __device__ __forceinline__ void a_ready(const Unit&) const {}
    __device__ __forceinline__ void done(const Unit&) const {}
};
__device__ __forceinline__ unsigned cvt_pk_bf16(float lo, float hi) { unsigned r; asm volatile("v_cvt_pk_bf16_f32 %0, %1, %2" : "=v"(r) : "v"(lo), "v"(hi)); return r; }
typedef float f32x2 __attribute__((ext_vector_type(2)));
template <class Epi, class Sched, bool ALIGN_EPI = false, bool SP2 = false>
__device__ __forceinline__ void gemm_phase(PG8_LAS unsigned char* lds, const Gemm g, const Sched& S, const Epi& E) {
    int tid_l = threadIdx.x; asm volatile("" : "+v"(tid_l));
    const int tid = tid_l, wid = __builtin_amdgcn_readfirstlane(tid >> 6), lane = tid & 63, wr = wid >> 2, wc = wid & 3, fr = lane & 15, fq = lane >> 4;
    const int K = g.K, nt = K / BK;
    unsigned voffA[2], voffB[2];
#pragma unroll
    for (int i = 0; i < 2; ++i) { int R, C; stage_rc(tid * 16 + i * 8192, R, C); const int Rb = Epi::PERM ? ((R & ~31) + perm32(R & 31)) : R;
        voffA[i] = (unsigned)(R * K + C) * 2u; voffB[i] = (unsigned)(Rb * K + C) * 2u; }
    const size_t kstep = (size_t)(BK * 2);
    const size_t hstep = (size_t)HALF * K * 2;
    const size_t tstep = 2 * hstep;
    const size_t atstep = (size_t)g.a_rows * K * 2;
    const unsigned ldsw = (unsigned)wid * 1024u;
    const int aoff = lds_byte(wr * 64 + fr, fq * 8), boff = lds_byte(wc * 32 + fr, fq * 8);
#define PG8_SA(b, h) (((b) * 2 + (h)) * HTB)
#define PG8_SB(b, h) ((4 + (b) * 2 + (h)) * HTB)
#define PG8_STAGE(bufoff, gbase, voff) do { _Pragma("unroll") for (int _i = 0; _i < 2; ++_i) \
        __builtin_amdgcn_global_load_lds((const unsigned*)((const char*)(gbase) + (voff)[_i]), (PG8_LAS unsigned*)(lds + (bufoff) + ldsw + _i * 8192), 16, 0, 0); } while (0)
#define PG8_LDA(dst, b, h) do { _Pragma("unroll") for (int m = 0; m < 4; ++m) _Pragma("unroll") for (int k = 0; k < 2; ++k) dst[m][k] = *(const PG8_LAS bf16x8*)(lds + PG8_SA(b, h) + aoff + m * 2048 + k * 1024); } while (0)
#define PG8_LDB(dst, b, h) do { _Pragma("unroll") for (int n = 0; n < 2; ++n) _Pragma("unroll") for (int k = 0; k < 2; ++k) dst[n][k] = *(const PG8_LAS bf16x8*)(lds + PG8_SB(b, h) + boff + n * 2048 + k * 1024); } while (0)
#define PG8_MMA(ai, bj, At, Bt) do { __builtin_amdgcn_s_setprio(1); _Pragma("unroll") for (int m = 0; m < 4; ++m) _Pragma("unroll") for (int n = 0; n < 2; ++n) _Pragma("unroll") for (int k = 0; k < 2; ++k) \
        acc[ai][bj][m][n] = __builtin_amdgcn_mfma_f32_16x16x32_bf16(Bt[n][k], At[m][k], acc[ai][bj][m][n], 0, 0, 0); __builtin_amdgcn_s_setprio(0); } while (0)
#define PG8_WAIT_V(n) asm volatile("s_waitcnt vmcnt(" #n ")" ::: "memory")
#define PG8_WAIT_L(n) asm volatile("s_waitcnt lgkmcnt(" #n ")" ::: "memory")
#define PG8_BAR __builtin_amdgcn_s_barrier()
#define PG8_SCHED __builtin_amdgcn_sched_barrier(0)
    Unit cur, nxt; int ui = 0;
    if (!S.next(0, cur)) return;
    f32x4 acc[2][2][4][2];
#pragma unroll
    for (int a = 0; a < 2; ++a)
#pragma unroll
        for (int b = 0; b < 2; ++b)
#pragma unroll
            for (int m = 0; m < 4; ++m)
#pragma unroll
                for (int n = 0; n < 2; ++n) acc[a][b][m][n] = (f32x4){0.f, 0.f, 0.f, 0.f};
    bf16x8 At[4][2], B0[2][2], B1[2][2];
    const char* cA = (const char*)g.A + (size_t)cur.pm * atstep; const char* cB = (const char*)g.Bt + (size_t)cur.pn * tstep;
    S.a_ready(cur);
    if constexpr (SP2) {
        PG8_STAGE(PG8_SB(0, 0), cB, voffB); PG8_STAGE(PG8_SB(0, 1), cB + hstep, voffB); PG8_STAGE(PG8_SA(0, 0), cA, voffA); PG8_STAGE(PG8_SA(0, 1), cA + hstep, voffA);
        if (wr == 1) PG8_BAR;
        PG8_WAIT_V(2); PG8_BAR;
        PG8_STAGE(PG8_SB(1, 0), cB + kstep, voffB); PG8_STAGE(PG8_SA(1, 0), cA + kstep, voffA); PG8_STAGE(PG8_SB(1, 1), cB + hstep + kstep, voffB);
        PG8_WAIT_V(6); PG8_BAR;
    } else {
        PG8_STAGE(PG8_SB(0, 0), cB, voffB); PG8_STAGE(PG8_SA(0, 0), cA, voffA); PG8_STAGE(PG8_SB(0, 1), cB + hstep, voffB); PG8_STAGE(PG8_SA(0, 1), cA + hstep, voffA);
        if (wr == 1) PG8_BAR;
        PG8_WAIT_V(4); PG8_BAR;
        PG8_STAGE(PG8_SB(1, 0), cB + kstep, voffB); PG8_STAGE(PG8_SA(1, 0), cA + kstep, voffA); PG8_STAGE(PG8_SB(1, 1), cB + hstep + kstep, voffB);
        PG8_WAIT_V(6); PG8_BAR;
    }
    for (;;) {
        const bool has_next = S.next(ui + 1, nxt);
        const char* nA = has_next ? (const char*)g.A + (size_t)nxt.pm * atstep : cA; const char* nB = has_next ? (const char*)g.Bt + (size_t)nxt.pn * tstep : cB;
        for (int t = 0; t < nt; t += 2) {
            const bool last = (t == nt - 2);
            const char* a1 = cA + (size_t)(t + 1) * kstep;
            const char* a2 = last ? nA : cA + (size_t)(t + 2) * kstep; const char* b2 = last ? nB : cB + (size_t)(t + 2) * kstep;
            const char* a3 = a2 + kstep; const char* b3 = b2 + kstep;
            if (last && has_next) S.a_ready(nxt);
            if constexpr (SP2) {
            PG8_LDB(B0, 0, 0); PG8_LDB(B1, 0, 1); PG8_SCHED; PG8_LDA(At, 0, 0); PG8_STAGE(PG8_SA(1, 1), a1 + hstep, voffA);
            PG8_WAIT_V(8); PG8_WAIT_L(0); PG8_BAR; PG8_MMA(0, 0, At, B0); PG8_MMA(0, 1, At, B1); PG8_BAR; PG8_SCHED;
            PG8_LDA(At, 0, 1); PG8_STAGE(PG8_SB(0, 0), b2, voffB); PG8_STAGE(PG8_SB(0, 1), b2 + hstep, voffB); PG8_STAGE(PG8_SA(0, 0), a2, voffA);
            PG8_WAIT_V(8); PG8_WAIT_L(0); PG8_BAR; PG8_MMA(1, 0, At, B0); PG8_MMA(1, 1, At, B1); PG8_BAR; PG8_SCHED;
            PG8_LDB(B0, 1, 0); PG8_LDB(B1, 1, 1); PG8_SCHED; PG8_LDA(At, 1, 0); PG8_STAGE(PG8_SA(0, 1), a2 + hstep, voffA);
            PG8_WAIT_V(8); PG8_WAIT_L(0); PG8_BAR; PG8_MMA(0, 0, At, B0); PG8_MMA(0, 1, At, B1); PG8_BAR; PG8_SCHED;
            PG8_LDA(At, 1, 1); PG8_STAGE(PG8_SB(1, 0), b3, voffB); PG8_STAGE(PG8_SB(1, 1), b3 + hstep, voffB); PG8_STAGE(PG8_SA(1, 0), a3, voffA);
            PG8_WAIT_V(8); PG8_WAIT_L(0); PG8_BAR; PG8_MMA(1, 0, At, B0); PG8_MMA(1, 1, At, B1); PG8_BAR; PG8_SCHED;
            } else {
            PG8_LDB(B0, 0, 0); PG8_SCHED; PG8_LDA(At, 0, 0); PG8_STAGE(PG8_SA(1, 1), a1 + hstep, voffA);
            PG8_WAIT_L(8); PG8_BAR; PG8_WAIT_L(0); PG8_MMA(0, 0, At, B0); PG8_BAR; PG8_SCHED;
            PG8_LDB(B1, 0, 1); PG8_STAGE(PG8_SB(0, 0), b2, voffB);
            PG8_BAR; PG8_WAIT_L(0); PG8_MMA(0, 1, At, B1); PG8_BAR;
            PG8_LDA(At, 0, 1); PG8_STAGE(PG8_SA(0, 0), a2, voffA);
            PG8_BAR; PG8_WAIT_L(0); PG8_MMA(1, 0, At, B0); PG8_BAR; PG8_SCHED;
            PG8_STAGE(PG8_SB(0, 1), b2 + hstep, voffB);
            PG8_WAIT_V(6); PG8_BAR; PG8_MMA(1, 1, At, B1); PG8_BAR;
            PG8_LDB(B0, 1, 0); PG8_SCHED; PG8_LDA(At, 1, 0); PG8_STAGE(PG8_SA(0, 1), a2 + hstep, voffA);
            PG8_WAIT_L(8); PG8_BAR; PG8_WAIT_L(0); PG8_MMA(0, 0, At, B0); PG8_BAR; PG8_SCHED;
            PG8_LDB(B1, 1, 1); PG8_STAGE(PG8_SB(1, 0), b3, voffB);
            PG8_BAR; PG8_WAIT_L(0); PG8_MMA(0, 1, At, B1); PG8_BAR;
            PG8_LDA(At, 1, 1); PG8_STAGE(PG8_SA(1, 0), a3, voffA);
            PG8_BAR; PG8_WAIT_L(0); PG8_MMA(1, 0, At, B0); PG8_BAR; PG8_SCHED;
            PG8_STAGE(PG8_SB(1, 1), b3 + hstep, voffB);
            PG8_WAIT_V(6); PG8_BAR; PG8_MMA(1, 1, At, B1); PG8_BAR;
            }
        }
        if constexpr (ALIGN_EPI) { if (wr == 0) PG8_BAR; }
        if constexpr (!Epi::AFTER_DRAIN) { E(acc, cur, wr, wc, fr, fq); S.done(cur); }
        if (!has_next) break;
#pragma unroll
        for (int a = 0; a < 2; ++a)
#pragma unroll
            for (int b = 0; b < 2; ++b)
#pragma unroll
                for (int m = 0; m < 4; ++m)
#pragma unroll
                    for (int n = 0; n < 2; ++n) acc[a][b][m][n] = (f32x4){0.f, 0.f, 0.f, 0.f};
        cur = nxt; cA = nA; cB = nB; ++ui;
        if constexpr (ALIGN_EPI) { if (wr == 1) PG8_BAR; }
    }
    PG8_WAIT_V(0);
    if constexpr (!ALIGN_EPI) { if (wr == 0) PG8_BAR; }
    PG8_BAR;
    if constexpr (Epi::AFTER_DRAIN) { E.fused(acc, cur, wr, wc, fr, fq, lds, wid, lane); S.done(cur); }
#undef PG8_SA
#undef PG8_SB
#undef PG8_STAGE
#undef PG8_LDA
#undef PG8_LDB
#undef PG8_MMA
#undef PG8_WAIT_V
#undef PG8_WAIT_L
#undef PG8_BAR
#undef PG8_SCHED
}
}

#ifndef EN_ATT
#define EN_ATT 1
#endif
#ifndef EN_HY
#define EN_HY 1
#endif
#ifndef EN_FFN
#define EN_FFN 1
#endif
#ifndef PROBE_PH
#define PROBE_PH -1
#endif
#ifndef PHASES
#define PHASES 0xFFFF
#endif
#define PH(k) ((PHASES >> (k)) & 1)
#define LAS __attribute__((address_space(3)))
typedef unsigned short bf16_t;
typedef pg8::f32x4 f32x4;
typedef pg8::u32x4 u32x4;
typedef pg8::bf16x8 bf16x8;
typedef float f32x16 __attribute__((ext_vector_type(16)));
typedef float f32x2 __attribute__((ext_vector_type(2)));
typedef unsigned u32x2 __attribute__((ext_vector_type(2)));
typedef short s16x4 __attribute__((ext_vector_type(4)));

constexpr int D = 1024, NB = 8, SEQ = 4096, MROWS = NB * SEQ, CTX = 256, MCTX = NB * CTX, KV = CTX + SEQ;
constexpr int INC = 5120, DFF = 2816, NUP = 2 * DFF, NADA = 6 * D;
constexpr float LN_EPS = 1e-5f, RMS_EPS = 1e-5f;
constexpr float DN_ALPHA = 1.189207115002721f;
constexpr float LAM_INIT = 0.2f;
constexpr float QSCALE = 0.125f * 1.4426950408889634f;

constexpr size_t MiB = 1u << 20;
constexpr size_t WS_ST0 = 0, WS_ST1 = 256 * 1024, WS_ROPE = 512 * 1024, WS_TW = 528 * 1024, WS_MOD = 576 * 1024;
constexpr size_t WS_MODP = 1 * MiB;
constexpr size_t WS_WIN = 3 * MiB, WS_WHY = 13 * MiB, WS_WAT = 14 * MiB, WS_WOUT = 15 * MiB, WS_WUP = 17 * MiB, WS_WDN = 28 * MiB;
constexpr size_t WS_XM = 34 * MiB;
constexpr size_t WS_ON = 34 * MiB, WS_YHT = 66 * MiB, WS_HM = 34 * MiB;
constexpr size_t WS_CTXM = 98 * MiB;
constexpr size_t WS_FILT = 490 * MiB;
constexpr size_t WS_SG = 102 * MiB;
constexpr size_t WS_KSPEC = 230 * MiB;
constexpr size_t WS_MBUF = 230 * MiB;
constexpr size_t WS_ZHY = 294 * MiB;
constexpr size_t WS_YH = 294 * MiB;
constexpr size_t WS_Q = 390 * MiB, WS_K = 422 * MiB, WS_V = 456 * MiB;
constexpr size_t WS_U = 102 * MiB;
constexpr size_t WS_ACT = 278 * MiB;
constexpr size_t WS_TSC = 102 * MiB;
constexpr size_t WS_R1B = 134 * MiB;
constexpr size_t WS_END = 506 * MiB;

constexpr int LDS_MISC = 139264;
constexpr int LDS_BYTES = 139264 + 256;
constexpr size_t WS_BAR = 832 * 1024;

__device__ __forceinline__ int tid_fresh() { int t = threadIdx.x; asm volatile("" : "+v"(t)); return t; }
__device__ __forceinline__ unsigned pk2(float lo, float hi) { return pg8::cvt_pk_bf16(lo, hi); }
__device__ __forceinline__ float bflo(unsigned w) { return __uint_as_float(w << 16); }
__device__ __forceinline__ float bfhi(unsigned w) { return __uint_as_float(w & 0xffff0000u); }
__device__ __forceinline__ float bf1(bf16_t v) { return __uint_as_float((unsigned)v << 16); }
template <int MASK> __device__ __forceinline__ float xswz(float v) { return __uint_as_float((unsigned)__builtin_amdgcn_ds_swizzle((int)__float_as_uint(v), 0x1F | (MASK << 10))); }
__device__ __forceinline__ float xsum32(float v) { const unsigned u = __float_as_uint(v); auto rr = __builtin_amdgcn_permlane32_swap(u, u, false, false); return __uint_as_float(rr[0]) + __uint_as_float(rr[1]); }
__device__ __forceinline__ float xmax32(float v) { const unsigned u = __float_as_uint(v); auto rr = __builtin_amdgcn_permlane32_swap(u, u, false, false); return fmaxf(__uint_as_float(rr[0]), __uint_as_float(rr[1])); }
__device__ __forceinline__ float xget32(float v, bool upper) { const unsigned u = __float_as_uint(v); auto rr = __builtin_amdgcn_permlane32_swap(u, u, false, false); return __uint_as_float(upper ? rr[0] : rr[1]); }
__device__ __forceinline__ float wave_sum(float v) {
    v += xswz<1>(v); v += xswz<2>(v); v += xswz<4>(v); v += xswz<8>(v); v += xswz<16>(v);
    return xsum32(v);
}
__device__ __forceinline__ float fast_sigmoid(float x) { return __builtin_amdgcn_rcpf(1.0f + __builtin_amdgcn_exp2f(-1.4426950408889634f * x)); }
__device__ __forceinline__ u32x4 pack8(const f32x4& a, const f32x4& b) { u32x4 w; w.x = pk2(a[0], a[1]); w.y = pk2(a[2], a[3]); w.z = pk2(b[0], b[1]); w.w = pk2(b[2], b[3]); return w; }
__device__ __forceinline__ void unpack8(const u32x4& w, f32x4& a, f32x4& b) { a = (f32x4){bflo(w.x), bfhi(w.x), bflo(w.y), bfhi(w.y)}; b = (f32x4){bflo(w.z), bfhi(w.z), bflo(w.w), bfhi(w.w)}; }

__device__ __forceinline__ size_t koff(int pos, int d) { return ((size_t)(((pos >> 6) * 8 + (d >> 3)) * 64 + (pos & 63))) * 8 + (d & 7); }
__device__ __forceinline__ size_t voff(int pos, int dv) { return ((size_t)(((pos >> 6) * 4 + (dv >> 5)) * 64 + (pos & 63))) * 32 + (dv & 31); }
struct EpiIn {
    static constexpr bool PERM = true, AFTER_DRAIN = false;
    bf16_t *zhy, *q, *k, *v, *sg; const f32x2* rope;
    __device__ __forceinline__ void operator()(const f32x4 (&acc)[2][2][4][2], const pg8::Unit& u, int wr, int wc, int fr, int fq) const {
        const int pn = u.pn;
#pragma unroll
        for (int ai = 0; ai < 2; ++ai)
#pragma unroll
            for (int m = 0; m < 4; ++m) {
                const int r = u.pm * 256 + ai * 128 + wr * 64 + m * 16 + fr; const int b = r >> 12, t = r & 4095;
#pragma unroll
                for (int bj = 0; bj < 2; ++bj) {
                    const int c = pn * 256 + bj * 128 + wc * 32 + fq * 8;
                    const f32x4 v0 = acc[ai][bj][m][0], v1 = acc[ai][bj][m][1];
                    if (pn < 6) {
                        bf16_t* dst = zhy + ((size_t)(b * 1536 + c) * 4096 + t);
                        const u32x4 w = pack8(v0, v1);
                        dst[0] = (bf16_t)(w.x & 0xffff); dst[4096] = (bf16_t)(w.x >> 16); dst[2 * 4096] = (bf16_t)(w.y & 0xffff); dst[3 * 4096] = (bf16_t)(w.y >> 16);
                        dst[4 * 4096] = (bf16_t)(w.z & 0xffff); dst[5 * 4096] = (bf16_t)(w.z >> 16); dst[6 * 4096] = (bf16_t)(w.w & 0xffff); dst[7 * 4096] = (bf16_t)(w.w >> 16);
                    } else if (pn < 10) {
                        const bool isq = pn < 8; const int cq = c - (isq ? 1536 : 2048);
                        const int h = cq >> 7, cc = (cq >> 6) & 1, d = cq & 63, axis = (cq >> 5) & 1;
                        const int pos = axis ? (t & 63) : (t >> 6);
                        const f32x4* rt = (const f32x4*)(rope + pos * 16 + (fq & 1) * 8);
                        const f32x4 t0 = rt[0], t1 = rt[1], t2 = rt[2], t3 = rt[3];
                        const float sgn = (fq < 2) ? -1.0f : 1.0f;
                        f32x4 p0, p1;
#pragma unroll
                        for (int e = 0; e < 4; ++e) { p0[e] = xget32(v0[e], fq >= 2); p1[e] = xget32(v1[e], fq >= 2); }
                        f32x4 o0, o1;
                        o0[0] = v0[0] * t0[0] + sgn * p0[0] * t0[1]; o0[1] = v0[1] * t0[2] + sgn * p0[1] * t0[3];
                        o0[2] = v0[2] * t1[0] + sgn * p0[2] * t1[1]; o0[3] = v0[3] * t1[2] + sgn * p0[3] * t1[3];
                        o1[0] = v1[0] * t2[0] + sgn * p1[0] * t2[1]; o1[1] = v1[1] * t2[2] + sgn * p1[1] * t2[3];
                        o1[2] = v1[2] * t3[0] + sgn * p1[2] * t3[1]; o1[3] = v1[3] * t3[2] + sgn * p1[3] * t3[3];
                        if (isq) { o0 = o0 * QSCALE; o1 = o1 * QSCALE; *(u32x4*)(q + ((size_t)((b * 4 + h) * 2 + cc) * SEQ + t) * 64 + d) = pack8(o0, o1); }
                        else *(u32x4*)(k + (size_t)((b * 4 + h) * 2 + cc) * KV * 64 + koff(CTX + t, d)) = pack8(o0, o1);
                    } else if (pn < 12) {
                        const int cv = c - 2560, h = cv >> 7, dv = cv & 127;
                        *(u32x4*)(v + (size_t)(b * 4 + h) * KV * 128 + voff(CTX + t, dv)) = pack8(v0, v1);
                    } else {
                        f32x4 s0, s1;
#pragma unroll
                        for (int e = 0; e < 4; ++e) { s0[e] = fast_sigmoid(v0[e]); s1[e] = fast_sigmoid(v1[e]); }
                        *(u32x4*)(sg + (size_t)r * 2048 + (c - 3072)) = pack8(s0, s1);
                    }
                }
            }
    }
};
struct EpiCtx {
    static constexpr bool PERM = true, AFTER_DRAIN = false;
    bf16_t *k, *v;
    __device__ __forceinline__ void operator()(const f32x4 (&acc)[2][2][4][2], const pg8::Unit& u, int wr, int wc, int fr, int fq) const {
        const int pn = u.pn;
#pragma unroll
        for (int ai = 0; ai < 2; ++ai)
#pragma unroll
            for (int m = 0; m < 4; ++m) {
                const int r = u.pm * 256 + ai * 128 + wr * 64 + m * 16 + fr; const int b = r >> 8, t = r & 255;
#pragma unroll
                for (int bj = 0; bj < 2; ++bj) {
                    const int c = pn * 256 + bj * 128 + wc * 32 + fq * 8;
                    const u32x4 w = pack8(acc[ai][bj][m][0], acc[ai][bj][m][1]);
                    if (pn < 2) { const int h = c >> 7, cc = (c >> 6) & 1, d = c & 63; *(u32x4*)(k + (size_t)((b * 4 + h) * 2 + cc) * KV * 64 + koff(t, d)) = w; }
                    else { const int cv = c - 512, h = cv >> 7, dv = cv & 127; *(u32x4*)(v + (size_t)(b * 4 + h) * KV * 128 + voff(t, dv)) = w; }
                }
            }
    }
};
template <bool ADD> struct EpiMerge {
    static constexpr bool PERM = true, AFTER_DRAIN = false;
    bf16_t* mb; const bf16_t* sg;
    __device__ __forceinline__ void operator()(const f32x4 (&acc)[2][2][4][2], const pg8::Unit& u, int wr, int wc, int fr, int fq) const {
#pragma unroll
        for (int ai = 0; ai < 2; ++ai)
#pragma unroll
            for (int m = 0; m < 4; ++m) {
                const int r = u.pm * 256 + ai * 128 + wr * 64 + m * 16 + fr;
#pragma unroll
                for (int bj = 0; bj < 2; ++bj) {
                    const int c = u.pn * 256 + bj * 128 + wc * 32 + fq * 8;
                    f32x4 g0, g1; unpack8(*(const u32x4*)(sg + (size_t)r * 2048 + (ADD ? 1024 : 0) + c), g0, g1);
                    f32x4 o0 = acc[ai][bj][m][0] * g0, o1 = acc[ai][bj][m][1] * g1;
                    bf16_t* dst = mb + (size_t)r * D + c;
                    if (ADD) { f32x4 p0, p1; unpack8(*(const u32x4*)dst, p0, p1); o0 = o0 + p0; o1 = o1 + p1; }
                    *(u32x4*)dst = pack8(o0, o1);
                }
            }
    }
};
struct EpiOut {
    static constexpr bool PERM = true, AFTER_DRAIN = false;
    const float *x, *st0, *lg, *lb, *mod; bf16_t* r1b;
    __device__ __forceinline__ void operator()(const f32x4 (&acc)[2][2][4][2], const pg8::Unit& u, int wr, int wc, int fr, int fq) const {
        const int b = (u.pm * 256) >> 12;
#pragma unroll
        for (int bj = 0; bj < 2; ++bj) {
            const int c = u.pn * 256 + bj * 128 + wc * 32 + fq * 8;
            f32x4 g[2], bb[2], g1[2];
#pragma unroll
            for (int n = 0; n < 2; ++n) { g[n] = *(const f32x4*)(lg + c + 4 * n); bb[n] = *(const f32x4*)(lb + c + 4 * n); g1[n] = *(const f32x4*)(mod + b * NADA + 2 * D + c + 4 * n); }
#pragma unroll
            for (int ai = 0; ai < 2; ++ai)
#pragma unroll
                for (int m = 0; m < 4; ++m) {
                    const int r = u.pm * 256 + ai * 128 + wr * 64 + m * 16 + fr;
                    const f32x2 st = *(const f32x2*)(st0 + 2 * r);
                    f32x4 rr[2];
#pragma unroll
                    for (int n = 0; n < 2; ++n) {
                        const f32x4 xv = *(const f32x4*)(x + (size_t)r * D + c + 4 * n);
                        const f32x4 xl = (xv - st.x) * st.y * g[n] + bb[n];
                        rr[n] = xl * DN_ALPHA + g1[n] * acc[ai][bj][m][n];
                    }
                    *(u32x4*)(r1b + (size_t)r * D + c) = pack8(rr[0], rr[1]);
                }
        }
    }
};
struct EpiUpGate {
    static constexpr bool PERM = true, AFTER_DRAIN = false;
    bf16_t* tsc; bf16_t* act; const float* cw; const float* cb; bf16_t* ubnd;
    __device__ __forceinline__ void operator()(const f32x4 (&acc)[2][2][4][2], const pg8::Unit& u, int wr, int wc, int fr, int fq) const {
        bf16_t* T = tsc + (size_t)blockIdx.x * 65536;
#pragma unroll
        for (int ai = 0; ai < 2; ++ai)
#pragma unroll
            for (int m = 0; m < 4; ++m) {
                const int r = ai * 128 + wr * 64 + m * 16 + fr;
#pragma unroll
                for (int bj = 0; bj < 2; ++bj) *(u32x4*)(T + r * 256 + bj * 128 + wc * 32 + fq * 8) = pack8(acc[ai][bj][m][0], acc[ai][bj][m][1]);
            }
        asm volatile("s_waitcnt vmcnt(0)" ::: "memory"); __builtin_amdgcn_s_barrier(); asm volatile("" ::: "memory");
        const int tid = (wr * 4 + wc) * 64 + fq * 16 + fr, cg_ = tid & 15, rc = tid >> 4;
        if (tid < 128) {
            const int q = tid >> 5, ch = tid & 31, rr = (q < 2) ? q : 252 + q;
            *(u32x4*)(ubnd + ((size_t)((u.pm * 22 + u.pn) * 4 + q)) * 256 + ch * 8) = *(const u32x4*)(T + rr * 256 + ch * 8);
        }
        const int ca = u.pn * 128 + cg_ * 8, cgt = DFF + ca;
        f32x4 wA[3][2], wG[3][2], bA[2], bG[2];
#pragma unroll
        for (int j = 0; j < 3; ++j)
#pragma unroll
            for (int n = 0; n < 2; ++n) { wA[j][n] = *(const f32x4*)(cw + j * NUP + ca + 4 * n); wG[j][n] = *(const f32x4*)(cw + j * NUP + cgt + 4 * n); }
#pragma unroll
        for (int n = 0; n < 2; ++n) { bA[n] = *(const f32x4*)(cb + ca + 4 * n); bG[n] = *(const f32x4*)(cb + cgt + 4 * n); }
        const f32x4 z4 = {0.f, 0.f, 0.f, 0.f};
#pragma unroll 1
        for (int hh = 0; hh < 2; ++hh) {
            u32x4 ra[6], rg[6];
#pragma unroll
            for (int i = 0; i < 6; ++i) { int r = rc * 8 + hh * 4 - 1 + i; r = r < 0 ? 0 : (r > 255 ? 255 : r);
                ra[i] = *(const u32x4*)(T + r * 256 + cg_ * 8); rg[i] = *(const u32x4*)(T + r * 256 + 128 + cg_ * 8); }
#pragma unroll
            for (int i = 0; i < 4; ++i) {
                const int r = rc * 8 + hh * 4 + i, R = 256 * u.pm + r, t = R & 4095;
                f32x4 pA[2], cA[2], nA[2], pG[2], cG[2], nG[2];
                unpack8(ra[i], pA[0], pA[1]); unpack8(ra[i + 1], cA[0], cA[1]); unpack8(ra[i + 2], nA[0], nA[1]);
                unpack8(rg[i], pG[0], pG[1]); unpack8(rg[i + 1], cG[0], cG[1]); unpack8(rg[i + 2], nG[0], nG[1]);
                if (t == 0) { pA[0] = pA[1] = pG[0] = pG[1] = z4; }
                if (t == 4095) { nA[0] = nA[1] = nG[0] = nG[1] = z4; }
                f32x4 o[2];
#pragma unroll
                for (int n = 0; n < 2; ++n) {
                    const f32x4 av = wA[0][n] * pA[n] + wA[1][n] * cA[n] + wA[2][n] * nA[n] + bA[n];
                    const f32x4 gv = wG[0][n] * pG[n] + wG[1][n] * cG[n] + wG[2][n] * nG[n] + bG[n];
#pragma unroll
                    for (int e = 0; e < 4; ++e) o[n][e] = gv[e] * fast_sigmoid(gv[e]) * av[e];
                }
                if ((r >= 1 || t == 0) && (r <= 254 || t == 4095)) *(u32x4*)(act + (size_t)R * DFF + ca) = pack8(o[0], o[1]);
            }
        }
    }
};
struct EpiDown {
    static constexpr bool PERM = true, AFTER_DRAIN = false;
    const float *st1, *lg, *lb, *mod; const bf16_t* r1b; float* out;
    __device__ __forceinline__ void operator()(const f32x4 (&acc)[2][2][4][2], const pg8::Unit& u, int wr, int wc, int fr, int fq) const {
        const int b = (u.pm * 256) >> 12;
#pragma unroll
        for (int bj = 0; bj < 2; ++bj) {
            const int c = u.pn * 256 + bj * 128 + wc * 32 + fq * 8;
            f32x4 g[2], bb[2], g2[2];
#pragma unroll
            for (int n = 0; n < 2; ++n) { g[n] = *(const f32x4*)(lg + c + 4 * n); bb[n] = *(const f32x4*)(lb + c + 4 * n); g2[n] = *(const f32x4*)(mod + b * NADA + 5 * D + c + 4 * n); }
#pragma unroll
            for (int ai = 0; ai < 2; ++ai)
#pragma unroll
                for (int m = 0; m < 4; ++m) {
                    const int r = u.pm * 256 + ai * 128 + wr * 64 + m * 16 + fr;
                    const f32x2 st = *(const f32x2*)(st1 + 2 * r);
                    f32x4 rv2[2]; unpack8(*(const u32x4*)(r1b + (size_t)r * D + c), rv2[0], rv2[1]);
#pragma unroll
                    for (int n = 0; n < 2; ++n) {
                        const f32x4 x1 = (rv2[n] - st.x) * st.y * g[n] + bb[n];
#if EN_FFN
                        *(f32x4*)(out + (size_t)r * D + c + 4 * n) = x1 * DN_ALPHA + g2[n] * acc[ai][bj][m][n];
#else
                        *(f32x4*)(out + (size_t)r * D + c + 4 * n) = x1 * DN_ALPHA;
#endif
                    }
                }
        }
    }
};

namespace att {
constexpr int NT = KV / 64, KSTG = 16384, V_BASE = 3 * 16384, VSTG = 16384;
__device__ __forceinline__ void stage_k(LAS unsigned char* dst, const bf16_t* K0, const bf16_t* K1, int key0, int wid, int lane) {
    const size_t o = ((size_t)((key0 >> 6) * 8 + wid) * 64 + lane) * 8;
    __builtin_amdgcn_global_load_lds((const unsigned*)(K0 + o), (LAS unsigned*)(dst + wid * 1024), 16, 0, 0);
    __builtin_amdgcn_global_load_lds((const unsigned*)(K1 + o), (LAS unsigned*)(dst + 8192 + wid * 1024), 16, 0, 0);
}
__device__ __forceinline__ void stage_v(LAS unsigned char* dst, const bf16_t* Vb, int key0, int wid, int lane) {
#pragma unroll
    for (int i = 0; i < 2; ++i) {
        const int pv = wid + 8 * i, db = pv >> 2, kg = pv & 3;
        __builtin_amdgcn_global_load_lds((const unsigned*)(Vb + ((size_t)((key0 >> 6) * 4 + db) * 64 + 16 * kg) * 32 + lane * 8), (LAS unsigned*)(dst + db * 4096 + kg * 1024), 16, 0, 0);
    }
}
__device__ __forceinline__ s16x4 vtr(const LAS unsigned char* p) {
    typedef short v4i16_t __attribute__((ext_vector_type(4)));
    return __builtin_bit_cast(s16x4, __builtin_amdgcn_ds_read_tr16_b64_v4i16((LAS v4i16_t*)p));
}
#define ATT_THR 8.0f
#define VTR_ASM(dst, addr, off) asm volatile("ds_read_b64_tr_b16 %0, %1 offset:%c2" : "=&v"(dst) : "v"(addr), "i"(off) : "memory")
#define VTR_BLK(blk) do { _Pragma("unroll") for (int ks = 0; ks < 4; ++ks) { VTR_ASM(la[ks], vaddr, (blk) * 4096 + ks * 1024); VTR_ASM(ha[ks], vaddr, (blk) * 4096 + ks * 1024 + 512); } } while (0)
#define VTR_WAIT() asm volatile("s_waitcnt lgkmcnt(0)" : "+v"(la[0]), "+v"(la[1]), "+v"(la[2]), "+v"(la[3]), "+v"(ha[0]), "+v"(ha[1]), "+v"(ha[2]), "+v"(ha[3]) :: "memory")
#define PV_BLK(blk) do { _Pragma("unroll") for (int ks = 0; ks < 4; ++ks) { \
        const bf16x8 vf = (bf16x8){la[ks][0], la[ks][1], la[ks][2], la[ks][3], ha[ks][0], ha[ks][1], ha[ks][2], ha[ks][3]}; \
        o[blk] = __builtin_amdgcn_mfma_f32_32x32x16_bf16(vf, pf[ks], o[blk], 0, 0, 0); } } while (0)
#define QKT(P0, P1, KSLOT) do { \
    const LAS unsigned char* Ks = lds + (KSLOT) * KSTG + (comp ? 8192 : 0); \
    _Pragma("unroll") for (int d0 = 0; d0 < 4; ++d0) { \
        const bf16x8 ka = *(const LAS bf16x8*)(Ks + (2 * d0 + hi) * 1024 + r32 * 16); \
        const bf16x8 kb = *(const LAS bf16x8*)(Ks + (2 * d0 + hi) * 1024 + 512 + r32 * 16); \
        if (d0 == 0) { P0 = __builtin_amdgcn_mfma_f32_32x32x16_bf16(ka, qr[0], negm, 0, 0, 0); P1 = __builtin_amdgcn_mfma_f32_32x32x16_bf16(kb, qr[0], negm, 0, 0, 0); } \
        else { P0 = __builtin_amdgcn_mfma_f32_32x32x16_bf16(ka, qr[d0], P0, 0, 0, 0); P1 = __builtin_amdgcn_mfma_f32_32x32x16_bf16(kb, qr[d0], P1, 0, 0, 0); } } \
} while (0)
#define EXP8(P, B) do { _Pragma("unroll") for (int r = (B); r < (B) + 8; ++r) { P[r] = __builtin_amdgcn_exp2f(P[r]); } } while (0)
#define WAITBAR(n) asm volatile("s_waitcnt vmcnt(" #n ") lgkmcnt(0)\n\ts_barrier" ::: "memory")
__device__ __forceinline__ void attn_unit(int b, int h, int qb, const bf16_t* Q, const bf16_t* Kg, const bf16_t* Vg, bf16_t* On, float lam, const float* subln, LAS unsigned char* lds) {
    const int tid = tid_fresh(), lane = tid & 63, r32 = lane & 31, hi = lane >> 5;
    const int wid = __builtin_amdgcn_readfirstlane(tid >> 6), comp = wid >> 2, wq = wid & 3;
    const int t0 = qb * 128 + wq * 32;
    const bf16_t* Qp = Q + ((size_t)((b * 4 + h) * 2 + comp) * SEQ + t0 + r32) * 64;
    const bf16_t* K0 = Kg + (size_t)((b * 4 + h) * 2) * KV * 64; const bf16_t* K1 = K0 + (size_t)KV * 64;
    const bf16_t* Vb = Vg + (size_t)(b * 4 + h) * KV * 128;
    bf16x8 qr[4];
#pragma unroll
    for (int d0 = 0; d0 < 4; ++d0) qr[d0] = *(const bf16x8*)(Qp + d0 * 16 + hi * 8);
    asm volatile("" ::: "memory");
    stage_k(lds, K0, K1, 0, wid, lane); stage_k(lds + KSTG, K0, K1, 64, wid, lane);
    stage_k(lds + 2 * KSTG, K0, K1, 128, wid, lane); stage_v(lds + V_BASE, Vb, 0, wid, lane);
    f32x16 o[4];
#pragma unroll
    for (int i = 0; i < 4; ++i)
#pragma unroll
        for (int r = 0; r < 16; ++r) o[i][r] = 0.f;
    float mref = 0.f, lrun = 0.f, alpha_prev = 1.f;
    f32x16 negm, pc0, pc1, pn0, pn1;
#pragma unroll
    for (int r = 0; r < 16; ++r) { negm[r] = 0.f; pn0[r] = 0.f; pn1[r] = 0.f; }
    bf16x8 pf[4];
#pragma unroll
    for (int i = 0; i < 4; ++i) pf[i] = (bf16x8){0, 0, 0, 0, 0, 0, 0, 0};
    s16x4 la[4], ha[4];
    const int vlane = ((lane >> 4) & 1) * 32 + (lane & 3) * 8 + (4 * hi + ((lane & 15) >> 2)) * 64;
    const unsigned vbase = (unsigned)(uintptr_t)(lds + V_BASE + vlane);
    asm volatile("s_waitcnt vmcnt(6)" ::: "memory"); __builtin_amdgcn_s_barrier(); asm volatile("" ::: "memory");
    QKT(pc0, pc1, 0);
    int k3 = 1;
    for (int t = 0; t < NT; ++t) {
        if (t + 2 < NT) WAITBAR(4); else if (t + 1 < NT) WAITBAR(2); else WAITBAR(0);
        if (t + 3 < NT) stage_k(lds + (k3 == 0 ? 2 : k3 - 1) * KSTG, K0, K1, (t + 3) * 64, wid, lane);
        if (t + 1 < NT) stage_v(lds + V_BASE + ((t + 1) & 3) * VSTG, Vb, (t + 1) * 64, wid, lane);
        if (t + 1 < NT) QKT(pn0, pn1, k3);
        float mx = fmaxf(pc0[0], pc1[0]);
#pragma unroll
        for (int r = 1; r < 16; ++r) mx = fmaxf(fmaxf(mx, pc0[r]), pc1[r]);
        mx = xmax32(mx);
        float alpha_cur = 1.0f;
        if (__any(mx > ATT_THR)) {
            const float dl = fmaxf(mx, 0.f); mref += dl;
#pragma unroll
            for (int r = 0; r < 16; ++r) { pc0[r] -= dl; pc1[r] -= dl; pn0[r] -= dl; pn1[r] -= dl; negm[r] = -mref; }
            alpha_cur = __builtin_amdgcn_exp2f(-dl); lrun *= alpha_cur;
        }
        if (__any(alpha_prev != 1.0f)) {
#pragma unroll
            for (int i = 0; i < 4; ++i)
#pragma unroll
                for (int r = 0; r < 16; ++r) o[i][r] *= alpha_prev;
        }
        if (t > 0) {
            const unsigned vaddr = vbase + (unsigned)((t + 3) & 3) * VSTG;
            VTR_BLK(0); EXP8(pc0, 0); VTR_WAIT(); PV_BLK(0);
            VTR_BLK(1); EXP8(pc0, 8); VTR_WAIT(); PV_BLK(1);
            VTR_BLK(2); EXP8(pc1, 0); VTR_WAIT(); PV_BLK(2);
            VTR_BLK(3); EXP8(pc1, 8); VTR_WAIT(); PV_BLK(3);
        } else { EXP8(pc0, 0); EXP8(pc0, 8); EXP8(pc1, 0); EXP8(pc1, 8); }
        f32x2 ls2a = {0.f, 0.f}, ls2b = {0.f, 0.f};
#pragma unroll
        for (int r = 0; r < 16; r += 2) { ls2a += (f32x2){pc0[r], pc0[r + 1]}; ls2b += (f32x2){pc1[r], pc1[r + 1]}; }
        ls2a += ls2b; lrun += ls2a.x + ls2a.y;
        { u32x4 w;
          w.x = pk2(pc0[0], pc0[1]); w.y = pk2(pc0[2], pc0[3]); w.z = pk2(pc0[4], pc0[5]); w.w = pk2(pc0[6], pc0[7]); pf[0] = __builtin_bit_cast(bf16x8, w);
          w.x = pk2(pc0[8], pc0[9]); w.y = pk2(pc0[10], pc0[11]); w.z = pk2(pc0[12], pc0[13]); w.w = pk2(pc0[14], pc0[15]); pf[1] = __builtin_bit_cast(bf16x8, w);
          w.x = pk2(pc1[0], pc1[1]); w.y = pk2(pc1[2], pc1[3]); w.z = pk2(pc1[4], pc1[5]); w.w = pk2(pc1[6], pc1[7]); pf[2] = __builtin_bit_cast(bf16x8, w);
          w.x = pk2(pc1[8], pc1[9]); w.y = pk2(pc1[10], pc1[11]); w.z = pk2(pc1[12], pc1[13]); w.w = pk2(pc1[14], pc1[15]); pf[3] = __builtin_bit_cast(bf16x8, w); }
        pc0 = pn0; pc1 = pn1; alpha_prev = alpha_cur;
        k3 = (k3 == 2) ? 0 : k3 + 1;
    }
    WAITBAR(0);
    if (__any(alpha_prev != 1.0f)) {
#pragma unroll
        for (int i = 0; i < 4; ++i)
#pragma unroll
            for (int r = 0; r < 16; ++r) o[i][r] *= alpha_prev;
    }
    { const unsigned vaddr = vbase + (unsigned)((NT - 1) & 3) * VSTG;
      VTR_BLK(0); VTR_WAIT(); PV_BLK(0); VTR_BLK(1); VTR_WAIT(); PV_BLK(1); VTR_BLK(2); VTR_WAIT(); PV_BLK(2); VTR_BLK(3); VTR_WAIT(); PV_BLK(3); }
    lrun = xsum32(lrun);
    const float inv = 1.0f / lrun;
    __syncthreads();
    LAS float* ex = (LAS float*)lds;
    if (comp == 1) {
#pragma unroll
        for (int i = 0; i < 4; ++i)
#pragma unroll
            for (int r = 0; r < 16; ++r) ex[(wq * 64 + i * 16 + r) * 64 + lane] = o[i][r] * inv;
    }
    __syncthreads();
    if (comp == 0) {
        float ss = 0.f;
#pragma unroll
        for (int i = 0; i < 4; ++i)
#pragma unroll
            for (int r = 0; r < 16; ++r) { const float v = o[i][r] * inv - lam * ex[(wq * 64 + i * 16 + r) * 64 + lane]; o[i][r] = v; ss += v * v; }
        ss = xsum32(ss);
        const float rn = 1.0f / sqrtf(ss * (1.0f / 128.0f) + RMS_EPS) * (1.0f - LAM_INIT);
        bf16_t* dst = On + (size_t)(b * SEQ + t0 + r32) * 512 + h * 128;
#pragma unroll
        for (int i = 0; i < 4; ++i)
#pragma unroll
            for (int g = 0; g < 4; ++g) {
                const int d = 32 * i + 8 * g + 4 * hi;
                const f32x4 sg = *(const f32x4*)(subln + d);
                u32x2 w; w.x = pk2(o[i][4 * g] * rn * sg[0], o[i][4 * g + 1] * rn * sg[1]); w.y = pk2(o[i][4 * g + 2] * rn * sg[2], o[i][4 * g + 3] * rn * sg[3]);
                *(u32x2*)(dst + d) = w;
            }
    }
    __syncthreads();
}
#undef VTR_ASM
#undef VTR_BLK
#undef VTR_WAIT
#undef PV_BLK
#undef QKT
#undef EXP8
#undef WAITBAR
}

namespace hy {
__device__ const float WC[16] = {1.0f, 0.98078528040323043f, 0.92387953251128674f, 0.83146961230254524f, 0.70710678118654757f, 0.55557023301960229f, 0.38268343236508984f, 0.19509032201612833f,
                                 0.0f, -0.19509032201612833f, -0.38268343236508984f, -0.55557023301960229f, -0.70710678118654757f, -0.83146961230254524f, -0.92387953251128674f, -0.98078528040323043f};
__device__ const float WS[16] = {0.0f, 0.19509032201612825f, 0.38268343236508978f, 0.55557023301960218f, 0.70710678118654746f, 0.83146961230254524f, 0.92387953251128674f, 0.98078528040323043f,
                                 1.0f, 0.98078528040323043f, 0.92387953251128674f, 0.83146961230254546f, 0.70710678118654757f, 0.55557023301960218f, 0.38268343236508989f, 0.19509032201612861f};
__device__ __forceinline__ int PX(int i) { return i + ((i >> 5) << 1); }
template <bool CONJ> __device__ __forceinline__ f32x2 cmulw(f32x2 a, float c, float s) {
    const f32x2 sw = CONJ ? (f32x2){-a.y, a.x} : (f32x2){a.y, -a.x};
    return a * (f32x2){c, c} + sw * (f32x2){s, s};
}
template <int H, bool INV, bool ZUP = false> __device__ __forceinline__ void pass16(LAS f32x2* X, const f32x2* TW, int tid) {
    constexpr int S = H / 8, MULT = 4096 / H;
    const int j0 = tid % S, blk = tid / S, base = blk * 2 * H + j0;
    f32x2 e[16];
#pragma unroll
    for (int r = 0; r < 16; ++r) e[r] = (ZUP && r >= 8) ? (f32x2){0.f, 0.f} : X[PX(base + r * S)];
    f32x2 w[4];
#pragma unroll
    for (int k = 0; k < 4; ++k) w[k] = TW[(j0 << k) * MULT];
    if (!INV) {
#pragma unroll
        for (int k = 0; k < 4; ++k) {
            const int hk = 8 >> k;
#pragma unroll
            for (int r = 0; r < 16; ++r) if (!(r & hk)) {
                const f32x2 a = e[r], bb = e[r + hk]; e[r] = a + bb; f32x2 d = a - bb;
                const int ci = (r % hk) << (k + 1);
                if (ci != 0) d = cmulw<false>(d, WC[ci], WS[ci]);
                e[r + hk] = cmulw<false>(d, w[k].x, w[k].y);
            }
        }
    } else {
#pragma unroll
        for (int k = 3; k >= 0; --k) {
            const int hk = 8 >> k;
#pragma unroll
            for (int r = 0; r < 16; ++r) if (!(r & hk)) {
                const f32x2 a = e[r]; f32x2 bb = cmulw<true>(e[r + hk], w[k].x, w[k].y);
                const int ci = (r % hk) << (k + 1);
                if (ci != 0) bb = cmulw<true>(bb, WC[ci], WS[ci]);
                e[r] = a + bb; e[r + hk] = a - bb;
            }
        }
    }
#pragma unroll
    for (int r = 0; r < 16; ++r) X[PX(base + r * S)] = e[r];
}
template <bool FILT> __device__ __forceinline__ void pass32(LAS f32x2* X, f32x2* Kout, const f32x2* Kin, int tid) {
    if (tid < 256) {
        f32x2 e[32];
        u32x4 kvv[8];
        if (!FILT) { const u32x4* kp0 = (const u32x4*)Kin + tid;
#pragma unroll
            for (int i = 0; i < 8; ++i) kvv[i] = kp0[i * 256]; }
        const LAS f32x4* xp = (const LAS f32x4*)(X + PX(32 * tid));
#pragma unroll
        for (int i = 0; i < 16; ++i) { const f32x4 v = xp[i]; e[2 * i] = (f32x2){v[0], v[1]}; e[2 * i + 1] = (f32x2){v[2], v[3]}; }
#pragma unroll
        for (int k = 0; k < 5; ++k) {
            const int hk = 16 >> k;
#pragma unroll
            for (int r = 0; r < 32; ++r) if (!(r & hk)) {
                const f32x2 a = e[r], bb = e[r + hk]; e[r] = a + bb; f32x2 d = a - bb;
                const int ci = (r % hk) << k;
                if (ci != 0) d = cmulw<false>(d, WC[ci], WS[ci]);
                e[r + hk] = d;
            }
        }
        if (FILT) {
            u32x4* kp = (u32x4*)Kout + tid;
#pragma unroll
            for (int i = 0; i < 8; ++i) { u32x4 w; w.x = pk2(e[4 * i].x, e[4 * i].y); w.y = pk2(e[4 * i + 1].x, e[4 * i + 1].y); w.z = pk2(e[4 * i + 2].x, e[4 * i + 2].y); w.w = pk2(e[4 * i + 3].x, e[4 * i + 3].y); kp[i * 256] = w; }
        } else {
#pragma unroll
            for (int i = 0; i < 8; ++i) {
#pragma unroll
                for (int j = 0; j < 4; ++j) { const unsigned kw = kvv[i][j]; const float kr = bflo(kw), ki = bfhi(kw); const f32x2 a = e[4 * i + j];
                    e[4 * i + j] = (f32x2){a.x * kr - a.y * ki, a.x * ki + a.y * kr}; }
            }
#pragma unroll
            for (int k = 4; k >= 0; --k) {
                const int hk = 16 >> k;
#pragma unroll
                for (int r = 0; r < 32; ++r) if (!(r & hk)) {
                    const f32x2 a = e[r]; f32x2 bb = e[r + hk];
                    const int ci = (r % hk) << k;
                    if (ci != 0) bb = cmulw<true>(bb, WC[ci], WS[ci]);
                    e[r] = a + bb; e[r + hk] = a - bb;
                }
            }
            LAS f32x4* xo = (LAS f32x4*)(X + PX(32 * tid));
#pragma unroll
            for (int i = 0; i < 16; ++i) xo[i] = (f32x4){e[2 * i].x, e[2 * i].y, e[2 * i + 1].x, e[2 * i + 1].y};
        }
    }
}
__device__ __forceinline__ void conv_fft(LAS f32x2* X, const f32x2* TW, const f32x2* Ks, int tid) {
    __syncthreads(); pass16<4096, false, true>(X, TW, tid);
    __syncthreads(); pass16<256, false>(X, TW, tid);
    __syncthreads(); pass32<false>(X, nullptr, Ks, tid);
    __syncthreads(); pass16<256, true>(X, TW, tid);
    __syncthreads(); pass16<4096, true>(X, TW, tid);
    __syncthreads();
}
struct Raw { u32x4 r; float lo, hi; };
__device__ __forceinline__ Raw raw_load(const bf16_t* zrow, int tid) {
    Raw w; w.r = *(const u32x4*)(zrow + 8 * tid);
    const bf16_t lo = zrow[tid > 0 ? 8 * tid - 1 : 0], hi = zrow[tid < 511 ? 8 * tid + 8 : 4095];
    w.lo = tid > 0 ? bf1(lo) : 0.f; w.hi = tid < 511 ? bf1(hi) : 0.f; return w;
}
__device__ __forceinline__ void conv3_raw(const Raw& w, float w0, float w1, float w2, float bias, float (&out)[8]) {
    float z[10];
    z[0] = w.lo; z[9] = w.hi;
    z[1] = bflo(w.r.x); z[2] = bfhi(w.r.x); z[3] = bflo(w.r.y); z[4] = bfhi(w.r.y); z[5] = bflo(w.r.z); z[6] = bfhi(w.r.z); z[7] = bflo(w.r.w); z[8] = bfhi(w.r.w);
#pragma unroll
    for (int i = 0; i < 8; ++i) out[i] = w0 * z[i] + w1 * z[i + 1] + w2 * z[i + 2] + bias;
}
__device__ __forceinline__ void put8(LAS f32x2* X, int tid, const float (&a)[8], const float (&b)[8]) {
    LAS f32x4* lo = (LAS f32x4*)(X + PX(8 * tid));
#pragma unroll
    for (int i = 0; i < 4; ++i) lo[i] = (f32x4){a[2 * i], b[2 * i], a[2 * i + 1], b[2 * i + 1]};
}
__device__ __forceinline__ void get8(const LAS f32x2* X, int tid, float (&a)[8], float (&b)[8]) {
    const LAS f32x4* lo = (const LAS f32x4*)(X + PX(8 * tid));
#pragma unroll
    for (int i = 0; i < 4; ++i) { const f32x4 v = lo[i]; a[2 * i] = v[0] * (1.0f / 8192.0f); b[2 * i] = v[1] * (1.0f / 8192.0f); a[2 * i + 1] = v[2] * (1.0f / 8192.0f); b[2 * i + 1] = v[3] * (1.0f / 8192.0f); }
}
__device__ __forceinline__ void hyena_unit(int c, int bp, const bf16_t* zhy, const float* cw, const float* cb, const float* hbias, const f32x2* kspec, const f32x2* TW, bf16_t* yht, LAS f32x2* X) {
    const int tid = tid_fresh(); const int b0 = 2 * bp, b1 = b0 + 1; const int c1 = 512 + c, c2 = 1024 + c;
    const Raw rva = raw_load(zhy + (size_t)(b0 * 1536 + c) * 4096, tid), rvb = raw_load(zhy + (size_t)(b1 * 1536 + c) * 4096, tid);
    const Raw r1a = raw_load(zhy + (size_t)(b0 * 1536 + c1) * 4096, tid), r1b = raw_load(zhy + (size_t)(b1 * 1536 + c1) * 4096, tid);
    const float p00 = cw[c], p01 = cw[1536 + c], p02 = cw[3072 + c], p0b = cb[c];
    const float p10 = cw[c1], p11 = cw[1536 + c1], p12 = cw[3072 + c1], p1b = cb[c1], hb0 = hbias[c];
    const float p20 = cw[c2], p21 = cw[1536 + c2], p22 = cw[3072 + c2], p2b = cb[c2], hb1 = hbias[512 + c];
    float va[8], vb[8];
    { const float w0 = p00, w1 = p01, w2 = p02, bs = p0b; conv3_raw(rva, w0, w1, w2, bs, va); conv3_raw(rvb, w0, w1, w2, bs, vb); }
    put8(X, tid, va, vb);
    conv_fft(X, TW, kspec + (size_t)c * 4096, tid);
    const Raw r2a = raw_load(zhy + (size_t)(b0 * 1536 + c2) * 4096, tid), r2b = raw_load(zhy + (size_t)(b1 * 1536 + c2) * 4096, tid);
    float ca[8], cbv[8]; get8(X, tid, ca, cbv);
    float za[8], zb[8];
    { const float w0 = p10, w1 = p11, w2 = p12, bs = p1b, hb = hb0;
      float xa[8], xb[8]; conv3_raw(r1a, w0, w1, w2, bs, xa); conv3_raw(r1b, w0, w1, w2, bs, xb);
#pragma unroll
      for (int i = 0; i < 8; ++i) { za[i] = xa[i] * (ca[i] + va[i] * hb); zb[i] = xb[i] * (cbv[i] + vb[i] * hb); } }
    put8(X, tid, za, zb);
    conv_fft(X, TW, kspec + (size_t)(512 + c) * 4096, tid);
    get8(X, tid, ca, cbv);
    { const float w0 = p20, w1 = p21, w2 = p22, bs = p2b, hb = hb1;
      float xa[8], xb[8]; conv3_raw(r2a, w0, w1, w2, bs, xa); conv3_raw(r2b, w0, w1, w2, bs, xb);
      u32x4 wa, wb;
      wa.x = pk2(xa[0] * (ca[0] + za[0] * hb), xa[1] * (ca[1] + za[1] * hb)); wa.y = pk2(xa[2] * (ca[2] + za[2] * hb), xa[3] * (ca[3] + za[3] * hb));
      wa.z = pk2(xa[4] * (ca[4] + za[4] * hb), xa[5] * (ca[5] + za[5] * hb)); wa.w = pk2(xa[6] * (ca[6] + za[6] * hb), xa[7] * (ca[7] + za[7] * hb));
      wb.x = pk2(xb[0] * (cbv[0] + zb[0] * hb), xb[1] * (cbv[1] + zb[1] * hb)); wb.y = pk2(xb[2] * (cbv[2] + zb[2] * hb), xb[3] * (cbv[3] + zb[3] * hb));
      wb.z = pk2(xb[4] * (cbv[4] + zb[4] * hb), xb[5] * (cbv[5] + zb[5] * hb)); wb.w = pk2(xb[6] * (cbv[6] + zb[6] * hb), xb[7] * (cbv[7] + zb[7] * hb));
      *(u32x4*)(yht + (size_t)(b0 * 512 + c) * 4096 + 8 * tid) = wa;
      *(u32x4*)(yht + (size_t)(b1 * 512 + c) * 4096 + 8 * tid) = wb; }
    __syncthreads();
}
}

__device__ __forceinline__ void transpose_item(const float* W, int K, int N, bf16_t* WT, LAS float* scr, int item, int lane, bool UPPERM) {
    const int nblk = N / 32, kb = item / nblk, nb = item % nblk, k0 = 64 * kb, n0 = 32 * nb;
    float tv[32];
#pragma unroll
    for (int i = 0; i < 32; ++i) tv[i] = W[(size_t)(k0 + 2 * i + (lane >> 5)) * N + n0 + (lane & 31)];
#pragma unroll
    for (int i = 0; i < 32; ++i) scr[(2 * i + (lane >> 5)) * 33 + (lane & 31)] = tv[i];
    asm volatile("s_waitcnt lgkmcnt(0)" ::: "memory");
    const int c = lane & 7;
#pragma unroll
    for (int j = 0; j < 4; ++j) { const int n = (lane >> 3) + 8 * j; const LAS float* s = scr + (8 * c) * 33 + n;
        u32x4 o; o.x = pk2(s[0 * 33], s[1 * 33]); o.y = pk2(s[2 * 33], s[3 * 33]); o.z = pk2(s[4 * 33], s[5 * 33]); o.w = pk2(s[6 * 33], s[7 * 33]);
        int dn = n0 + n; if (UPPERM) { const int c2 = dn >= DFF ? dn - DFF : dn; dn = 256 * (c2 >> 7) + (dn >= DFF ? 128 : 0) + (c2 & 127); }
        *(u32x4*)(WT + (size_t)dn * K + k0 + 8 * c) = o; }
    asm volatile("s_waitcnt lgkmcnt(0)" ::: "memory");
}
__device__ __forceinline__ void ln_row(const float* xrow, const float* g, const float* bb, int lane, f32x4 (&v)[4], float& mean, float& rstd) {
    const f32x4* xr = (const f32x4*)xrow + lane; float s = 0.f;
#pragma unroll
    for (int j = 0; j < 4; ++j) { v[j] = xr[64 * j]; s += (v[j][0] + v[j][1]) + (v[j][2] + v[j][3]); }
    mean = wave_sum(s) * (1.f / D); float s2 = 0.f;
#pragma unroll
    for (int j = 0; j < 4; ++j) { v[j] = v[j] - mean; s2 += (v[j][0] * v[j][0] + v[j][1] * v[j][1]) + (v[j][2] * v[j][2] + v[j][3] * v[j][3]); }
    rstd = 1.f / sqrtf(wave_sum(s2) * (1.f / D) + LN_EPS);
#pragma unroll
    for (int j = 0; j < 4; ++j) { const f32x4 gg = ((const f32x4*)g)[64 * j + lane], b4 = ((const f32x4*)bb)[64 * j + lane]; v[j] = v[j] * rstd * gg + b4; }
}

__device__ __forceinline__ void ln_load2_bf16(const bf16_t* xa, const bf16_t* xb, int lane, u32x4 (&r)[4]) {
    r[0] = ((const u32x4*)xa)[lane]; r[1] = ((const u32x4*)xa)[64 + lane]; r[2] = ((const u32x4*)xb)[lane]; r[3] = ((const u32x4*)xb)[64 + lane];
}
__device__ __forceinline__ void ln_fin2_bf16(const u32x4 (&r)[4], const float* g, const float* bb, int lane, f32x4 (&va)[4], f32x4 (&vb)[4], float& ma, float& ra, float& mb, float& rb) {
    unpack8(r[0], va[0], va[1]); unpack8(r[1], va[2], va[3]); unpack8(r[2], vb[0], vb[1]); unpack8(r[3], vb[2], vb[3]);
    float sa = 0.f, sb = 0.f;
#pragma unroll
    for (int j = 0; j < 4; ++j) { sa += (va[j][0] + va[j][1]) + (va[j][2] + va[j][3]); sb += (vb[j][0] + vb[j][1]) + (vb[j][2] + vb[j][3]); }
    sa = wave_sum(sa); sb = wave_sum(sb);
    ma = sa * (1.f / D); mb = sb * (1.f / D); float qa = 0.f, qb = 0.f;
#pragma unroll
    for (int j = 0; j < 4; ++j) { va[j] = va[j] - ma; vb[j] = vb[j] - mb;
        qa += (va[j][0] * va[j][0] + va[j][1] * va[j][1]) + (va[j][2] * va[j][2] + va[j][3] * va[j][3]);
        qb += (vb[j][0] * vb[j][0] + vb[j][1] * vb[j][1]) + (vb[j][2] * vb[j][2] + vb[j][3] * vb[j][3]); }
    qa = wave_sum(qa); qb = wave_sum(qb);
    ra = 1.f / sqrtf(qa * (1.f / D) + LN_EPS); rb = 1.f / sqrtf(qb * (1.f / D) + LN_EPS);
#pragma unroll
    for (int j = 0; j < 4; ++j) { const int col = 512 * (j >> 1) + 8 * lane + 4 * (j & 1); const f32x4 gg = *(const f32x4*)(g + col), b4 = *(const f32x4*)(bb + col); va[j] = va[j] * ra * gg + b4; vb[j] = vb[j] * rb * gg + b4; }
}
__device__ __forceinline__ void ln_load2(const float* xa, const float* xb, int lane, f32x4 (&va)[4], f32x4 (&vb)[4]) {
    const f32x4* pa = (const f32x4*)xa + lane; const f32x4* pb = (const f32x4*)xb + lane;
#pragma unroll
    for (int j = 0; j < 4; ++j) { va[j] = pa[64 * j]; vb[j] = pb[64 * j]; }
}
__device__ __forceinline__ void ln_fin2(const float* g, const float* bb, int lane, f32x4 (&va)[4], f32x4 (&vb)[4], float& ma, float& ra, float& mb, float& rb) {
    float sa = 0.f, sb = 0.f;
#pragma unroll
    for (int j = 0; j < 4; ++j) { sa += (va[j][0] + va[j][1]) + (va[j][2] + va[j][3]); sb += (vb[j][0] + vb[j][1]) + (vb[j][2] + vb[j][3]); }
    sa = wave_sum(sa); sb = wave_sum(sb);
    ma = sa * (1.f / D); mb = sb * (1.f / D); float qa = 0.f, qb = 0.f;
#pragma unroll
    for (int j = 0; j < 4; ++j) { va[j] = va[j] - ma; vb[j] = vb[j] - mb;
        qa += (va[j][0] * va[j][0] + va[j][1] * va[j][1]) + (va[j][2] * va[j][2] + va[j][3] * va[j][3]);
        qb += (vb[j][0] * vb[j][0] + vb[j][1] * vb[j][1]) + (vb[j][2] * vb[j][2] + vb[j][3] * vb[j][3]); }
    qa = wave_sum(qa); qb = wave_sum(qb);
    ra = 1.f / sqrtf(qa * (1.f / D) + LN_EPS); rb = 1.f / sqrtf(qb * (1.f / D) + LN_EPS);
#pragma unroll
    for (int j = 0; j < 4; ++j) { const f32x4 gg = ((const f32x4*)g)[64 * j + lane], b4 = ((const f32x4*)bb)[64 * j + lane]; va[j] = va[j] * ra * gg + b4; vb[j] = vb[j] * rb * gg + b4; }
}

#define RLX_AGENT __ATOMIC_RELAXED, __HIP_MEMORY_SCOPE_AGENT
#define XB_TMO      128
#define XB_XCNT(j)  (256  + 64 * (j))
#define XB_XSUB(j)  (1280 + 64 * (j))
#define XB_XGEN(j)  (2304 + 64 * (j))
#define XB_TOP      3328
#define XB_TOPGEN   3392
#define XCD_BAR_WORDS 3456
#define XB_SPIN_CAP (1u << 18)

__device__ __forceinline__ unsigned xb_ld(unsigned* p)              { return __hip_atomic_load(p, __ATOMIC_RELAXED, __HIP_MEMORY_SCOPE_AGENT); }
__device__ __forceinline__ unsigned xb_add(unsigned* p, unsigned v) { return __hip_atomic_fetch_add(p, v, __ATOMIC_RELAXED, __HIP_MEMORY_SCOPE_AGENT); }
__device__ __forceinline__ unsigned xb_xcc_id() { return (unsigned)__builtin_amdgcn_s_getreg((3 << 11) | 20) & 0xFu; }
#define XB_SPIN(cond, bar) do { unsigned _sp = 0; while (cond) { __builtin_amdgcn_s_sleep(1); \
    if ((++_sp & 255u) == 0u) { if (xb_ld(&(bar)[XB_TMO])) break; if (_sp > XB_SPIN_CAP) { atomicAdd(&(bar)[XB_TMO], 1u); break; } } } } while (0)

struct XcdBarrier {
    unsigned* bar; unsigned x;
    volatile LAS unsigned* st;
};

__device__ __forceinline__ XcdBarrier xcd_barrier_post(unsigned* bar, volatile LAS unsigned* st) {
    XcdBarrier b; b.bar = bar; b.x = xb_xcc_id(); b.st = st;
    if (threadIdx.x == 0) (void)xb_add(&bar[XB_XCNT(b.x)], 1u);
    return b;
}
__device__ __forceinline__ void xcd_barrier_complete(unsigned* bar, unsigned x, unsigned& nloc, unsigned& nx) {
    const unsigned G = gridDim.x * gridDim.y * gridDim.z;
    unsigned sum, cnt, mine, sp = 0u;
    for (;;) {
        sum = 0u; cnt = 0u; mine = 0u;
#pragma unroll
        for (unsigned j = 0; j < 16; ++j) { const unsigned c = xb_ld(&bar[XB_XCNT(j)]); sum += c; cnt += (c > 0u) ? 1u : 0u; mine = (j == x) ? c : mine; }
        if (sum == G) break;
        __builtin_amdgcn_s_sleep(1);
        if ((++sp & 255u) == 0u) { if (xb_ld(&bar[XB_TMO])) break; if (sp > XB_SPIN_CAP) { atomicAdd(&bar[XB_TMO], 1u); break; } }
    }
    nloc = mine > 0u ? mine : 1u; nx = cnt > 0u ? cnt : 1u;
}

__device__ __forceinline__ void xcd_barrier(const XcdBarrier& b) {
    asm volatile("s_waitcnt vmcnt(0)" ::: "memory");
    __syncthreads();
    if (threadIdx.x == 0) {
        unsigned* bar = b.bar;
        __builtin_amdgcn_s_waitcnt(0);
        unsigned nloc = b.st[0], nx = b.st[1];
        if (nloc == 0u) { xcd_barrier_complete(bar, b.x, nloc, nx); b.st[0] = nloc; b.st[1] = nx; }
        const unsigned old = xb_add(&bar[XB_XSUB(b.x)], 1u);
        const unsigned gen = old / nloc;
        if (old + 1u == (gen + 1u) * nloc) {
            __builtin_amdgcn_fence(__ATOMIC_RELEASE, "agent");
            asm volatile("s_waitcnt vmcnt(0)" ::: "memory");
            const unsigned og = xb_add(&bar[XB_TOP], 1u);
            const unsigned tg = og / nx;
            if (og + 1u == (tg + 1u) * nx) xb_add(&bar[XB_TOPGEN], 1u);
            else XB_SPIN(xb_ld(&bar[XB_TOPGEN]) == tg, bar);
            __builtin_amdgcn_fence(__ATOMIC_ACQUIRE, "agent");
            xb_add(&bar[XB_XGEN(b.x)], 1u);
            asm volatile("s_waitcnt vmcnt(0)" ::: "memory");
        } else {
            XB_SPIN(xb_ld(&bar[XB_XGEN(b.x)]) == gen, bar);
            __builtin_amdgcn_fence(__ATOMIC_ACQUIRE, "agent");
            asm volatile("s_waitcnt vmcnt(0)" ::: "memory");
        }
    }
    __syncthreads();
}

struct Params { const float* in[36]; float* out; unsigned char* ws; };
typedef const __attribute__((address_space(4))) Params* KPtr;
__device__ __forceinline__ KPtr kargs() { KPtr k = (KPtr)__builtin_amdgcn_kernarg_segment_ptr(); asm volatile("" : "+s"(k)); return k; }
#define WSP(T, off) ((T*)(kp->ws + (off)))
#define PROBE_T(k, slot) do { if (PROBE_PH == (k) && blockIdx.x == 0 && threadIdx.x == 0) { KPtr kq = kargs(); ((unsigned long long*)(kq->ws + 800 * 1024))[slot] = __builtin_amdgcn_s_memrealtime(); } } while (0)
#define TIDS() const int tid = tid_fresh(), lane = tid & 63, wave = __builtin_amdgcn_readfirstlane(tid >> 6); const int gw = vcu * 8 + wave; (void)lane; (void)gw

__global__ void __launch_bounds__(512, 2) fwd_kernel(Params p) {
    extern __shared__ __attribute__((aligned(16))) unsigned char lds_raw[];
    LAS unsigned char* lds = (LAS unsigned char*)lds_raw;
    cg::grid_group grid = cg::this_grid();
    const int bx = blockIdx.x, G = gridDim.x;
    { volatile LAS unsigned* st = (volatile LAS unsigned*)(lds + LDS_MISC); if (threadIdx.x < 4) st[threadIdx.x] = 0u; }
    __syncthreads();
    const XcdBarrier xbar = xcd_barrier_post((unsigned*)(kargs()->ws + WS_BAR), (volatile LAS unsigned*)(lds + LDS_MISC));
    const int vcu = (G % 8 == 0) ? (bx % 8) * (G / 8) + bx / 8 : bx;
    const int NGW = G * 8;
    PROBE_T(0, 0);
    if (PH(0)) {
        KPtr kp = kargs();
        TIDS();
        f32x2* rope = WSP(f32x2, WS_ROPE); f32x2* TW = WSP(f32x2, WS_TW); float* modp = WSP(float, WS_MODP); bf16_t* FILT = WSP(bf16_t, WS_FILT);
        LAS float* SC = (LAS float*)lds;
        { const float* cin = kp->in[1]; const float* cctx = kp->in[3]; float cv[18];
#pragma unroll
          for (int j = 0; j < 16; ++j) cv[j] = cin[tid + 512 * j];
          cv[16] = cctx[tid]; cv[17] = cctx[tid + 512];
#pragma unroll
          for (int j = 0; j < 18; ++j) SC[tid + 512 * j] = cv[j] * fast_sigmoid(cv[j]); }
        { const int gt = bx * 512 + tid;
          if (gt < 4096) { float sn, cs; sincospif((float)gt * (1.0f / 4096.0f), &sn, &cs); TW[gt] = (f32x2){cs, sn}; }
          else if (gt < 5120) { const int e = gt - 4096, pos = e >> 4, j = e & 15; const float inv = powf(10000.0f, -(float)(2 * j) / 32.0f); const float ang = (float)pos * inv; rope[e] = (f32x2){cosf(ang), sinf(ang)}; } }
        {
            LAS float* zf = (LAS float*)(lds + 40960);
            LAS float* hA = zf + 16 * 33 + 16;
            LAS float* hB = hA + 1024;
            const int t0 = 16 * bx;
            for (int idx = tid; idx < 16 * 33; idx += 512) {
                const int pp = idx / 33, i = idx % 33, t = t0 + pp; float val;
                if (i == 0) val = (float)t / 4095.0f;
                else { const int band = (i - 1) & 15; const float fv = 1e-4f + (float)band * ((15.0f - 1e-4f) / 15.0f); const float wv = (6.283185307179586f / 4096.0f) * (float)t; const float arg = fv * wv; val = (i <= 16) ? cosf(arg) : -sinf(arg); }
                zf[idx] = val;
            }
            __syncthreads();
            const float *w1 = kp->in[11], *b1 = kp->in[12], *w2 = kp->in[13], *b2 = kp->in[14], *w3 = kp->in[15], *b3 = kp->in[16], *fq = kp->in[17], *wout = kp->in[18];
            LAS float* WL = hB + 1024;
            for (int i = tid; i < 33 * 64; i += 512) WL[i] = w1[i];
            __syncthreads();
            for (int idx = tid; idx < 1024; idx += 512) { const int f = idx & 63, pp = idx >> 6; float s = b1[f];
#pragma unroll 11
                for (int i = 0; i < 33; ++i) s += zf[pp * 33 + i] * WL[i * 64 + f];
                hA[f * 16 + pp] = sinf(fq[f] * s); }
            __syncthreads();
            for (int i = tid; i < 4096; i += 512) WL[i] = w2[i];
            __syncthreads();
            for (int idx = tid; idx < 1024; idx += 512) { const int f = idx & 63, pp = idx >> 6; float s = b2[f];
#pragma unroll 16
                for (int k = 0; k < 64; ++k) s += hA[k * 16 + pp] * WL[k * 64 + f];
                hB[f * 16 + pp] = sinf(fq[64 + f] * s); }
            __syncthreads();
            for (int i = tid; i < 4096; i += 512) WL[i] = w3[i];
            __syncthreads();
            for (int idx = tid; idx < 1024; idx += 512) { const int f = idx & 63, pp = idx >> 6; float s = b3[f];
#pragma unroll 16
                for (int k = 0; k < 64; ++k) s += hB[k * 16 + pp] * WL[k * 64 + f];
                hA[f * 16 + pp] = sinf(fq[128 + f] * s); }
            __syncthreads();
            for (int q = 0; q < 4; ++q) {
                const int n = wave * 256 + q * 64 + lane;
                f32x4 a0 = {0.f, 0.f, 0.f, 0.f}, a1 = a0, a2 = a0, a3 = a0;
#pragma unroll 1
                for (int kb = 0; kb < 64; kb += 16) {
                    float wv[16];
#pragma unroll
                    for (int k = 0; k < 16; ++k) wv[k] = wout[(kb + k) * 2048 + n];
#pragma unroll
                    for (int k = 0; k < 16; ++k) { const float w = wv[k]; const LAS f32x4* hp = (const LAS f32x4*)(hA + (kb + k) * 16);
                        a0 += hp[0] * w; a1 += hp[1] * w; a2 += hp[2] * w; a3 += hp[3] * w; }
                }
                const int cch = n & 511; const float mind = -3.0701134573253945f, maxd = -15.350567286626973f;
                const float delta = fabsf(mind + (float)cch * ((maxd - mind) / 511.0f));
                f32x4 dc[4];
#pragma unroll
                for (int g4 = 0; g4 < 4; ++g4)
#pragma unroll
                    for (int e = 0; e < 4; ++e) dc[g4][e] = __builtin_amdgcn_exp2f(-((float)(t0 + 4 * g4 + e) / 4095.0f) * delta * 1.4426950408889634f);
                u32x4* dst = (u32x4*)(FILT + (size_t)n * 4096 + t0);
                dst[0] = pack8(a0 * dc[0], a1 * dc[1]); dst[1] = pack8(a2 * dc[2], a3 * dc[3]);
            }
        }
        if (wave < 3) {
            const int item = bx * 3 + wave; const int kc = item / 96, nb = item % 96, n = nb * 64 + lane;
            const float* wa = kp->in[6];
            float acc[9];
#pragma unroll
            for (int i = 0; i < 9; ++i) acc[i] = 0.f;
#pragma unroll 32
            for (int k = kc * 128; k < kc * 128 + 128; ++k) { const float w = wa[(size_t)k * NADA + n];
#pragma unroll
                for (int i = 0; i < 9; ++i) acc[i] += SC[i * 1024 + k] * w; }
#pragma unroll
            for (int i = 0; i < 9; ++i) modp[(size_t)(kc * 9 + i) * NADA + n] = acc[i];
        }
        {
            LAS float* scr = (LAS float*)(lds + 65536 + wave * 8448);
            constexpr int I_IN = 16 * 160, I_HY = 8 * 32, I_AT = 8 * 32, I_OUT = 16 * 32, I_UP = 16 * 176, I_DN = 44 * 32;
            constexpr int NIT = I_IN + I_HY + I_AT + I_OUT + I_UP + I_DN;
            for (int it = gw; it < NIT; it += NGW) {
                int r = it; const float* W; bf16_t* WT; int K, N; bool up = false;
                if (r < I_IN) { W = kp->in[8]; K = 1024; N = INC; WT = WSP(bf16_t, WS_WIN); }
                else if ((r -= I_IN) < I_HY) { W = kp->in[25]; K = 512; N = 1024; WT = WSP(bf16_t, WS_WHY); }
                else if ((r -= I_HY) < I_AT) { W = kp->in[26]; K = 512; N = 1024; WT = WSP(bf16_t, WS_WAT); }
                else if ((r -= I_AT) < I_OUT) { W = kp->in[27]; K = 1024; N = 1024; WT = WSP(bf16_t, WS_WOUT); }
                else if ((r -= I_OUT) < I_UP) { W = kp->in[30]; K = 1024; N = NUP; WT = WSP(bf16_t, WS_WUP); up = true; }
                else { r -= I_UP; W = kp->in[33]; K = DFF; N = 1024; WT = WSP(bf16_t, WS_WDN); }
                transpose_item(W, K, N, WT, scr, r, lane, up);
            }
        }
    }
    if (G == 0x7fffffff) grid.sync();
    xcd_barrier(xbar);

    PROBE_T(0, 1); PROBE_T(1, 0);
    if (PH(1)) {
        KPtr kp = kargs();
        TIDS();
        const float* x = kp->in[0]; const float* ctx = kp->in[2]; const float *ln_in_g = kp->in[4], *ln_in_b = kp->in[5];
        float* st0 = WSP(float, WS_ST0); float* mod = WSP(float, WS_MOD); const float* modp = WSP(float, WS_MODP); bf16_t *XM = WSP(bf16_t, WS_XM), *CTXM = WSP(bf16_t, WS_CTXM);
        LAS float* SH = (LAS float*)(lds + 73728);
        const int b = bx >> 5;
        const float* bada = kp->in[7];
        { float sacc[8];
#pragma unroll
          for (int i = 0; i < 8; ++i) { const int j = tid + 512 * i, row = j < 2048 ? b : 8, col = j & 2047; float s = bada[col];
#pragma unroll
              for (int kc = 0; kc < 8; ++kc) s += modp[(size_t)(kc * 9 + row) * NADA + col];
              sacc[i] = s; }
#pragma unroll
          for (int i = 0; i < 8; ++i) SH[tid + 512 * i] = sacc[i]; }
        if (tid < 216) { const int e = bx * 216 + tid, row = e / NADA, col = e - row * NADA;
            float s = bada[col];
#pragma unroll
            for (int kc = 0; kc < 8; ++kc) s += modp[(size_t)(kc * 9 + row) * NADA + col];
            mod[e] = s; }
        __syncthreads();
        f32x4 na[4], nb[4];
        ln_load2(x + (size_t)(bx * 128 + wave) * D, x + (size_t)(bx * 128 + 8 + wave) * D, lane, na, nb);
        for (int ip = 0; ip < 8; ++ip) {
            const int ra_ = bx * 128 + (2 * ip) * 8 + wave, rb_ = ra_ + 8;
            f32x4 va[4], vb[4]; float ma, sa, mb, sb;
#pragma unroll
            for (int j = 0; j < 4; ++j) { va[j] = na[j]; vb[j] = nb[j]; }
            if (ip < 7) ln_load2(x + (size_t)(ra_ + 16) * D, x + (size_t)(rb_ + 16) * D, lane, na, nb);
            ln_fin2(ln_in_g, ln_in_b, lane, va, vb, ma, sa, mb, sb);
            if (lane == 0) { *(f32x2*)(st0 + 2 * ra_) = (f32x2){ma, sa}; *(f32x2*)(st0 + 2 * rb_) = (f32x2){mb, sb}; }
#pragma unroll
            for (int j = 0; j < 4; ++j) { const int col = 256 * j + 4 * lane;
                const f32x4 s4 = *(const LAS f32x4*)(SH + col), c4 = *(const LAS f32x4*)(SH + 1024 + col);
                const f32x4 oa = va[j] * (c4 + 1.0f) + s4, ob = vb[j] * (c4 + 1.0f) + s4;
                u32x2 w; w.x = pk2(oa[0], oa[1]); w.y = pk2(oa[2], oa[3]); *(u32x2*)(XM + (size_t)ra_ * D + col) = w;
                w.x = pk2(ob[0], ob[1]); w.y = pk2(ob[2], ob[3]); *(u32x2*)(XM + (size_t)rb_ * D + col) = w; }
        }
        {
            const int r = bx * 8 + wave;
            f32x4 v[4]; float mean, rstd;
            ln_row(ctx + (size_t)r * D, ln_in_g, ln_in_b, lane, v, mean, rstd);
#pragma unroll
            for (int j = 0; j < 4; ++j) { const int col = 256 * j + 4 * lane;
                const f32x4 s4 = *(const LAS f32x4*)(SH + 2048 + col), c4 = *(const LAS f32x4*)(SH + 3072 + col);
                const f32x4 o = v[j] * (c4 + 1.0f) + s4;
                u32x2 w; w.x = pk2(o[0], o[1]); w.y = pk2(o[2], o[3]); *(u32x2*)(CTXM + (size_t)r * D + col) = w; }
        }
    }
    xcd_barrier(xbar);

    PROBE_T(1, 1); PROBE_T(2, 0);
    if (PH(2)) {
        KPtr kp = kargs();
        pg8::Gemm g{WSP(bf16_t, WS_XM), WSP(bf16_t, WS_WIN), MROWS, INC, D}; pg8::StaticOrder S; S.init(MROWS, INC, G, bx);
        EpiIn E{WSP(bf16_t, WS_ZHY), WSP(bf16_t, WS_Q), WSP(bf16_t, WS_K), WSP(bf16_t, WS_V), WSP(bf16_t, WS_SG), WSP(f32x2, WS_ROPE)};
        pg8::gemm_phase<EpiIn, pg8::StaticOrder, true, true>(lds, g, S, E);
    }
    if (PH(2)) {
        KPtr kp = kargs();
        pg8::Gemm g{WSP(bf16_t, WS_CTXM), WSP(bf16_t, WS_WIN) + (size_t)2048 * D, MCTX, 1024, D}; pg8::StaticOrder S; S.init(MCTX, 1024, G, bx);
        EpiCtx E{WSP(bf16_t, WS_K), WSP(bf16_t, WS_V)};
        pg8::gemm_phase<EpiCtx, pg8::StaticOrder, true, true>(lds, g, S, E);
    }
#if EN_HY
    if (PH(2) && bx >= 32) {
        KPtr kp = kargs(); TIDS();
        const f32x2* TW = WSP(f32x2, WS_TW); const bf16_t* FILT = WSP(bf16_t, WS_FILT); f32x2* KSPEC = WSP(f32x2, WS_KSPEC);
        LAS f32x2* X = (LAS f32x2*)lds;
        LAS f32x2* XB = X + 8704;
        for (int pr = bx - 32; pr < 512; pr += G - 32) {
            __syncthreads();
#pragma unroll
            for (int u = 0; u < 2; ++u) {
                const int fid = 2 * pr + u, order = fid >> 9, c = fid & 511;
                const bf16_t* fwd = FILT + (size_t)(order * 1024 + c) * 4096; const bf16_t* bwd = fwd + (size_t)512 * 4096;
                LAS f32x2* Xu = u ? XB : X;
                float fv[16];
#pragma unroll
                for (int r = 0; r < 8; ++r) { fv[r] = bf1(fwd[tid + 512 * r]); const int jb = 4096 - tid - 512 * r; fv[8 + r] = bf1(bwd[jb > 4095 ? 4095 : jb]); }
                if (tid == 0) fv[8] = 0.f;
#pragma unroll
                for (int r = 0; r < 16; ++r) Xu[hy::PX(tid + 512 * r)] = (f32x2){fv[r], 0.f};
            }
            __syncthreads(); hy::pass16<4096, false>(X, TW, tid); hy::pass16<4096, false>(XB, TW, tid);
            __syncthreads(); hy::pass16<256, false>(X, TW, tid); hy::pass16<256, false>(XB, TW, tid);
            __syncthreads(); hy::pass32<true>(tid < 256 ? X : XB, KSPEC + (size_t)(2 * pr + (tid >> 8)) * 4096, nullptr, tid & 255);
        }
    }
#endif
    xcd_barrier(xbar);

    PROBE_T(2, 1); PROBE_T(3, 0);
    if (PH(3)) {
        KPtr kp = kargs();
        TIDS();
#if EN_ATT
        float lam;
        { const float a = kp->in[20][lane] * kp->in[21][lane], bq = kp->in[22][lane] * kp->in[23][lane]; lam = expf(wave_sum(a)) - expf(wave_sum(bq)) + LAM_INIT; }
        for (int i = 0; i < 4; ++i) { const int unit = (((vcu >> 5) * 4 + i) << 5) | (vcu & 31); if (unit < 1024) att::attn_unit(unit >> 7, (unit >> 5) & 3, unit & 31, WSP(bf16_t, WS_Q), WSP(bf16_t, WS_K), WSP(bf16_t, WS_V), WSP(bf16_t, WS_ON), lam, kp->in[24], lds); }
#else
        for (size_t i = (size_t)bx * 512 + tid; i < (size_t)MROWS * 512 / 8; i += (size_t)G * 512) (WSP(u32x4, WS_ON))[i] = (u32x4){0u, 0u, 0u, 0u};
#endif
        PROBE_T(3, 1); PROBE_T(4, 0);
#if EN_HY
        {
            unsigned* qctr = (unsigned*)(kp->ws + WS_BAR + 14336);
            volatile LAS unsigned* qs = (volatile LAS unsigned*)(lds + LDS_MISC + 16);
            for (;;) {
                if (tid == 0) *qs = __hip_atomic_fetch_add(qctr, 1u, __ATOMIC_RELAXED, __HIP_MEMORY_SCOPE_AGENT);
                __syncthreads();
                const unsigned ch = *qs;
                __syncthreads();
                if (ch >= 2048u) break;
                for (int j = 0; j < 1; ++j) { const int unit = (int)ch;
                    hy::hyena_unit(unit >> 2, unit & 3, WSP(bf16_t, WS_ZHY), kp->in[9], kp->in[10], kp->in[19], WSP(f32x2, WS_KSPEC), WSP(f32x2, WS_TW), WSP(bf16_t, WS_YHT), (LAS f32x2*)lds); }
            }
        }
#endif
    }
    xcd_barrier(xbar);

    PROBE_T(4, 1); PROBE_T(5, 0);
    if (PH(4)) {
        KPtr kp = kargs();
        TIDS();
        const bf16_t* YHT = WSP(bf16_t, WS_YHT); bf16_t* YH = WSP(bf16_t, WS_YH);
#if EN_HY
        LAS bf16_t* scr = (LAS bf16_t*)(lds + wave * 8448);
        for (int tile = gw; tile < 4096; tile += NGW) {
            const int b = tile >> 9, cb = (tile >> 6) & 7, tb = tile & 63;
            const bf16_t* src = YHT + (size_t)(b * 512 + cb * 64) * 4096 + tb * 64;
            for (int i = 0; i < 64; ++i) scr[i * 66 + lane] = src[(size_t)i * 4096 + lane];
            asm volatile("s_waitcnt lgkmcnt(0)" ::: "memory");
            bf16_t* dst = YH + (size_t)(b * 4096 + tb * 64) * 512 + cb * 64;
            for (int j = 0; j < 64; ++j) dst[(size_t)j * 512 + lane] = scr[lane * 66 + j];
            asm volatile("s_waitcnt lgkmcnt(0)" ::: "memory");
        }
#else
        for (size_t i = (size_t)bx * 512 + tid; i < (size_t)MROWS * 512 / 8; i += (size_t)G * 512) ((u32x4*)YH)[i] = (u32x4){0u, 0u, 0u, 0u};
#endif
    }
    xcd_barrier(xbar);

    PROBE_T(5, 1); PROBE_T(6, 0);
    if (PH(5)) {
        KPtr kp = kargs();
        pg8::Gemm g{WSP(bf16_t, WS_YH), WSP(bf16_t, WS_WHY), MROWS, D, 512}; pg8::StaticOrder S; S.init(MROWS, D, G, bx);
        EpiMerge<false> E{WSP(bf16_t, WS_MBUF), WSP(bf16_t, WS_SG)};
        pg8::gemm_phase<EpiMerge<false>, pg8::StaticOrder, true, true>(lds, g, S, E);
    }
    asm volatile("s_waitcnt vmcnt(0)" ::: "memory"); __syncthreads();
    if (PH(5)) {
        KPtr kp = kargs();
        pg8::Gemm g{WSP(bf16_t, WS_ON), WSP(bf16_t, WS_WAT), MROWS, D, 512}; pg8::StaticOrder S; S.init(MROWS, D, G, bx);
        EpiMerge<true> E{WSP(bf16_t, WS_MBUF), WSP(bf16_t, WS_SG)};
        pg8::gemm_phase<EpiMerge<true>, pg8::StaticOrder, true, true>(lds, g, S, E);
    }
    xcd_barrier(xbar);

    PROBE_T(6, 1); PROBE_T(7, 0);
    if (PH(6)) {
        KPtr kp = kargs();
        pg8::Gemm g{WSP(bf16_t, WS_MBUF), WSP(bf16_t, WS_WOUT), MROWS, D, D}; pg8::StaticOrder S; S.init(MROWS, D, G, bx);
        EpiOut E{kp->in[0], WSP(float, WS_ST0), kp->in[4], kp->in[5], WSP(float, WS_MOD), WSP(bf16_t, WS_R1B)};
        pg8::gemm_phase<EpiOut, pg8::StaticOrder, true, true>(lds, g, S, E);
    }
    xcd_barrier(xbar);

    PROBE_T(7, 1); PROBE_T(8, 0);
    if (PH(7)) { KPtr kp = kargs(); TIDS(); float* st1 = WSP(float, WS_ST1); const float* mod = WSP(float, WS_MOD); bf16_t* HM = WSP(bf16_t, WS_HM); const bf16_t* r1b = WSP(bf16_t, WS_R1B); const float *l1g = kp->in[28], *l1b = kp->in[29];
    u32x4 nr[4];
    ln_load2_bf16(r1b + (size_t)(2 * gw) * D, r1b + (size_t)(2 * gw + 1) * D, lane, nr);
    for (int r = 2 * gw; r < MROWS; r += 2 * NGW) {
        f32x4 va[4], vb[4]; float ma, sa, mb, sb; const int b = r >> 12;
        u32x4 cr[4];
#pragma unroll
        for (int j = 0; j < 4; ++j) cr[j] = nr[j];
        if (r + 2 * NGW < MROWS) ln_load2_bf16(r1b + (size_t)(r + 2 * NGW) * D, r1b + (size_t)(r + 2 * NGW + 1) * D, lane, nr);
        ln_fin2_bf16(cr, l1g, l1b, lane, va, vb, ma, sa, mb, sb);
        if (lane == 0) *(f32x4*)(st1 + 2 * r) = (f32x4){ma, sa, mb, sb};
#pragma unroll
        for (int j = 0; j < 4; ++j) { const int col = 512 * (j >> 1) + 8 * lane + 4 * (j & 1);
            const f32x4 s4 = *(const f32x4*)(mod + b * NADA + 3 * D + col), c4 = *(const f32x4*)(mod + b * NADA + 4 * D + col);
            const f32x4 oa = va[j] * (c4 + 1.0f) + s4, ob = vb[j] * (c4 + 1.0f) + s4;
            u32x2 w; w.x = pk2(oa[0], oa[1]); w.y = pk2(oa[2], oa[3]); *(u32x2*)(HM + (size_t)r * D + col) = w;
            w.x = pk2(ob[0], ob[1]); w.y = pk2(ob[2], ob[3]); *(u32x2*)(HM + (size_t)(r + 1) * D + col) = w; }
    } }
    xcd_barrier(xbar);

    PROBE_T(8, 1);
#if EN_FFN
    PROBE_T(9, 0);
    if (PH(8)) {
        KPtr kp = kargs();
        pg8::Gemm g{WSP(bf16_t, WS_HM), WSP(bf16_t, WS_WUP), MROWS, NUP, D}; pg8::StaticOrder S; S.init(MROWS, NUP, G, bx);
        EpiUpGate E{WSP(bf16_t, WS_TSC), WSP(bf16_t, WS_ACT), kp->in[31], kp->in[32], WSP(bf16_t, WS_FILT)};
        pg8::gemm_phase<EpiUpGate, pg8::StaticOrder, true, true>(lds, g, S, E);
    }
    xcd_barrier(xbar);
    PROBE_T(9, 1);
#endif
    PROBE_T(11, 0);
    if (PH(10)) {
        KPtr kp = kargs();
        pg8::Gemm g{WSP(bf16_t, WS_ACT), WSP(bf16_t, WS_WDN), MROWS, D, DFF}; pg8::StaticOrder S; S.init(MROWS, D, G, bx);
#if EN_FFN
        {
            TIDS();
            const bf16_t* ub = WSP(bf16_t, WS_FILT); bf16_t* act = WSP(bf16_t, WS_ACT); const float* cw = kp->in[31]; const float* cb = kp->in[32];
            for (int ui = 0; ui < 2; ++ui) {
                pg8::Unit u; if (!S.next(ui, u)) break;
                for (int it = tid; it < 704; it += 512) {
                    const int which = it / 352, jg = it % 352, ca = jg * 8, pn = ca >> 7, cl = ca & 127, cgt = DFF + ca;
                    const int pm = u.pm; const bool lastrow = which != 0;
                    if (lastrow ? ((pm & 15) == 15) : ((pm & 15) == 0)) continue;
                    const int R = 256 * pm + (lastrow ? 255 : 0);
                    const bf16_t* pp = ub + ((size_t)(((lastrow ? pm : pm - 1) * 22 + pn) * 4 + (lastrow ? 2 : 3))) * 256;
                    const bf16_t* pc = ub + ((size_t)((pm * 22 + pn) * 4 + (lastrow ? 3 : 0))) * 256;
                    const bf16_t* pq = ub + ((size_t)(((lastrow ? pm + 1 : pm) * 22 + pn) * 4 + (lastrow ? 0 : 1))) * 256;
                    f32x4 pA[2], cA[2], nA[2], pG[2], cG[2], nG[2];
                    unpack8(*(const u32x4*)(pp + cl), pA[0], pA[1]); unpack8(*(const u32x4*)(pc + cl), cA[0], cA[1]); unpack8(*(const u32x4*)(pq + cl), nA[0], nA[1]);
                    unpack8(*(const u32x4*)(pp + 128 + cl), pG[0], pG[1]); unpack8(*(const u32x4*)(pc + 128 + cl), cG[0], cG[1]); unpack8(*(const u32x4*)(pq + 128 + cl), nG[0], nG[1]);
                    f32x4 o[2];
#pragma unroll
                    for (int n = 0; n < 2; ++n) {
                        const f32x4 av = *(const f32x4*)(cw + ca + 4 * n) * pA[n] + *(const f32x4*)(cw + NUP + ca + 4 * n) * cA[n] + *(const f32x4*)(cw + 2 * NUP + ca + 4 * n) * nA[n] + *(const f32x4*)(cb + ca + 4 * n);
                        const f32x4 gv = *(const f32x4*)(cw + cgt + 4 * n) * pG[n] + *(const f32x4*)(cw + NUP + cgt + 4 * n) * cG[n] + *(const f32x4*)(cw + 2 * NUP + cgt + 4 * n) * nG[n] + *(const f32x4*)(cb + cgt + 4 * n);
#pragma unroll
                        for (int e = 0; e < 4; ++e) o[n][e] = gv[e] * fast_sigmoid(gv[e]) * av[e];
                    }
                    *(u32x4*)(act + (size_t)R * DFF + ca) = pack8(o[0], o[1]);
                }
            }
            asm volatile("s_waitcnt vmcnt(0)" ::: "memory"); __syncthreads();
        }
#endif
        EpiDown E{WSP(float, WS_ST1), kp->in[28], kp->in[29], WSP(float, WS_MOD), WSP(bf16_t, WS_R1B), kp->out};
        pg8::gemm_phase<EpiDown, pg8::StaticOrder, true, true>(lds, g, S, E);
    }
    xcd_barrier(xbar);

    PROBE_T(11, 1); PROBE_T(12, 0);
    if (PH(11)) { KPtr kp = kargs(); TIDS(); float* outp = kp->out; const float *l2g = kp->in[34], *l2b = kp->in[35];
    f32x4 na[4], nb[4];
    ln_load2(outp + (size_t)(2 * gw) * D, outp + (size_t)(2 * gw + 1) * D, lane, na, nb);
    for (int r = 2 * gw; r < MROWS; r += 2 * NGW) {
        f32x4 va[4], vb[4]; float ma, sa, mb, sb;
#pragma unroll
        for (int j = 0; j < 4; ++j) { va[j] = na[j]; vb[j] = nb[j]; }
        if (r + 2 * NGW < MROWS) ln_load2(outp + (size_t)(r + 2 * NGW) * D, outp + (size_t)(r + 2 * NGW + 1) * D, lane, na, nb);
        ln_fin2(l2g, l2b, lane, va, vb, ma, sa, mb, sb);
        f32x4* oa = (f32x4*)(outp + (size_t)r * D) + lane; f32x4* ob = (f32x4*)(outp + (size_t)(r + 1) * D) + lane;
#pragma unroll
        for (int j = 0; j < 4; ++j) { oa[64 * j] = va[j]; ob[64 * j] = vb[j]; }
    } }
#ifdef EXTRA_SYNCS
    for (int i = 0; i < EXTRA_SYNCS; ++i) xcd_barrier(xbar);
#endif
    PROBE_T(12, 1);
    if (PROBE_PH >= 0 && blockIdx.x == 0 && threadIdx.x == 0) { KPtr kq = kargs(); const unsigned long long* tp = (const unsigned long long*)(kq->ws + 800 * 1024);
        const unsigned long long dt = tp[1] - tp[0], t0 = __builtin_amdgcn_s_memrealtime(); while (__builtin_amdgcn_s_memrealtime() - t0 < dt) __builtin_amdgcn_s_sleep(16); }
}

extern "C" void kernel_launch(void* const* d_in, const int* in_sizes, int n_in, void* d_out, int out_size, void* d_ws, size_t ws_size, hipStream_t stream) {
    static int grid = 0;
    if (grid == 0) {
        if (n_in != 36 || out_size != MROWS * D || ws_size < WS_END) { fprintf(stderr, "kernel_launch: unexpected shapes (n_in %d out %d ws %zu)\n", n_in, out_size, ws_size); grid = -1; return; }
        int dev = 0, cus = 0, per_cu = 0;
        hipGetDevice(&dev); hipDeviceGetAttribute(&cus, hipDeviceAttributeMultiprocessorCount, dev);
        hipFuncSetAttribute((const void*)fwd_kernel, hipFuncAttributeMaxDynamicSharedMemorySize, LDS_BYTES);
        hipOccupancyMaxActiveBlocksPerMultiprocessor(&per_cu, (const void*)fwd_kernel, 512, LDS_BYTES);
        if (per_cu < 1) { fprintf(stderr, "kernel_launch: occupancy query returned %d\n", per_cu); per_cu = 1; }
        (void)hipGetLastError();
        grid = cus;
    }
    if (grid < 0) return;
    if (hipMemsetAsync((char*)d_ws + WS_BAR, 0, 16384, stream) != hipSuccess) { fprintf(stderr, "kernel_launch: memset of the barrier words failed\n"); return; }
    Params prm{};
    for (int i = 0; i < 36; ++i) prm.in[i] = (const float*)d_in[i];
    prm.out = (float*)d_out; prm.ws = (unsigned char*)d_ws;
    void* args[] = {&prm};
    hipError_t e = hipLaunchCooperativeKernel((const void*)fwd_kernel, dim3(grid), dim3(512), args, LDS_BYTES, stream);
    if (e != hipSuccess) fprintf(stderr, "cooperative launch failed: %s (grid %d)\n", hipGetErrorString(e), grid);
}
```
